# Optimizing an MI355X kernel written in HIP

```python
import math, functools
import jax, jax.numpy as jnp
from jax import lax
import numpy as np

D_MODEL = 1024
BATCH = 4
SEQ = 4096
DEPTH = 1
DEC_BATCH = 128
DEC_SEQ = 4
PAST_LEN = 8192
PAGE_SIZE = 128

DN_DK = 128
DN_DV = 128
DN_HEADS = D_MODEL // DN_DV
CONV_W = 4
DN_CHUNK = 64
SW_HEAD_DIM = 64
SW_HEADS = D_MODEL // SW_HEAD_DIM
SW_KV_HEADS = SW_HEADS // 4
SW_GROUP = SW_HEADS // SW_KV_HEADS
WINDOW = 128
ROT_DIM = SW_HEAD_DIM // 4
ROPE_THETA = 500000.0
D_FF = ((8 * D_MODEL // 3 + 63) // 64) * 64
N_SUB = 3
EPS = 1e-6
NEG_INF = -1e30

DN_QK = DN_HEADS * DN_DK
DN_V = DN_HEADS * DN_DV
CONV_CH = 2 * DN_QK + DN_V
SW_Q = SW_HEADS * SW_HEAD_DIM
SW_KV = SW_KV_HEADS * SW_HEAD_DIM
IN_SIZES = (CONV_CH, DN_V, DN_HEADS, DN_HEADS, SW_Q, SW_KV, SW_KV, D_MODEL, D_MODEL)
D_IN = sum(IN_SIZES)

kernel_name = 'hybrid_deltanet_swa_macaron_step'


def rmsnorm(x, gain):
    xf = x.astype(jnp.float32)
    y = xf * lax.rsqrt(jnp.mean(xf * xf, axis=-1, keepdims=True) + EPS)
    return (y * gain.astype(jnp.float32)).astype(x.dtype)


def l2norm(x):
    xf = x.astype(jnp.float32)
    return xf * lax.rsqrt(jnp.sum(xf * xf, axis=-1, keepdims=True) + EPS)


def swiglu(h, w_gate, w_up, w_down):
    return (jax.nn.silu(h @ w_gate) * (h @ w_up)) @ w_down


def short_conv(u, buf, w):
    T = u.shape[1]
    full = jnp.concatenate([buf.astype(u.dtype), u], axis=1)
    out = sum(full[:, i:i + T] * w[i] for i in range(CONV_W))
    return jax.nn.silu(out), full[:, T:]


def rope_partial(x, pos):
    half = ROT_DIM // 2
    inv_freq = ROPE_THETA ** (-jnp.arange(half, dtype=jnp.float32) * (2.0 / ROT_DIM))
    ang = pos.astype(jnp.float32)[:, None] * inv_freq[None, :]
    cos = jnp.cos(ang)[None, :, None, :]
    sin = jnp.sin(ang)[None, :, None, :]
    xr = x[..., :ROT_DIM].astype(jnp.float32)
    x1, x2 = xr[..., :half], xr[..., half:]
    rot = jnp.concatenate([x1 * cos - x2 * sin, x2 * cos + x1 * sin], axis=-1)
    return jnp.concatenate([rot.astype(x.dtype), x[..., ROT_DIM:]], axis=-1)


def gated_delta_rule(q, k, v, g, beta, S0):
    B, T, H, DK = q.shape
    DV = v.shape[-1]
    C = math.gcd(T, DN_CHUNK)
    N = T // C
    f32 = jnp.float32

    def blocks(a):
        return a.astype(f32).reshape(B, N, C, H, -1).transpose(0, 1, 3, 2, 4)

    qc, kc, vc = blocks(q), blocks(k), blocks(v)
    gc = jnp.cumsum(g.astype(f32).reshape(B, N, C, H).transpose(0, 1, 3, 2), axis=-1)
    bc = beta.astype(f32).reshape(B, N, C, H).transpose(0, 1, 3, 2)[..., None]
    incl = jnp.tril(jnp.ones((C, C), dtype=bool))
    strict = jnp.tril(jnp.ones((C, C), dtype=bool), -1)
    diff = gc[..., :, None] - gc[..., None, :]
    decay = jnp.where(incl, jnp.exp(jnp.where(incl, diff, 0.0)), 0.0)
    kb = kc * bc
    lower = jnp.where(strict, jnp.einsum('bnhid,bnhjd->bnhij', kb, kc) * decay, 0.0)
    rhs = jnp.concatenate([vc * bc, kb * jnp.exp(gc)[..., None]], axis=-1)
    sol = lax.linalg.triangular_solve(jnp.eye(C, dtype=f32) + lower, rhs,
                                      left_side=True, lower=True, unit_diagonal=True)
    u, w = sol[..., :DV], sol[..., DV:]
    a_intra = jnp.where(incl, jnp.einsum('bnhid,bnhjd->bnhij', qc, kc) * decay, 0.0)

    def step(S, xs):
        qn, kn, un, wn, gn, an = xs
        v_new = un - jnp.einsum('bhcd,bhde->bhce', wn, S)
        o = (jnp.einsum('bhcd,bhde->bhce', qn * jnp.exp(gn)[..., None], S)
             + jnp.einsum('bhij,bhje->bhie', an, v_new))
        g_last = gn[..., -1:]
        k_dec = kn * jnp.exp(g_last - gn)[..., None]
        S = S * jnp.exp(g_last)[..., None] + jnp.einsum('bhcd,bhce->bhde', k_dec, v_new)
        return S, o

    xs = tuple(jnp.moveaxis(a, 1, 0) for a in (qc, kc, u, w, gc, a_intra))
    S, o = lax.scan(step, S0.astype(f32), xs)
    o = o.transpose(1, 0, 3, 2, 4).reshape(B, T, H, DV)
    return o.astype(v.dtype), S.astype(S0.dtype)


def sink_softmax(scores, mask, sinks):
    s = jnp.where(mask, scores, NEG_INF)
    sink = jnp.broadcast_to(sinks.astype(jnp.float32)[:, :, None, None], s.shape[:-1] + (1,))
    p = jax.nn.softmax(jnp.concatenate([s, sink], axis=-1), axis=-1)
    return p[..., :-1]


def swa_banded(q, k, v, sinks):
    B, T = q.shape[:2]
    W = WINDOW
    NB = T // W
    qb = q.reshape(B, NB, W, SW_KV_HEADS, SW_GROUP, SW_HEAD_DIM)
    kb = k.reshape(B, NB, W, SW_KV_HEADS, SW_HEAD_DIM)
    vb = v.reshape(B, NB, W, SW_KV_HEADS, SW_HEAD_DIM)
    pad = ((0, 0), (1, 0), (0, 0), (0, 0), (0, 0))
    kk = jnp.concatenate([jnp.pad(kb, pad)[:, :NB], kb], axis=2)
    vv = jnp.concatenate([jnp.pad(vb, pad)[:, :NB], vb], axis=2)
    qi = jnp.arange(W)[:, None] + W
    sj = jnp.arange(2 * W)[None, :]
    d = qi - sj
    band = (d >= 0) & (d <= WINDOW)
    valid = (jnp.arange(NB) > 0)[:, None, None] | (sj >= W)[None]
    mask = (band[None] & valid)[None, :, None, None]
    scores = jnp.einsum('bnqkgd,bnskd->bnkgqs', qb, kk).astype(jnp.float32) * (SW_HEAD_DIM ** -0.5)
    p = sink_softmax(scores, mask, sinks.reshape(SW_KV_HEADS, SW_GROUP))
    o = jnp.einsum('bnkgqs,bnskd->bnqkgd', p.astype(vv.dtype), vv).reshape(B, T, SW_Q)
    nb = min(WINDOW, T)
    return o, k[:, -nb:], v[:, -nb:]


def swa_buffered(kbuf, vbuf, q, k, v, sinks):
    B, T = q.shape[:2]
    Wb = kbuf.shape[1]
    kk = jnp.concatenate([kbuf.astype(k.dtype), k], axis=1)
    vv = jnp.concatenate([vbuf.astype(v.dtype), v], axis=1)
    qg = q.reshape(B, T, SW_KV_HEADS, SW_GROUP, SW_HEAD_DIM)
    d = (jnp.arange(T)[:, None] + Wb) - jnp.arange(Wb + T)[None, :]
    mask = ((d >= 0) & (d <= WINDOW))[None, None, None]
    scores = jnp.einsum('bqkgd,bskd->bkgqs', qg, kk).astype(jnp.float32) * (SW_HEAD_DIM ** -0.5)
    p = sink_softmax(scores, mask, sinks.reshape(SW_KV_HEADS, SW_GROUP))
    o = jnp.einsum('bkgqs,bskd->bqkgd', p.astype(vv.dtype), vv).reshape(B, T, SW_Q)
    return o, kk[:, -Wb:], vv[:, -Wb:]


def token_mixer(h, pos, conv_buf, S0, attend, p):
    B, T = h.shape[:2]
    proj = h @ p['w_in']
    split_idx = np.cumsum(IN_SIZES)[:-1].tolist()
    u, z, b_raw, a_raw, q_sw, k_sw, v_sw, gate_a, gate_b = jnp.split(proj, split_idx, axis=-1)
    u, conv_new = short_conv(u, conv_buf, p['conv_w'])
    q_dn, k_dn, v_dn = jnp.split(u, [DN_QK, 2 * DN_QK], axis=-1)
    q_dn = l2norm(q_dn.reshape(B, T, DN_HEADS, DN_DK)) * (DN_DK ** -0.5)
    k_dn = l2norm(k_dn.reshape(B, T, DN_HEADS, DN_DK))
    v_dn = v_dn.reshape(B, T, DN_HEADS, DN_DV)
    beta = jax.nn.sigmoid(b_raw.astype(jnp.float32))
    g = -jnp.exp(p['a_log'].astype(jnp.float32)) * jax.nn.softplus(
        a_raw.astype(jnp.float32) + p['dt_bias'].astype(jnp.float32))
    o_dn, S_new = gated_delta_rule(q_dn, k_dn, v_dn, g, beta, S0)
    o_dn = (rmsnorm(o_dn, p['dn_norm']) * jax.nn.silu(z.reshape(B, T, DN_HEADS, DN_DV))).reshape(B, T, DN_V)
    q = rope_partial(q_sw.reshape(B, T, SW_HEADS, SW_HEAD_DIM), pos)
    k = rope_partial(k_sw.reshape(B, T, SW_KV_HEADS, SW_HEAD_DIM), pos)
    v = v_sw.reshape(B, T, SW_KV_HEADS, SW_HEAD_DIM)
    o_sw, kbuf_new, vbuf_new = attend(q, k, v, p['sinks'])
    y = jax.nn.sigmoid(gate_a) * o_dn + jax.nn.sigmoid(gate_b) * o_sw
    return y @ p['w_out'], (kbuf_new, vbuf_new, conv_new, S_new)


def decoder_layer(x, c, pos, conv_buf, S0, attend, p):
    mod = jax.nn.silu(c) @ p['w_ada'] + p['b_ada']
    sh1, sc1, g1, sh2, sc2, g2, sh3, sc3, g3 = [m[:, None, :] for m in jnp.split(mod, 3 * N_SUB, axis=-1)]
    h = rmsnorm(x, p['ffn1_norm_pre']) * (1 + sc1) + sh1
    x = x + 0.5 * g1 * rmsnorm(swiglu(h, p['ffn1_w_gate'], p['ffn1_w_up'], p['ffn1_w_down']), p['ffn1_norm_post'])
    h = rmsnorm(x, p['mix_norm_pre']) * (1 + sc2) + sh2
    y, state = token_mixer(h, pos, conv_buf, S0, attend, p)
    x = x + g2 * rmsnorm(y, p['mix_norm_post'])
    h = rmsnorm(x, p['ffn2_norm_pre']) * (1 + sc3) + sh3
    x = x + 0.5 * g3 * rmsnorm(swiglu(h, p['ffn2_w_gate'], p['ffn2_w_up'], p['ffn2_w_down']), p['ffn2_norm_post'])
    return x, state


def setup_inputs(seed: int = 0) -> dict:
    key = jax.random.key(seed)
    ks = jax.random.split(key, 40)
    f32 = jnp.float32

    def nrm(k, shape, s=1.0):
        return s * jax.random.normal(k, shape, f32)

    def gain(k, n=D_MODEL):
        return 1.0 + nrm(k, (DEPTH, n), 0.05)

    wb = min(WINDOW, PAST_LEN)
    dt = jnp.exp(jax.random.uniform(ks[30], (DEPTH, DN_HEADS), f32, math.log(1e-3), math.log(1e-1)))
    return {
        'x_prompt': nrm(ks[0], (BATCH, SEQ, D_MODEL)),
        'x_sample': nrm(ks[1], (DEC_BATCH, DEC_SEQ, D_MODEL)),
        'cache_swa_k': nrm(ks[2], (DEPTH, DEC_BATCH, wb, SW_KV_HEADS, SW_HEAD_DIM)),
        'cache_swa_v': nrm(ks[3], (DEPTH, DEC_BATCH, wb, SW_KV_HEADS, SW_HEAD_DIM)),
        'state_conv': nrm(ks[4], (DEPTH, DEC_BATCH, CONV_W - 1, CONV_CH)),
        'state_delta': nrm(ks[5], (DEPTH, DEC_BATCH, DN_HEADS, DN_DK, DN_DV), DN_DK ** -0.5),
        'c_prompt': nrm(ks[6], (BATCH, D_MODEL)),
        'c_sample': nrm(ks[7], (DEC_BATCH, D_MODEL)),
        'w_ada': nrm(ks[8], (DEPTH, D_MODEL, 3 * N_SUB * D_MODEL), 0.5 * D_MODEL ** -0.5),
        'b_ada': nrm(ks[9], (DEPTH, 3 * N_SUB * D_MODEL), 0.02),
        'ffn1_norm_pre': gain(ks[10]),
        'ffn1_norm_post': gain(ks[11]),
        'ffn1_w_gate': nrm(ks[12], (DEPTH, D_MODEL, D_FF), D_MODEL ** -0.5),
        'ffn1_w_up': nrm(ks[13], (DEPTH, D_MODEL, D_FF), D_MODEL ** -0.5),
        'ffn1_w_down': nrm(ks[14], (DEPTH, D_FF, D_MODEL), D_FF ** -0.5),
        'mix_norm_pre': gain(ks[15]),
        'mix_norm_post': gain(ks[16]),
        'w_in': nrm(ks[17], (DEPTH, D_MODEL, D_IN), D_MODEL ** -0.5),
        'conv_w': nrm(ks[18], (DEPTH, CONV_W, CONV_CH), CONV_W ** -0.5),
        'a_log': jnp.log(jax.random.uniform(ks[19], (DEPTH, DN_HEADS), f32, 1.0, 16.0)),
        'dt_bias': dt + jnp.log(-jnp.expm1(-dt)),
        'dn_norm': gain(ks[20], DN_DV),
        'sinks': nrm(ks[21], (DEPTH, SW_HEADS), 0.5),
        'w_out': nrm(ks[22], (DEPTH, D_MODEL, D_MODEL), D_MODEL ** -0.5),
        'ffn2_norm_pre': gain(ks[23]),
        'ffn2_norm_post': gain(ks[24]),
        'ffn2_w_gate': nrm(ks[25], (DEPTH, D_MODEL, D_FF), D_MODEL ** -0.5),
        'ffn2_w_up': nrm(ks[26], (DEPTH, D_MODEL, D_FF), D_MODEL ** -0.5),
        'ffn2_w_down': nrm(ks[27], (DEPTH, D_FF, D_MODEL), D_FF ** -0.5),
    }


def reference(x_prompt, x_sample, cache_swa_k, cache_swa_v, state_conv, state_delta,
              c_prompt, c_sample, w_ada, b_ada, ffn1_norm_pre, ffn1_norm_post,
              ffn1_w_gate, ffn1_w_up, ffn1_w_down, mix_norm_pre, mix_norm_post,
              w_in, conv_w, a_log, dt_bias, dn_norm, sinks, w_out,
              ffn2_norm_pre, ffn2_norm_post, ffn2_w_gate, ffn2_w_up, ffn2_w_down):
    B = x_prompt.shape[0]
    pos_p = jnp.arange(x_prompt.shape[1])
    pos_s = PAST_LEN + jnp.arange(x_sample.shape[1])
    y_p, y_s = x_prompt, x_sample
    kp, vp, cp, sp = [], [], [], []
    ksm, vsm, csm, ssm = [], [], [], []
    for l in range(DEPTH):
        p = dict(w_ada=w_ada[l], b_ada=b_ada[l],
                 ffn1_norm_pre=ffn1_norm_pre[l], ffn1_norm_post=ffn1_norm_post[l],
                 ffn1_w_gate=ffn1_w_gate[l], ffn1_w_up=ffn1_w_up[l], ffn1_w_down=ffn1_w_down[l],
                 mix_norm_pre=mix_norm_pre[l], mix_norm_post=mix_norm_post[l],
                 w_in=w_in[l], conv_w=conv_w[l], a_log=a_log[l], dt_bias=dt_bias[l],
                 dn_norm=dn_norm[l], sinks=sinks[l], w_out=w_out[l],
                 ffn2_norm_pre=ffn2_norm_pre[l], ffn2_norm_post=ffn2_norm_post[l],
                 ffn2_w_gate=ffn2_w_gate[l], ffn2_w_up=ffn2_w_up[l], ffn2_w_down=ffn2_w_down[l])
        conv0 = jnp.zeros((B, CONV_W - 1, CONV_CH), x_prompt.dtype)
        S0 = jnp.zeros((B, DN_HEADS, DN_DK, DN_DV), state_delta.dtype)
        y_p, (k1, v1, c1, s1) = decoder_layer(y_p, c_prompt, pos_p, conv0, S0, swa_banded, p)
        attend_s = functools.partial(swa_buffered, cache_swa_k[l], cache_swa_v[l])
        y_s, (k2, v2, c2, s2) = decoder_layer(y_s, c_sample, pos_s, state_conv[l], state_delta[l], attend_s, p)
        kp.append(k1); vp.append(v1); cp.append(c1); sp.append(s1)
        ksm.append(k2); vsm.append(v2); csm.append(c2); ssm.append(s2)
    swa_k_prompt, swa_v_prompt = jnp.stack(kp), jnp.stack(vp)
    conv_prompt, delta_prompt = jnp.stack(cp), jnp.stack(sp)
    swa_k_sample, swa_v_sample = jnp.stack(ksm), jnp.stack(vsm)
    conv_sample, delta_sample = jnp.stack(csm), jnp.stack(ssm)
    return (y_p, y_s, swa_k_prompt, swa_v_prompt, conv_prompt, delta_prompt,
            swa_k_sample, swa_v_sample, conv_sample, delta_sample)
```

```cpp
#include <hip/hip_runtime.h>
#include <hip/hip_cooperative_groups.h>
#include <stdint.h>
#include <cstdio>
namespace cg = cooperative_groups;

#ifndef MK_COOP
#define MK_COOP 1
#endif
#ifndef MK_ONLY
#define MK_ONLY -1
#endif
#define PHON(k) (MK_ONLY < 0 || MK_ONLY == (k))

#define DI __device__ __forceinline__
typedef unsigned short bf16_t;
typedef short bf16x8 __attribute__((ext_vector_type(8)));
typedef short s16x4 __attribute__((ext_vector_type(4)));
typedef float f32x4 __attribute__((ext_vector_type(4)));
typedef unsigned u32x4 __attribute__((ext_vector_type(4)));
typedef unsigned u32x2 __attribute__((ext_vector_type(2)));
#define LAS __attribute__((address_space(3)))
#define MFMA16(a, b, c) __builtin_amdgcn_mfma_f32_16x16x32_bf16((a), (b), (c), 0, 0, 0)

constexpr int MP = 16384, MALL = 16896, DM = 1024, DFF = 2752;
constexpr float EPSF = 1e-6f;
constexpr size_t OFF_MOD = 0;
constexpr size_t OFF_H = 9437184;
constexpr size_t OFF_WB = 44040192;
constexpr size_t OFF_WO = 50331648;
constexpr size_t OFF_SC = 52428800;
constexpr size_t OFF_ROPE = 52953088;
constexpr size_t OFF_C = 53215744;
constexpr size_t C_F = 0;
constexpr size_t C_ACT = 69206016;
constexpr size_t C_WADA = 0;
constexpr size_t C_PU = 0;
constexpr size_t C_KDT = 103809024;
constexpr size_t C_ACH = 137363456;
constexpr size_t C_PQ = 154140672;
constexpr size_t C_PKV = 188743680;
constexpr size_t C_KCS = 206045184;
constexpr size_t C_VTP = 215482368;
constexpr size_t C_VTS = 223870976;
constexpr size_t C_PBA = 234356736;
constexpr size_t C_SSQ = 235438080;
constexpr size_t C_GAM = 235978752;
constexpr size_t C_Y = C_KDT;
constexpr size_t C_W2GU = 166723584;
constexpr size_t C_W2D = 177995776;
constexpr size_t O_Y = 0, O_SWKP = 17301504, O_SWVP = 17432576, O_CONVP = 17563648, O_DELTAP = 17600512,
                 O_SWKS = 18124800, O_SWVS = 22319104, O_CONVS = 26513408, O_DELTAS = 27693056;
constexpr size_t T_W1GU = O_SWKS * 4;
constexpr size_t T_W1D = T_W1GU + 11272192;
constexpr size_t T_WA = T_W1D + 5636096;
constexpr size_t T_UP = O_SWKS * 4;
constexpr size_t C_HALO = 235986944;

struct Params {
    const float* x_p; const float* x_s; const float* cache_k; const float* cache_v; const float* st_conv; const float* st_delta;
    const float* c_p; const float* c_s; const float* w_ada; const float* b_ada;
    const float* n1pre; const float* n1post; const float* w1g; const float* w1u; const float* w1d;
    const float* nmpre; const float* nmpost; const float* w_in; const float* conv_w; const float* a_log; const float* dt_bias;
    const float* dn_norm; const float* sinks; const float* w_out;
    const float* n2pre; const float* n2post; const float* w2g; const float* w2u; const float* w2d;
    float* out; char* ws; int plo; int phi;
};

typedef __bf16 bf16v2_t __attribute__((ext_vector_type(2)));
typedef float f32v2_t __attribute__((ext_vector_type(2)));
DI unsigned pack2(float a, float b) { const f32v2_t v = {a, b}; return __builtin_bit_cast(unsigned, __builtin_convertvector(v, bf16v2_t)); }
DI unsigned f2bf(float x) { return pack2(x, 0.f) & 0xffffu; }
DI float bf2f(unsigned h) { return __uint_as_float(h << 16); }
DI float bflo(unsigned w) { return __uint_as_float(w << 16); }
DI float bfhi(unsigned w) { return __uint_as_float(w & 0xffff0000u); }
DI float sigm(float x) { return __builtin_amdgcn_rcpf(1.f + __expf(-x)); }
DI float siluf(float x) { return x * __builtin_amdgcn_rcpf(1.f + __expf(-x)); }
DI float softplusf(float x) { return fmaxf(x, 0.f) + log1pf(__expf(-fabsf(x))); }
DI bf16x8 pack8(const f32x4& a, const f32x4& b) {
    u32x4 p; p.x = pack2(a[0], a[1]); p.y = pack2(a[2], a[3]); p.z = pack2(b[0], b[1]); p.w = pack2(b[2], b[3]);
    return __builtin_bit_cast(bf16x8, p);
}
DI bf16x8 cat4(const s16x4& lo, const s16x4& hi) { return __builtin_shufflevector(lo, hi, 0, 1, 2, 3, 4, 5, 6, 7); }

template <int NT, class Epi>
DI void gemm_phase(const bf16_t* __restrict__ A, const bf16_t* __restrict__ Bt, int K, int nmt, int nnt, char* lds, const Epi& epi) {
    const int tid = threadIdx.x, lane = tid & 63, wid = tid >> 6, fr = lane & 15, fq = lane >> 4;
    const int wm = wid >> 1, wn = wid & 1;
    constexpr int BN = NT * 32;
    constexpr int BCH = BN / 32;
    const int ntiles = nmt * nnt, nk = K >> 6;
    const int srow = tid >> 3, spos = tid & 7;
    const bool xmap = nmt >= 16 && (gridDim.x & 7) == 0;
    const int xcd = blockIdx.x & 7;
    const int mlo = xmap ? (xcd * nmt) >> 3 : 0, mcnt = xmap ? (((xcd + 1) * nmt) >> 3) - mlo : nmt;
    const int estart = xmap ? (int)(blockIdx.x >> 3) : (int)blockIdx.x, estep = xmap ? (int)(gridDim.x >> 3) : (int)gridDim.x;
    const int etotal = xmap ? mcnt * nnt : ntiles;
    for (int e = estart; e < etotal; e += estep) {
        int mt, nt;
        if (xmap) {
            const int pg = mcnt * 8, ng = e / pg, nrem = nnt - ng * 8, gw = nrem < 8 ? nrem : 8, r = e - ng * pg, mi = r / gw;
            mt = mlo + mi; nt = ng * 8 + (r - mi * gw);
        } else { mt = e % nmt; nt = e / nmt; }
        const int m0 = mt * 128, n0 = nt * BN;
        f32x4 acc[4][NT];
#pragma unroll
        for (int m = 0; m < 4; ++m)
#pragma unroll
            for (int n = 0; n < NT; ++n) acc[m][n] = (f32x4){0.f, 0.f, 0.f, 0.f};
        const bf16_t* ag[4]; const bf16_t* bg[BCH];
#pragma unroll
        for (int i = 0; i < 4; ++i) { const int row = srow + 32 * i; ag[i] = A + (size_t)(m0 + row) * K + ((spos ^ ((row >> 1) & 7)) << 3); }
#pragma unroll
        for (int i = 0; i < BCH; ++i) { const int row = srow + 32 * i; bg[i] = Bt + (size_t)(n0 + row) * K + ((spos ^ ((row >> 1) & 7)) << 3); }
        __syncthreads();
#define GEMM_ISSUE(kt_, st_) do { \
        _Pragma("unroll") for (int i = 0; i < 4; ++i) __builtin_amdgcn_global_load_lds((const unsigned*)(ag[i] + (kt_) * 64), (LAS unsigned*)(lds + (st_) * 32768 + i * 4096 + wid * 1024), 16, 0, 0); \
        _Pragma("unroll") for (int i = 0; i < BCH; ++i) __builtin_amdgcn_global_load_lds((const unsigned*)(bg[i] + (kt_) * 64), (LAS unsigned*)(lds + (st_) * 32768 + 16384 + i * 4096 + wid * 1024), 16, 0, 0); } while (0)
        GEMM_ISSUE(0, 0);
        for (int kt = 0; kt < nk; ++kt) {
            asm volatile("s_waitcnt vmcnt(0)" ::: "memory");
            __syncthreads();
            if (kt + 1 < nk) GEMM_ISSUE(kt + 1, (kt + 1) & 1);
            const char* As = lds + (kt & 1) * 32768;
            const char* Bs = As + 16384;
            bf16x8 af[2][4], bfr[2][NT];
#pragma unroll
            for (int ks = 0; ks < 2; ++ks) {
                const int ch = ks * 4 + fq;
#pragma unroll
                for (int m = 0; m < 4; ++m) { const int row = wm * 64 + m * 16 + fr; af[ks][m] = *(const bf16x8*)(As + row * 128 + ((ch ^ ((row >> 1) & 7)) << 4)); }
#pragma unroll
                for (int n = 0; n < NT; ++n) { const int row = wn * NT * 16 + n * 16 + fr; bfr[ks][n] = *(const bf16x8*)(Bs + row * 128 + ((ch ^ ((row >> 1) & 7)) << 4)); }
            }
            __builtin_amdgcn_s_setprio(1);
#pragma unroll
            for (int ks = 0; ks < 2; ++ks)
#pragma unroll
                for (int m = 0; m < 4; ++m)
#pragma unroll
                    for (int n = 0; n < NT; ++n) acc[m][n] = MFMA16(bfr[ks][n], af[ks][m], acc[m][n]);
            __builtin_amdgcn_s_setprio(0);
        }
#undef GEMM_ISSUE
        epi(acc, m0 + wm * 64 + fr, n0, wn, fq, lane);
    }
}

struct EpiF32 {
    float* C; int ldc; const float* bias;
    DI void operator()(const f32x4 (&acc)[4][4], int rowb, int n0, int wn, int fq, int) const {
#pragma unroll
        for (int m = 0; m < 4; ++m)
#pragma unroll
            for (int n = 0; n < 4; ++n) {
                const int col = n0 + wn * 64 + n * 16 + 4 * fq;
                f32x4 v = acc[m][n];
                if (bias) { const f32x4 bv = *(const f32x4*)(bias + col); v = v + bv; }
                *(f32x4*)(C + (size_t)(rowb + m * 16) * ldc + col) = v;
            }
    }
};
struct EpiBf16 {
    bf16_t* O; int ldc;
    DI void operator()(const f32x4 (&acc)[4][4], int rowb, int n0, int wn, int fq, int) const {
#pragma unroll
        for (int m = 0; m < 4; ++m)
#pragma unroll
            for (int n = 0; n < 4; ++n) {
                const f32x4 v = acc[m][n]; u32x2 w; w.x = pack2(v[0], v[1]); w.y = pack2(v[2], v[3]);
                *(u32x2*)(O + (size_t)(rowb + m * 16) * ldc + n0 + wn * 64 + n * 16 + 4 * fq) = w;
            }
    }
};
struct EpiSwiglu {
    bf16_t* O;
    DI void operator()(const f32x4 (&acc)[4][4], int rowb, int n0, int wn, int fq, int) const {
        const int cb = (n0 >> 1) + wn * 32 + 4 * fq;
#pragma unroll
        for (int m = 0; m < 4; ++m)
#pragma unroll
            for (int n2 = 0; n2 < 2; ++n2) {
                const f32x4 g = acc[m][2 * n2], u = acc[m][2 * n2 + 1];
                u32x2 w; w.x = pack2(siluf(g[0]) * u[0], siluf(g[1]) * u[1]); w.y = pack2(siluf(g[2]) * u[2], siluf(g[3]) * u[3]);
                *(u32x2*)(O + (size_t)(rowb + m * 16) * DFF + cb + n2 * 16) = w;
            }
    }
};
struct EpiP {
    bf16_t* PU; bf16_t* PQ; bf16_t* PKV; float* PBA; const float* rope; bf16_t* HALO; float* out;
    DI void operator()(const f32x4 (&acc)[4][4], int rowb, int n0, int wn, int fq, int) const {
        if (n0 < 3072) {
#pragma unroll
            for (int m = 0; m < 4; ++m)
#pragma unroll
                for (int n = 0; n < 4; ++n) {
                    const f32x4 v = acc[m][n]; u32x2 w; w.x = pack2(v[0], v[1]); w.y = pack2(v[2], v[3]);
                    const int row = rowb + m * 16, col = n0 + wn * 64 + n * 16 + 4 * fq;
                    *(u32x2*)(PU + (size_t)row * 3072 + col) = w;
                    if ((row & 63) >= 61 && row < MP && (row & 4095) < 4032)
                        *(u32x2*)(HALO + ((size_t)((row >> 6) + 1) * 3 + ((row & 63) - 61)) * 3072 + col) = w;
                    if (row < MP && (row & 4095) >= 4093)
                        *(f32x4*)(out + O_CONVP + ((size_t)(row >> 12) * 3 + ((row & 4095) - 4093)) * 3072 + col) = v;
                }
        } else if (n0 < 4608) {
            const bool isq = n0 < 4096;
            const int cw = (isq ? n0 - 3072 : n0 - 4096) + wn * 64;
            const bool rot = isq || cw < 256;
            bf16_t* dst = isq ? PQ : PKV; const int ld = isq ? 1024 : 512;
#pragma unroll
            for (int m = 0; m < 4; ++m) {
                const int row = rowb + m * 16;
                const int pidx = row < MP ? (row & 4095) : 4096 + (row & 3);
                const float* tab = rope + pidx * 16 + 4 * (fq & 1);
#pragma unroll
                for (int n = 0; n < 4; ++n) {
                    f32x4 v = acc[m][n];
                    if (n == 0) {
                        f32x4 pr;
#pragma unroll
                        for (int j = 0; j < 4; ++j) pr[j] = __shfl_xor(v[j], 32);
                        if (rot) {
#pragma unroll
                            for (int j = 0; j < 4; ++j) { const float c = tab[j], s = tab[8 + j]; v[j] = (fq < 2) ? v[j] * c - pr[j] * s : v[j] * c + pr[j] * s; }
                        }
                    }
                    u32x2 w; w.x = pack2(v[0], v[1]); w.y = pack2(v[2], v[3]);
                    *(u32x2*)(dst + (size_t)row * ld + cw + n * 16 + 4 * fq) = w;
                    if (!isq && row < MP && (row & 4095) >= 3968) {
                        const int cc = cw + n * 16 + 4 * fq;
                        *(f32x4*)(out + (cc < 256 ? O_SWKP : O_SWVP) + ((size_t)(row >> 12) * 128 + ((row & 4095) - 3968)) * 256 + (cc & 255)) = v;
                    }
                }
            }
        } else {
            if (wn == 0) {
#pragma unroll
                for (int m = 0; m < 4; ++m) *(f32x4*)(PBA + (size_t)(rowb + m * 16) * 16 + 4 * fq) = acc[m][0];
            }
        }
    }
};
struct EpiMerge {
    const bf16_t* PU; const bf16_t* PQ; const float* dng; bf16_t* Y;
    DI void operator()(const f32x4 (&acc)[4][3], int rowb, int n0, int wn, int fq, int) const {
        const int c0 = (n0 / 96) * 32 + wn * 16 + 4 * fq;
        const f32x4 gn = *(const f32x4*)(dng + (c0 & 127));
        u32x4 ov[4][4];
#pragma unroll
        for (int m = 0; m < 4; ++m) {
            const bf16_t* op = PU + (size_t)(rowb + m * 16) * 3072 + 2048 + (c0 & ~127) + fq * 32;
#pragma unroll
            for (int i = 0; i < 4; ++i) ov[m][i] = *(const u32x4*)(op + i * 8);
        }
#pragma unroll
        for (int m = 0; m < 4; ++m) {
            const int row = rowb + m * 16;
            float ss = 0.f;
#pragma unroll
            for (int i = 0; i < 4; ++i)
#pragma unroll
                for (int e = 0; e < 4; ++e) { const float a = bflo(ov[m][i][e]), b = bfhi(ov[m][i][e]); ss += a * a + b * b; }
            ss += __shfl_xor(ss, 16); ss += __shfl_xor(ss, 32);
            const float rstd = rsqrtf(ss * (1.f / 128.f) + EPSF);
            const u32x2 ou = *(const u32x2*)(PU + (size_t)row * 3072 + 2048 + c0);
            const u32x2 os = *(const u32x2*)(PQ + (size_t)row * 1024 + c0);
            const float od[4] = {bflo(ou.x), bfhi(ou.x), bflo(ou.y), bfhi(ou.y)};
            const float sw[4] = {bflo(os.x), bfhi(os.x), bflo(os.y), bfhi(os.y)};
            float y[4];
#pragma unroll
            for (int j = 0; j < 4; ++j) y[j] = sigm(acc[m][1][j]) * (od[j] * rstd * gn[j]) * siluf(acc[m][0][j]) + sigm(acc[m][2][j]) * sw[j];
            u32x2 w; w.x = pack2(y[0], y[1]); w.y = pack2(y[2], y[3]);
            *(u32x2*)(Y + (size_t)row * 1024 + c0) = w;
        }
    }
};

struct CvtJob { const float* src; int ld; int K; int col0; int ncols; bf16_t* dst; int G; int which; int rowbase; };
DI int job_tiles(const CvtJob& j) { return ((j.ncols + 63) >> 6) * (j.K >> 6); }
DI void cvt_tile(const CvtJob& j, int t, char* lds) {
    float* tl = (float*)lds;
    const int tid = threadIdx.x;
    const int nkt = j.K >> 6, ct = t / nkt, kt = t % nkt, c0 = ct * 64, k0 = kt * 64;
    __syncthreads();
#pragma unroll
    for (int i = 0; i < 16; ++i) {
        const int kr = (tid >> 6) + 4 * i, col = tid & 63;
        tl[kr * 65 + col] = (c0 + col < j.ncols) ? j.src[(size_t)(k0 + kr) * j.ld + j.col0 + c0 + col] : 0.f;
    }
    __syncthreads();
#pragma unroll
    for (int i = 0; i < 2; ++i) {
        const int col = (tid >> 3) + 32 * i, ch = tid & 7, jc = c0 + col;
        if (jc < j.ncols) {
            const int drow = j.rowbase + (jc >> 4) * (j.G * 16) + j.which * 16 + (jc & 15);
            u32x4 w;
            w.x = pack2(tl[(ch * 8 + 0) * 65 + col], tl[(ch * 8 + 1) * 65 + col]);
            w.y = pack2(tl[(ch * 8 + 2) * 65 + col], tl[(ch * 8 + 3) * 65 + col]);
            w.z = pack2(tl[(ch * 8 + 4) * 65 + col], tl[(ch * 8 + 5) * 65 + col]);
            w.w = pack2(tl[(ch * 8 + 6) * 65 + col], tl[(ch * 8 + 7) * 65 + col]);
            *(u32x4*)(j.dst + (size_t)drow * j.K + k0 + ch * 8) = w;
        }
    }
}
DI CvtJob get_job(const Params& p, int id) {
    char* ws = p.ws; char* ob = (char*)p.out;
    bf16_t* W1GU = (bf16_t*)(ob + T_W1GU); bf16_t* W1D = (bf16_t*)(ob + T_W1D); bf16_t* WA = (bf16_t*)(ob + T_WA);
    bf16_t* WB = (bf16_t*)(ws + OFF_WB); bf16_t* WO = (bf16_t*)(ws + OFF_WO); bf16_t* WADA = (bf16_t*)(ws + OFF_C + C_WADA);
    bf16_t* W2GU = (bf16_t*)(ws + OFF_C + C_W2GU); bf16_t* W2D = (bf16_t*)(ws + OFF_C + C_W2D);
    switch (id) {
        case 0: return CvtJob{p.w1g, DFF, 1024, 0, DFF, W1GU, 2, 0, 0};
        case 1: return CvtJob{p.w1u, DFF, 1024, 0, DFF, W1GU, 2, 1, 0};
        case 2: return CvtJob{p.w1d, 1024, DFF, 0, 1024, W1D, 1, 0, 0};
        case 3: return CvtJob{p.w_in, 7696, 1024, 0, 3072, WA, 1, 0, 0};
        case 4: return CvtJob{p.w_in, 7696, 1024, 3072, 1024, WB, 3, 0, 0};
        case 5: return CvtJob{p.w_in, 7696, 1024, 4096, 16, WA, 1, 0, 4608};
        case 6: return CvtJob{p.w_in, 7696, 1024, 4112, 1024, WA, 1, 0, 3072};
        case 7: return CvtJob{p.w_in, 7696, 1024, 5136, 256, WA, 1, 0, 4096};
        case 8: return CvtJob{p.w_in, 7696, 1024, 5392, 256, WA, 1, 0, 4352};
        case 9: return CvtJob{p.w_in, 7696, 1024, 5648, 1024, WB, 3, 1, 0};
        case 10: return CvtJob{p.w_in, 7696, 1024, 6672, 1024, WB, 3, 2, 0};
        case 11: return CvtJob{p.w_out, 1024, 1024, 0, 1024, WO, 1, 0, 0};
        case 12: return CvtJob{p.w_ada, 9216, 1024, 0, 9216, WADA, 1, 0, 0};
        case 13: return CvtJob{p.w2g, DFF, 1024, 0, DFF, W2GU, 2, 0, 0};
        case 14: return CvtJob{p.w2u, DFF, 1024, 0, DFF, W2GU, 2, 1, 0};
        default: return CvtJob{p.w2d, 1024, DFF, 0, 1024, W2D, 1, 0, 0};
    }
}
template <int JLO, int JHI>
DI void cvt_jobs(const Params& p, char* lds) {
    int base = 0;
#pragma unroll
    for (int id = JLO; id < JHI; ++id) {
        const CvtJob j = get_job(p, id);
        const int nt = job_tiles(j);
        int first = ((int)blockIdx.x - base) % (int)gridDim.x; if (first < 0) first += gridDim.x;
        for (int t = first; t < nt; t += gridDim.x) cvt_tile(j, t, lds);
        base += nt;
    }
    __syncthreads();
}

DI void phase_prologue(const Params& p, char* lds) {
    cvt_jobs<0, 13>(p, lds);
    const int gtid = blockIdx.x * 256 + threadIdx.x, gsz = gridDim.x * 256;
    bf16_t* SC = (bf16_t*)(p.ws + OFF_SC);
    for (int i = gtid; i < 256 * 1024; i += gsz) {
        const int row = i >> 10, col = i & 1023;
        float v = 0.f;
        if (row < 4) v = siluf(p.c_p[row * 1024 + col]); else if (row < 132) v = siluf(p.c_s[(row - 4) * 1024 + col]);
        SC[i] = (bf16_t)f2bf(v);
    }
    float* rope = (float*)(p.ws + OFF_ROPE);
    for (int i = gtid; i < 4100 * 8; i += gsz) {
        const int pi = i >> 3, k = i & 7;
        const float pos = (float)(pi < 4096 ? pi : 8192 + (pi - 4096));
        const float invf = (float)exp(-(double)k * 0.125 * log(500000.0));
        const float ang = pos * invf;
        rope[pi * 16 + k] = (float)cos((double)ang);
        rope[pi * 16 + 8 + k] = (float)sin((double)ang);
    }
}

DI void norm_phase(const Params& p, bool x_from_input, const bf16_t* f, int gate_i, float gcoef, const float* post,
                   bool write_x, const float* pre, int sh_i, int sc_i) {
    const int lane = threadIdx.x & 63, wid = threadIdx.x >> 6;
    const float* MOD = (const float*)(p.ws + OFF_MOD);
    bf16_t* H = (bf16_t*)(p.ws + OFF_H);
    for (int row = blockIdx.x * 4 + wid; row < MALL; row += gridDim.x * 4) {
        const int cidx = row < MP ? (row >> 12) : 4 + ((row - MP) >> 2);
        const float* mrow = MOD + (size_t)cidx * 9216;
        const float* xr = x_from_input ? (row < MP ? p.x_p + (size_t)row * 1024 : p.x_s + (size_t)(row - MP) * 1024) : p.out + (size_t)row * 1024;
        f32x4 x[4];
#pragma unroll
        for (int i = 0; i < 4; ++i) x[i] = *(const f32x4*)(xr + lane * 4 + 256 * i);
        if (f) {
            f32x4 fv[4]; float ss = 0.f;
#pragma unroll
            for (int i = 0; i < 4; ++i) { const u32x2 fw = *(const u32x2*)(f + (size_t)row * 1024 + lane * 4 + 256 * i);
                fv[i] = (f32x4){bflo(fw.x), bfhi(fw.x), bflo(fw.y), bfhi(fw.y)}; ss += fv[i][0] * fv[i][0] + fv[i][1] * fv[i][1] + fv[i][2] * fv[i][2] + fv[i][3] * fv[i][3]; }
#pragma unroll
            for (int o = 32; o > 0; o >>= 1) ss += __shfl_xor(ss, o);
            const float rstd = rsqrtf(ss * (1.f / 1024.f) + EPSF);
#pragma unroll
            for (int i = 0; i < 4; ++i) {
                const int col = lane * 4 + 256 * i;
                const f32x4 g = *(const f32x4*)(mrow + gate_i * 1024 + col), pg = *(const f32x4*)(post + col);
#pragma unroll
                for (int j = 0; j < 4; ++j) x[i][j] += gcoef * g[j] * (fv[i][j] * rstd * pg[j]);
            }
        }
        if (write_x) {
#pragma unroll
            for (int i = 0; i < 4; ++i) *(f32x4*)(p.out + (size_t)row * 1024 + lane * 4 + 256 * i) = x[i];
        }
        if (pre) {
            float ss = 0.f;
#pragma unroll
            for (int i = 0; i < 4; ++i) ss += x[i][0] * x[i][0] + x[i][1] * x[i][1] + x[i][2] * x[i][2] + x[i][3] * x[i][3];
#pragma unroll
            for (int o = 32; o > 0; o >>= 1) ss += __shfl_xor(ss, o);
            const float rstd = rsqrtf(ss * (1.f / 1024.f) + EPSF);
#pragma unroll
            for (int i = 0; i < 4; ++i) {
                const int col = lane * 4 + 256 * i;
                const f32x4 pg = *(const f32x4*)(pre + col), sh = *(const f32x4*)(mrow + sh_i * 1024 + col), sc = *(const f32x4*)(mrow + sc_i * 1024 + col);
                float h[4];
#pragma unroll
                for (int j = 0; j < 4; ++j) h[j] = x[i][j] * rstd * pg[j] * (1.f + sc[j]) + sh[j];
                u32x2 w; w.x = pack2(h[0], h[1]); w.y = pack2(h[2], h[3]);
                *(u32x2*)(H + (size_t)row * 1024 + col) = w;
            }
        }
    }
}

DI void phase_mixprep(const Params& p, char* lds) {
    char* C = p.ws + OFF_C;
    const bf16_t* PKV = (const bf16_t*)(C + C_PKV);
    bf16_t* KCS = (bf16_t*)(C + C_KCS); bf16_t* VTP = (bf16_t*)(C + C_VTP); bf16_t* VTS = (bf16_t*)(C + C_VTS);
    float* SSQ = (float*)(C + C_SSQ);
    const int tid = threadIdx.x, gtid = blockIdx.x * 256 + tid, gsz = gridDim.x * 256;
    bf16_t* tl = (bf16_t*)lds;
    for (int t = blockIdx.x; t < 1024; t += gridDim.x) {
        const int b = t >> 8, cb = (t >> 6) & 3, tb = t & 63;
        __syncthreads();
#pragma unroll
        for (int i = 0; i < 16; ++i) { const int tr = (tid >> 6) + 4 * i, col = tid & 63; tl[tr * 66 + col] = PKV[(size_t)(b * 4096 + tb * 64 + tr) * 512 + 256 + cb * 64 + col]; }
        __syncthreads();
#pragma unroll
        for (int i = 0; i < 2; ++i) {
            const int col = (tid >> 3) + 32 * i, ch = tid & 7;
            u32x4 w;
            w.x = tl[(ch * 8 + 0) * 66 + col] | ((unsigned)tl[(ch * 8 + 1) * 66 + col] << 16);
            w.y = tl[(ch * 8 + 2) * 66 + col] | ((unsigned)tl[(ch * 8 + 3) * 66 + col] << 16);
            w.z = tl[(ch * 8 + 4) * 66 + col] | ((unsigned)tl[(ch * 8 + 5) * 66 + col] << 16);
            w.w = tl[(ch * 8 + 6) * 66 + col] | ((unsigned)tl[(ch * 8 + 7) * 66 + col] << 16);
            *(u32x4*)(VTP + (size_t)(b * 256 + cb * 64 + col) * 4096 + tb * 64 + ch * 8) = w;
        }
    }
    for (int t = blockIdx.x; t < 512; t += gridDim.x) {
        const int seq = t >> 2, cb = t & 3;
        __syncthreads();
        for (int i = tid; i < 160 * 64; i += 256) {
            const int s = i >> 6, col = i & 63;
            unsigned v = 0;
            if (s < 128) v = f2bf(p.cache_v[(size_t)(seq * 128 + s) * 256 + cb * 64 + col]);
            else if (s < 132) v = PKV[(size_t)(MP + seq * 4 + s - 128) * 512 + 256 + cb * 64 + col];
            tl[s * 66 + col] = (bf16_t)v;
        }
        __syncthreads();
        for (int i = tid; i < 64 * 20; i += 256) {
            const int col = i / 20, ch = i % 20;
            u32x4 w;
            w.x = tl[(ch * 8 + 0) * 66 + col] | ((unsigned)tl[(ch * 8 + 1) * 66 + col] << 16);
            w.y = tl[(ch * 8 + 2) * 66 + col] | ((unsigned)tl[(ch * 8 + 3) * 66 + col] << 16);
            w.z = tl[(ch * 8 + 4) * 66 + col] | ((unsigned)tl[(ch * 8 + 5) * 66 + col] << 16);
            w.w = tl[(ch * 8 + 6) * 66 + col] | ((unsigned)tl[(ch * 8 + 7) * 66 + col] << 16);
            *(u32x4*)(VTS + (size_t)(seq * 256 + cb * 64 + col) * 160 + ch * 8) = w;
        }
    }
    __syncthreads();
    for (int i = gtid; i < 128 * 144 * 32; i += gsz) {
        const int ch = i & 31, slot = (i >> 5) % 144, seq = (i >> 5) / 144;
        u32x4 w = (u32x4){0u, 0u, 0u, 0u};
        if (slot < 128) {
            const float* s = p.cache_k + (size_t)(seq * 128 + slot) * 256 + ch * 8;
            const f32x4 a = *(const f32x4*)s, b = *(const f32x4*)(s + 4);
            w.x = pack2(a[0], a[1]); w.y = pack2(a[2], a[3]); w.z = pack2(b[0], b[1]); w.w = pack2(b[2], b[3]);
        } else if (slot < 132) w = *(const u32x4*)(PKV + (size_t)(MP + seq * 4 + slot - 128) * 512 + ch * 8);
        *(u32x4*)(KCS + (size_t)i * 8) = w;
    }
}

DI void prep_item(const Params& p, int item, char* lds) {
    char* C = p.ws + OFF_C;
    bf16_t* PU = (bf16_t*)(C + C_PU);
    const float* PBA = (const float*)(C + C_PBA);
    bf16_t* KDT = (bf16_t*)(C + C_KDT); bf16_t* ACH = (bf16_t*)(C + C_ACH); float* GAM = (float*)(C + C_GAM);
    const bf16_t* HALO = (const bf16_t*)(C + C_HALO);
    bf16_t* UP = (bf16_t*)((char*)p.out + T_UP);
    int tid = threadIdx.x; asm volatile("" : "+v"(tid));
    const int lane = tid & 63, wid = tid >> 6, fr = lane & 15, fq = lane >> 4;
    const int b = item >> 9, n = (item >> 3) & 63, h = item & 7;
    const int r0 = b * 4096 + n * 64;
    char* Qt = lds; char* Kt = lds + 16384;
    float* Ls = (float*)(lds + 32768);
    float* gc = (float*)(lds + 50176); float* be = gc + 64; float* eg = be + 64;
    const bf16_t* halo = HALO + (size_t)(b * 64 + n) * 3 * 3072;
    __syncthreads();
    {
        const int slot = tid >> 4, l16 = tid & 15, which = slot & 1, rsub = slot >> 1;
        const int cbase = which * 1024 + h * 128 + l16 * 8;
        float w[4][8];
#pragma unroll
        for (int t = 0; t < 4; ++t) {
            const f32x4 a = *(const f32x4*)(p.conv_w + t * 3072 + cbase), bb = *(const f32x4*)(p.conv_w + t * 3072 + cbase + 4);
#pragma unroll
            for (int e = 0; e < 4; ++e) { w[t][e] = a[e]; w[t][4 + e] = bb[e]; }
        }
        const float qs = which == 0 ? 0.08838834764831845f : 1.f;
        for (int ps = 0; ps < 8; ++ps) {
            const int i = ps * 8 + rsub;
            float y[8];
#pragma unroll
            for (int e = 0; e < 8; ++e) y[e] = 0.f;
#pragma unroll
            for (int t = 0; t < 4; ++t) {
                const int tr = i - 3 + t;
                const bf16_t* src = tr < 0 ? halo + (3 + tr) * 3072 + cbase : PU + (size_t)(r0 + tr) * 3072 + cbase;
                u32x4 v = *(const u32x4*)src;
                if (tr < 0 && n == 0) v = (u32x4){0u, 0u, 0u, 0u};
                y[0] += w[t][0] * bflo(v.x); y[1] += w[t][1] * bfhi(v.x); y[2] += w[t][2] * bflo(v.y); y[3] += w[t][3] * bfhi(v.y);
                y[4] += w[t][4] * bflo(v.z); y[5] += w[t][5] * bfhi(v.z); y[6] += w[t][6] * bflo(v.w); y[7] += w[t][7] * bfhi(v.w);
            }
            float ss = 0.f;
#pragma unroll
            for (int e = 0; e < 8; ++e) { y[e] = siluf(y[e]); ss += y[e] * y[e]; }
            ss += __shfl_xor(ss, 1); ss += __shfl_xor(ss, 2); ss += __shfl_xor(ss, 4); ss += __shfl_xor(ss, 8);
            const float sc = rsqrtf(ss + EPSF) * qs;
            u32x4 o; o.x = pack2(y[0] * sc, y[1] * sc); o.y = pack2(y[2] * sc, y[3] * sc); o.z = pack2(y[4] * sc, y[5] * sc); o.w = pack2(y[6] * sc, y[7] * sc);
            *(u32x4*)((which ? Kt : Qt) + i * 256 + ((l16 ^ (i & 15)) << 4)) = o;
        }
    }
    if (wid == 0) {
        const float braw = PBA[(size_t)(r0 + lane) * 16 + h], araw = PBA[(size_t)(r0 + lane) * 16 + 8 + h];
        float g = -__expf(p.a_log[h]) * softplusf(araw + p.dt_bias[h]);
#pragma unroll
        for (int o = 1; o < 64; o <<= 1) { const float t = __shfl_up(g, o); if (lane >= o) g += t; }
        gc[lane] = g; be[lane] = sigm(braw); eg[lane] = __expf(g);
    }
    __syncthreads();
    {
        f32x4 ak[4], aq[4];
#pragma unroll
        for (int nj = 0; nj < 4; ++nj) { ak[nj] = (f32x4){0.f, 0.f, 0.f, 0.f}; aq[nj] = ak[nj]; }
#pragma unroll
        for (int ks = 0; ks < 4; ++ks) {
            const int ri = wid * 16 + fr, ch = ks * 4 + fq;
            const bf16x8 fk = *(const bf16x8*)(Kt + ri * 256 + ((ch ^ (ri & 15)) << 4));
            const bf16x8 fqq = *(const bf16x8*)(Qt + ri * 256 + ((ch ^ (ri & 15)) << 4));
#pragma unroll
            for (int nj = 0; nj < 4; ++nj) {
                const int rj = nj * 16 + fr;
                const bf16x8 fb = *(const bf16x8*)(Kt + rj * 256 + ((ch ^ (rj & 15)) << 4));
                ak[nj] = MFMA16(fk, fb, ak[nj]);
                aq[nj] = MFMA16(fqq, fb, aq[nj]);
            }
        }
#pragma unroll
        for (int nj = 0; nj < 4; ++nj)
#pragma unroll
            for (int jj = 0; jj < 4; ++jj) {
                const int i = wid * 16 + 4 * fq + jj, j = nj * 16 + fr;
                const float dec = __expf(fminf(gc[i] - gc[j], 0.f));
                Ls[i * 68 + j] = i > j ? be[i] * ak[nj][jj] * dec : 0.f;
                ACH[(size_t)item * 4096 + i * 64 + j] = (bf16_t)f2bf(i >= j ? aq[nj][jj] * dec : 0.f);
            }
    }
    __syncthreads();
    asm volatile("" : "+v"(tid));
    float x[64];
    if (tid < 128) {
        const int cv = 2048 + h * 128 + tid;
        const float w0 = p.conv_w[cv], w1 = p.conv_w[3072 + cv], w2 = p.conv_w[2 * 3072 + cv], w3 = p.conv_w[3 * 3072 + cv];
        float xm3 = bf2f(halo[cv]), xm2 = bf2f(halo[3072 + cv]), xm1 = bf2f(halo[2 * 3072 + cv]);
        if (n == 0) { xm3 = 0.f; xm2 = 0.f; xm1 = 0.f; }
#pragma unroll
        for (int i = 0; i < 64; ++i) {
            const float xi = bf2f(PU[(size_t)(r0 + i) * 3072 + cv]);
            x[i] = siluf(w0 * xm3 + w1 * xm2 + w2 * xm1 + w3 * xi) * be[i];
            xm3 = xm2; xm2 = xm1; xm1 = xi;
            if ((i & 15) == 15) __builtin_amdgcn_sched_barrier(0);
        }
    } else {
        const int ck = tid - 128;
#pragma unroll
        for (int i = 0; i < 64; ++i) {
            const bf16_t kv = *(const bf16_t*)(Kt + i * 256 + (((ck >> 3) ^ (i & 15)) << 4) + (ck & 7) * 2);
            x[i] = bf2f(kv) * be[i] * eg[i];
            if ((i & 15) == 15) __builtin_amdgcn_sched_barrier(0);
        }
    }
#pragma unroll
    for (int i = 1; i < 64; ++i) {
        float a = x[i];
#pragma unroll
        for (int j4 = 0; j4 < (i + 3) / 4; ++j4) {
            const f32x4 l = *(const f32x4*)(Ls + i * 68 + j4 * 4);
            a -= l[0] * x[j4 * 4];
            if (j4 * 4 + 1 < i) a -= l[1] * x[j4 * 4 + 1];
            if (j4 * 4 + 2 < i) a -= l[2] * x[j4 * 4 + 2];
            if (j4 * 4 + 3 < i) a -= l[3] * x[j4 * 4 + 3];
        }
        x[i] = a;
        __builtin_amdgcn_sched_barrier(0);
    }
    __syncthreads();
    asm volatile("" : "+v"(tid));
    if (tid < 128) {
        const int sl = tid >> 4, f16 = tid & 15;
#pragma unroll
        for (int q4 = 0; q4 < 4; ++q4) {
            bf16_t* dst = UP + (((size_t)item * 8 + sl) * 64 + q4 * 16 + f16) * 16;
            u32x4 a, bq;
            a.x = pack2(x[0 + 4 * q4 + 0], x[0 + 4 * q4 + 1]); a.y = pack2(x[0 + 4 * q4 + 2], x[0 + 4 * q4 + 3]);
            a.z = pack2(x[16 + 4 * q4 + 0], x[16 + 4 * q4 + 1]); a.w = pack2(x[16 + 4 * q4 + 2], x[16 + 4 * q4 + 3]);
            bq.x = pack2(x[32 + 4 * q4 + 0], x[32 + 4 * q4 + 1]); bq.y = pack2(x[32 + 4 * q4 + 2], x[32 + 4 * q4 + 3]);
            bq.z = pack2(x[48 + 4 * q4 + 0], x[48 + 4 * q4 + 1]); bq.w = pack2(x[48 + 4 * q4 + 2], x[48 + 4 * q4 + 3]);
            *(u32x4*)dst = a; *(u32x4*)(dst + 8) = bq;
        }
    } else {
        const unsigned off = (unsigned)r0 * 3072u + 1024u + h * 128u + (tid - 128);
#pragma unroll
        for (int i = 0; i < 64; ++i) PU[off + (unsigned)i * 3072u] = (bf16_t)f2bf(x[i]);
    }
    {
        const int i = tid >> 2, part = tid & 3;
        const float e = eg[i];
#pragma unroll
        for (int c4 = 0; c4 < 4; ++c4) {
            const int ch = part * 4 + c4;
            const u32x4 v = *(const u32x4*)(Qt + i * 256 + ((ch ^ (i & 15)) << 4));
            u32x4 o;
            o.x = pack2(bflo(v.x) * e, bfhi(v.x) * e); o.y = pack2(bflo(v.y) * e, bfhi(v.y) * e);
            o.z = pack2(bflo(v.z) * e, bfhi(v.z) * e); o.w = pack2(bflo(v.w) * e, bfhi(v.w) * e);
            *(u32x4*)(PU + (size_t)(r0 + i) * 3072 + h * 128 + ch * 8) = o;
        }
    }
    {
        const int dk = tid & 127, ih = tid >> 7;
        const float gl = gc[63];
#pragma unroll
        for (int c4 = 0; c4 < 4; ++c4) {
            float v[8];
#pragma unroll
            for (int e = 0; e < 8; ++e) {
                const int i = ih * 32 + c4 * 8 + e;
                const bf16_t kv = *(const bf16_t*)(Kt + i * 256 + (((dk >> 3) ^ (i & 15)) << 4) + (dk & 7) * 2);
                v[e] = bf2f(kv) * __expf(gl - gc[i]);
            }
            u32x4 o; o.x = pack2(v[0], v[1]); o.y = pack2(v[2], v[3]); o.z = pack2(v[4], v[5]); o.w = pack2(v[6], v[7]);
            *(u32x4*)(KDT + ((size_t)item * 128 + dk) * 64 + ih * 32 + c4 * 8) = o;
        }
        if (tid == 0) GAM[item] = __expf(gl);
    }
}

DI bf16x8 frag_perm(const char* base, int rowbytes, int row, int c0, int fq) {
    const char* q = base + row * rowbytes + (c0 + 4 * fq) * 2;
    const s16x4 lo = *(const s16x4*)q, hi = *(const s16x4*)(q + 32);
    return cat4(lo, hi);
}
#define LDS_BARRIER() do { asm volatile("s_waitcnt lgkmcnt(0)" ::: "memory"); __builtin_amdgcn_s_barrier(); asm volatile("" ::: "memory"); } while (0)
DI void scan_block(const Params& p, int blk, char* lds) {
    char* C = p.ws + OFF_C;
    bf16_t* PU = (bf16_t*)(C + C_PU);
    const bf16_t* KDT = (const bf16_t*)(C + C_KDT); const bf16_t* ACH = (const bf16_t*)(C + C_ACH); const float* GAM = (const float*)(C + C_GAM);
    float* SSQ = (float*)(C + C_SSQ);
    const bf16_t* UP = (const bf16_t*)((const char*)p.out + T_UP);
    const int tid = threadIdx.x, lane = tid & 63, wid = tid >> 6, fr = lane & 15, fq = lane >> 4;
    const int bh = blk & 31, half = blk >> 5, b = bh >> 3, h = bh & 7;
    const int dvb = half * 64 + wid * 16;
    char* Wt = lds; char* Qt = lds + 17408; char* At = lds + 34816; char* Kd = lds + 43520;
    f32x4 S[8];
#pragma unroll
    for (int t = 0; t < 8; ++t) S[t] = (f32x4){0.f, 0.f, 0.f, 0.f};
    u32x4 rW[4], rQ[4], rA[2], rK[4];
    u32x4 rU[2];
    float gam;
#define SCAN_LOAD(nn) do { \
        int tid = threadIdx.x; asm volatile("" : "+v"(tid)); const int lane = tid & 63, wid = tid >> 6; \
        const int r0n_ = b * 4096 + (nn) * 64; const size_t it_ = (size_t)((b * 64 + (nn)) * 8 + h); \
        _Pragma("unroll") for (int i = 0; i < 4; ++i) { const int id = tid + 256 * i, row = id >> 4, ch = id & 15; \
            rW[i] = *(const u32x4*)(PU + (size_t)(r0n_ + row) * 3072 + 1024 + h * 128 + ch * 8); \
            rQ[i] = *(const u32x4*)(PU + (size_t)(r0n_ + row) * 3072 + h * 128 + ch * 8); } \
        _Pragma("unroll") for (int i = 0; i < 2; ++i) { const int id = tid + 256 * i; rA[i] = *(const u32x4*)(ACH + it_ * 4096 + (size_t)id * 8); } \
        _Pragma("unroll") for (int i = 0; i < 4; ++i) { const int id = tid + 256 * i; rK[i] = *(const u32x4*)(KDT + it_ * 8192 + (size_t)id * 8); } \
        { const bf16_t* up_ = UP + ((it_ * 8 + half * 4 + wid) * 64 + lane) * 16; rU[0] = *(const u32x4*)up_; rU[1] = *(const u32x4*)(up_ + 8); } \
        gam = GAM[it_]; } while (0)
    SCAN_LOAD(0);
    __syncthreads();
    for (int n = 0; n < 64; ++n) {
        const int r0 = b * 4096 + n * 64;
        int tid = threadIdx.x; asm volatile("" : "+v"(tid));
#pragma unroll
        for (int i = 0; i < 4; ++i) { const int id = tid + 256 * i, row = id >> 4, ch = id & 15;
            *(u32x4*)(Wt + row * 272 + ch * 16) = rW[i]; *(u32x4*)(Qt + row * 272 + ch * 16) = rQ[i]; }
#pragma unroll
        for (int i = 0; i < 2; ++i) { const int id = tid + 256 * i, row = id >> 3, ch = id & 7; char* q = At + row * 136 + ch * 16;
            *(u32x2*)q = (u32x2){rA[i].x, rA[i].y}; *(u32x2*)(q + 8) = (u32x2){rA[i].z, rA[i].w}; }
#pragma unroll
        for (int i = 0; i < 4; ++i) { const int id = tid + 256 * i, row = id >> 3, ch = id & 7; char* q = Kd + row * 136 + ch * 16;
            *(u32x2*)q = (u32x2){rK[i].x, rK[i].y}; *(u32x2*)(q + 8) = (u32x2){rK[i].z, rK[i].w}; }
        float uc[16];
#pragma unroll
        for (int i = 0; i < 8; ++i) { const unsigned w = i < 4 ? rU[0][i] : rU[1][i - 4]; uc[2 * i] = bflo(w); uc[2 * i + 1] = bfhi(w); }
        const float gcur = gam;
        LDS_BARRIER();
        if (n + 1 < 64) SCAN_LOAD(n + 1);
        bf16x8 Sb[4];
#pragma unroll
        for (int ks = 0; ks < 4; ++ks) Sb[ks] = pack8(S[2 * ks], S[2 * ks + 1]);
        f32x4 aw[4], ao[4];
#pragma unroll
        for (int m = 0; m < 4; ++m) { aw[m] = (f32x4){0.f, 0.f, 0.f, 0.f}; ao[m] = aw[m]; }
#pragma unroll
        for (int ks = 0; ks < 4; ++ks)
#pragma unroll
            for (int m = 0; m < 4; ++m) aw[m] = MFMA16(frag_perm(Wt, 272, 16 * m + fr, 32 * ks, fq), Sb[ks], aw[m]);
#pragma unroll
        for (int ks = 0; ks < 4; ++ks)
#pragma unroll
            for (int m = 0; m < 4; ++m) ao[m] = MFMA16(frag_perm(Qt, 272, 16 * m + fr, 32 * ks, fq), Sb[ks], ao[m]);
        f32x4 vn[4];
#pragma unroll
        for (int m = 0; m < 4; ++m)
#pragma unroll
            for (int jj = 0; jj < 4; ++jj) vn[m][jj] = uc[m * 4 + jj] - aw[m][jj];
        bf16x8 Vb[2];
        Vb[0] = pack8(vn[0], vn[1]); Vb[1] = pack8(vn[2], vn[3]);
#pragma unroll
        for (int t = 0; t < 8; ++t) S[t] = S[t] * gcur;
#pragma unroll
        for (int k2 = 0; k2 < 2; ++k2) {
#pragma unroll
            for (int m = 2 * k2; m < 4; ++m) ao[m] = MFMA16(frag_perm(At, 136, 16 * m + fr, 32 * k2, fq), Vb[k2], ao[m]);
#pragma unroll
            for (int t = 0; t < 8; ++t) S[t] = MFMA16(frag_perm(Kd, 136, 16 * t + fr, 32 * k2, fq), Vb[k2], S[t]);
        }
#pragma unroll
        for (int m = 0; m < 4; ++m)
#pragma unroll
            for (int j2 = 0; j2 < 2; ++j2) {
                const unsigned w = pack2(ao[m][2 * j2], ao[m][2 * j2 + 1]);
                const unsigned ob = (unsigned)(r0 + 4 * fq) * 3072u + 2048u + h * 128u + dvb + fr + (unsigned)(16 * m + 2 * j2) * 3072u;
                PU[ob] = (bf16_t)(w & 0xffffu); PU[ob + 3072u] = (bf16_t)(w >> 16);
            }
        LDS_BARRIER();
    }
#undef SCAN_LOAD
#pragma unroll
    for (int t = 0; t < 8; ++t)
#pragma unroll
        for (int jj = 0; jj < 4; ++jj)
            p.out[O_DELTAP + ((size_t)(b * 8 + h) * 128 + 16 * t + 4 * fq + jj) * 128 + dvb + fr] = S[t][jj];
}

DI void sdelta_item(const Params& p, int item, char* lds) {
    char* C = p.ws + OFF_C;
    bf16_t* PU = (bf16_t*)(C + C_PU);
    const float* PBA = (const float*)(C + C_PBA);
    float* SSQ = (float*)(C + C_SSQ);
    const int tid = threadIdx.x, lane = tid & 63, wid = tid >> 6;
    const int seq = item >> 3, h = item & 7, rs = MP + seq * 4;
    float* qs = (float*)lds;
    float* ks = qs + 512; float* vs = ks + 512;
    float* red = vs + 512;
    float* bt = red + 16; float* al = bt + 4;
    float* kSp = al + 4;
    float* op = kSp + 1024;
    const int ch = tid & 127, part = tid >> 7;
    __syncthreads();
    float yq[4];
    {
        const int nch = part == 0 ? 2 : 1;
        for (int cc = 0; cc < nch; ++cc) {
            const int c = part == 1 ? 1024 + h * 128 + ch : (cc == 0 ? h * 128 + ch : 2048 + h * 128 + ch);
            float full[7];
#pragma unroll
            for (int i = 0; i < 3; ++i) full[i] = p.st_conv[(size_t)(seq * 3 + i) * 3072 + c];
#pragma unroll
            for (int i = 0; i < 4; ++i) full[3 + i] = bf2f(PU[(size_t)(rs + i) * 3072 + c]);
#pragma unroll
            for (int i = 0; i < 3; ++i) p.out[O_CONVS + (size_t)(seq * 3 + i) * 3072 + c] = full[4 + i];
            const float w0 = p.conv_w[c], w1 = p.conv_w[3072 + c], w2 = p.conv_w[2 * 3072 + c], w3 = p.conv_w[3 * 3072 + c];
            float y[4];
#pragma unroll
            for (int t = 0; t < 4; ++t) y[t] = siluf(w0 * full[t] + w1 * full[t + 1] + w2 * full[t + 2] + w3 * full[t + 3]);
            if (part == 0 && cc == 1) {
#pragma unroll
                for (int t = 0; t < 4; ++t) vs[t * 128 + ch] = y[t];
            } else {
#pragma unroll
                for (int t = 0; t < 4; ++t) yq[t] = y[t];
            }
        }
    }
#pragma unroll
    for (int t = 0; t < 4; ++t) {
        float s = yq[t] * yq[t];
#pragma unroll
        for (int o = 32; o > 0; o >>= 1) s += __shfl_xor(s, o);
        if (lane == 0) red[wid * 4 + t] = s;
    }
    if (tid < 4) {
        const float braw = PBA[(size_t)(rs + tid) * 16 + h], araw = PBA[(size_t)(rs + tid) * 16 + 8 + h];
        bt[tid] = sigm(braw);
        al[tid] = __expf(-__expf(p.a_log[h]) * softplusf(araw + p.dt_bias[h]));
    }
    __syncthreads();
#pragma unroll
    for (int t = 0; t < 4; ++t) {
        const float tot = red[(2 * part) * 4 + t] + red[(2 * part + 1) * 4 + t];
        const float sc = rsqrtf(tot + EPSF) * (part == 0 ? 0.08838834764831845f : 1.f);
        (part == 0 ? qs : ks)[t * 128 + ch] = yq[t] * sc;
    }
    __syncthreads();
    const int dv = ch, dk0 = part * 64;
    float S[64];
    const float* s0 = p.st_delta + ((size_t)(seq * 8 + h) * 128 + dk0) * 128 + dv;
#pragma unroll
    for (int i = 0; i < 64; ++i) S[i] = s0[(size_t)i * 128];
#pragma unroll
    for (int t = 0; t < 4; ++t) {
        float pk = 0.f;
#pragma unroll
        for (int i = 0; i < 64; ++i) pk += ks[t * 128 + dk0 + i] * S[i];
        kSp[(t * 2 + part) * 128 + dv] = pk;
        __syncthreads();
        const float kS = kSp[(t * 2) * 128 + dv] + kSp[(t * 2 + 1) * 128 + dv];
        const float a = al[t];
        const float vnew = bt[t] * (vs[t * 128 + dv] - a * kS);
        float po = 0.f;
#pragma unroll
        for (int i = 0; i < 64; ++i) { S[i] = a * S[i] + ks[t * 128 + dk0 + i] * vnew; po += qs[t * 128 + dk0 + i] * S[i]; }
        op[(t * 2 + part) * 128 + dv] = po;
        __syncthreads();
        if (part == 0) {
            const float o = op[(t * 2) * 128 + dv] + op[(t * 2 + 1) * 128 + dv];
            PU[(size_t)(rs + t) * 3072 + 2048 + h * 128 + dv] = (bf16_t)f2bf(o);
        }
    }
    float* so = p.out + O_DELTAS + ((size_t)(seq * 8 + h) * 128 + dk0) * 128 + dv;
#pragma unroll
    for (int i = 0; i < 64; ++i) so[(size_t)i * 128] = S[i];
}

DI void attn_block(const Params& p, int bt) {
    char* C = p.ws + OFF_C;
    bf16_t* PQ = (bf16_t*)(C + C_PQ);
    const bf16_t* PKV = (const bf16_t*)(C + C_PKV); const bf16_t* KCS = (const bf16_t*)(C + C_KCS);
    const bf16_t* VTP = (const bf16_t*)(C + C_VTP); const bf16_t* VTS = (const bf16_t*)(C + C_VTS);
    const int lane = threadIdx.x & 63, wid = threadIdx.x >> 6, fr = lane & 15, fq = lane >> 4;
    const bool isS = bt >= 4096;
    int b = 0, kvh, t0 = 0, seq = 0, head, qrow;
    if (!isS) { b = bt >> 10; kvh = (bt >> 8) & 3; t0 = (bt & 255) * 16; head = kvh * 4 + wid; qrow = b * 4096 + t0 + fr; }
    else { seq = bt - 4096; kvh = wid; head = kvh * 4 + (fr >> 2); qrow = MP + seq * 4 + (fr & 3); }
    bf16_t* qp = PQ + (size_t)qrow * 1024 + head * 64;
    const float sink = p.sinks[head];
    bf16x8 bq[2];
    bq[0] = *(const bf16x8*)(qp + fq * 8); bq[1] = *(const bf16x8*)(qp + 32 + fq * 8);
    f32x4 sc[10];
#pragma unroll
    for (int n = 0; n < 10; ++n) {
        const bf16_t* kp;
        if (!isS) { int t = t0 - 144 + 16 * n + fr; t = t < 0 ? 0 : t; kp = PKV + (size_t)(b * 4096 + t) * 512 + kvh * 64; }
        else { int s = 16 * n + fr; s = s > 143 ? 143 : s; kp = KCS + (size_t)(seq * 144 + s) * 256 + kvh * 64; }
        f32x4 a = (f32x4){0.f, 0.f, 0.f, 0.f};
        a = MFMA16(*(const bf16x8*)(kp + fq * 8), bq[0], a);
        a = MFMA16(*(const bf16x8*)(kp + 32 + fq * 8), bq[1], a);
        sc[n] = a;
    }
    float mx = sink;
#pragma unroll
    for (int n = 0; n < 10; ++n)
#pragma unroll
        for (int jj = 0; jj < 4; ++jj) {
            const int kidx = 16 * n + 4 * fq + jj;
            bool valid;
            if (!isS) { const int t = t0 - 144 + kidx, d = 144 + fr - kidx; valid = t >= 0 && d >= 0 && d <= 128; }
            else { const int d = (fr & 3) + 128 - kidx; valid = d >= 0 && d <= 128; }
            const float s = valid ? sc[n][jj] * 0.125f : -1e30f;
            sc[n][jj] = s; mx = fmaxf(mx, s);
        }
    mx = fmaxf(mx, __shfl_xor(mx, 16)); mx = fmaxf(mx, __shfl_xor(mx, 32));
    float sum = 0.f;
#pragma unroll
    for (int n = 0; n < 10; ++n)
#pragma unroll
        for (int jj = 0; jj < 4; ++jj) { const float e = __expf(sc[n][jj] - mx); sc[n][jj] = e; sum += e; }
    sum += __shfl_xor(sum, 16); sum += __shfl_xor(sum, 32);
    const float inv = 1.f / (sum + __expf(sink - mx));
    bf16x8 bP[5];
#pragma unroll
    for (int s5 = 0; s5 < 5; ++s5) bP[s5] = pack8(sc[2 * s5] * inv, sc[2 * s5 + 1] * inv);
#pragma unroll
    for (int ds = 0; ds < 4; ++ds) {
        const bf16_t* vrow = !isS ? VTP + (size_t)(b * 256 + kvh * 64 + 16 * ds + fr) * 4096 : VTS + (size_t)(seq * 256 + kvh * 64 + 16 * ds + fr) * 160;
        f32x4 a = (f32x4){0.f, 0.f, 0.f, 0.f};
#pragma unroll
        for (int s5 = 0; s5 < 5; ++s5) {
            int g0 = 32 * s5 + 4 * fq, g1 = g0 + 16;
            if (!isS) { g0 += t0 - 144; g1 += t0 - 144; g0 = g0 < 0 ? 0 : g0; g1 = g1 < 0 ? 0 : g1; }
            const s16x4 lo = *(const s16x4*)(vrow + g0), hi = *(const s16x4*)(vrow + g1);
            a = MFMA16(cat4(lo, hi), bP[s5], a);
        }
        u32x2 w; w.x = pack2(a[0], a[1]); w.y = pack2(a[2], a[3]);
        *(u32x2*)(qp + 16 * ds + 4 * fq) = w;
    }
}

DI void sample_window_out(const Params& p) {
    const bf16_t* PKV = (const bf16_t*)(p.ws + OFF_C + C_PKV);
    const int gt = blockIdx.x * 256 + threadIdx.x, gs = gridDim.x * 256;
    for (int i = gt; i < 128 * 128 * 512; i += gs) {
        const int c = i & 511, s = (i >> 9) & 127, seq = i >> 16;
        const int cc = c & 255; const bool isv = c >= 256;
        float v;
        if (s < 124) v = (isv ? p.cache_v : p.cache_k)[(size_t)(seq * 128 + s + 4) * 256 + cc];
        else v = bf2f(PKV[(size_t)(MP + seq * 4 + s - 124) * 512 + c]);
        p.out[(isv ? O_SWVS : O_SWKS) + (size_t)(seq * 128 + s) * 256 + cc] = v;
    }
}

DI void phase_mixer(const Params& p, char* lds) {
    const int nb = gridDim.x, blk = blockIdx.x;
    const int nscan = 64;
#ifndef MK_P9
#define MK_P9 7
#endif
    if (blk < nscan) { __builtin_amdgcn_s_setprio(3); if (MK_P9 & 1) scan_block(p, blk, lds); __builtin_amdgcn_s_setprio(0); return; }
    const int wb = blk - nscan, nw = nb - nscan;
    if (MK_P9 & 2) for (int it = wb; it < 1024; it += nw) sdelta_item(p, it, lds);
    if (MK_P9 & 4) for (int bt = wb; bt < 4224; bt += nw) attn_block(p, bt);
}

#define XB_TMO      128
#define XB_XCNT(j)  (256  + 64 * (j))
#define XB_XSUB(j)  (1280 + 64 * (j))
#define XB_XGEN(j)  (2304 + 64 * (j))
#define XB_TOP      3328
#define XB_TOPGEN   3392
#define XCD_BAR_WORDS 3456
#define XB_SPIN_CAP (1u << 22)
DI unsigned xb_ld(unsigned* p) { return __hip_atomic_load(p, __ATOMIC_RELAXED, __HIP_MEMORY_SCOPE_AGENT); }
DI unsigned xb_add(unsigned* p, unsigned v) { return __hip_atomic_fetch_add(p, v, __ATOMIC_RELAXED, __HIP_MEMORY_SCOPE_AGENT); }
DI unsigned xb_xcc_id() { return (unsigned)__builtin_amdgcn_s_getreg((3 << 11) | 20) & 0xFu; }
#define XB_SPIN(cond, bar) do { unsigned _sp = 0; while (cond) { __builtin_amdgcn_s_sleep(1); \
    if ((++_sp & 255u) == 0u) { if (xb_ld(&(bar)[XB_TMO])) break; if (_sp > XB_SPIN_CAP) { atomicAdd(&(bar)[XB_TMO], 1u); break; } } } } while (0)
struct XcdBarrier { unsigned* bar; unsigned x; unsigned nloc; unsigned nx; };
DI XcdBarrier xcd_barrier_post(unsigned* bar) {
    XcdBarrier b; b.bar = bar; b.x = xb_xcc_id(); b.nloc = 0u; b.nx = 0u;
    if (threadIdx.x == 0) (void)xb_add(&bar[XB_XCNT(b.x)], 1u);
    return b;
}
DI void xcd_barrier_complete(unsigned* bar, unsigned x, unsigned& nloc, unsigned& nx) {
    const unsigned G = gridDim.x * gridDim.y * gridDim.z;
    unsigned sum, cnt, mine, sp = 0u;
    for (;;) {
        sum = 0u; cnt = 0u; mine = 0u;
#pragma unroll
        for (unsigned j = 0; j < 16; ++j) { const unsigned c = xb_ld(&bar[XB_XCNT(j)]); sum += c; cnt += (c > 0u) ? 1u : 0u; mine = (j == x) ? c : mine; }
        if (sum == G) break;
        __builtin_amdgcn_s_sleep(1);
        if ((++sp & 255u) == 0u) { if (xb_ld(&bar[XB_TMO])) break; if (sp > XB_SPIN_CAP) { atomicAdd(&bar[XB_TMO], 1u); break; } }
    }
    nloc = mine > 0u ? mine : 1u; nx = cnt > 0u ? cnt : 1u;
}
DI void xcd_barrier(XcdBarrier& b) {
    asm volatile("s_waitcnt vmcnt(0)" ::: "memory");
    __syncthreads();
    if (threadIdx.x == 0) {
        unsigned* bar = b.bar;
        __builtin_amdgcn_s_waitcnt(0);
        unsigned nloc = b.nloc, nx = b.nx;
        if (nloc == 0u) { xcd_barrier_complete(bar, b.x, nloc, nx); b.nloc = nloc; b.nx = nx; }
        const unsigned old = xb_add(&bar[XB_XSUB(b.x)], 1u);
        const unsigned gen = old / nloc;
        if (old + 1u == (gen + 1u) * nloc) {
            __builtin_amdgcn_fence(__ATOMIC_RELEASE, "agent");
            asm volatile("s_waitcnt vmcnt(0)" ::: "memory");
            const unsigned og = xb_add(&bar[XB_TOP], 1u);
            const unsigned tg = og / nx;
            if (og + 1u == (tg + 1u) * nx) xb_add(&bar[XB_TOPGEN], 1u);
            else XB_SPIN(xb_ld(&bar[XB_TOPGEN]) == tg, bar);
            __builtin_amdgcn_fence(__ATOMIC_ACQUIRE, "agent");
            xb_add(&bar[XB_XGEN(b.x)], 1u);
            asm volatile("s_waitcnt vmcnt(0)" ::: "memory");
        } else {
            XB_SPIN(xb_ld(&bar[XB_XGEN(b.x)]) == gen, bar);
            __builtin_amdgcn_fence(__ATOMIC_ACQUIRE, "agent");
            asm volatile("s_waitcnt vmcnt(0)" ::: "memory");
        }
    }
    __syncthreads();
}
constexpr size_t OFF_BAR = 293921280;

template <bool COOP>
__global__ void __launch_bounds__(256, 2) mega(Params p) {
    __shared__ __attribute__((aligned(16))) char lds[65536];
    XcdBarrier xb;
    if (COOP) {
        xb = xcd_barrier_post((unsigned*)(p.ws + OFF_BAR));
        if (p.plo < 0) cg::this_grid().sync();
    }
    char* ws = p.ws; char* C = ws + OFF_C; char* ob = (char*)p.out;
    bf16_t* H = (bf16_t*)(ws + OFF_H);
    bf16_t* F = (bf16_t*)(C + C_F);
#define RUNPH(k, ...) do { if (PHON(k) && p.plo <= (k) && (k) < p.phi) { __VA_ARGS__ } \
        if (COOP && p.plo <= (k) && (k) + 1 < p.phi) { xcd_barrier(xb); } } while (0)
    RUNPH(0, phase_prologue(p, lds););
    RUNPH(1, EpiF32 e{(float*)(ws + OFF_MOD), 9216, p.b_ada}; gemm_phase<4>((const bf16_t*)(ws + OFF_SC), (const bf16_t*)(C + C_WADA), 1024, 2, 72, lds, e););
    RUNPH(2, norm_phase(p, true, nullptr, 0, 0.f, nullptr, false, p.n1pre, 0, 1););
    RUNPH(3, EpiSwiglu e{(bf16_t*)(C + C_ACT)}; gemm_phase<4>(H, (const bf16_t*)(ob + T_W1GU), 1024, 132, 43, lds, e););
    RUNPH(4, EpiBf16 e{F, 1024}; gemm_phase<4>((const bf16_t*)(C + C_ACT), (const bf16_t*)(ob + T_W1D), DFF, 132, 8, lds, e););
    RUNPH(5, norm_phase(p, true, F, 2, 0.5f, p.n1post, true, p.nmpre, 3, 4););
    RUNPH(6, EpiP e{(bf16_t*)(C + C_PU), (bf16_t*)(C + C_PQ), (bf16_t*)(C + C_PKV), (float*)(C + C_PBA), (const float*)(ws + OFF_ROPE), (bf16_t*)(C + C_HALO), p.out};
             gemm_phase<4>(H, (const bf16_t*)(ob + T_WA), 1024, 132, 37, lds, e););
    RUNPH(8, for (int it = blockIdx.x; it < 2048; it += gridDim.x) prep_item(p, it, lds); __syncthreads(); phase_mixprep(p, lds););
    RUNPH(9, phase_mixer(p, lds););
    RUNPH(10, sample_window_out(p); EpiMerge e{(const bf16_t*)(C + C_PU), (const bf16_t*)(C + C_PQ), p.dn_norm, (bf16_t*)(C + C_Y)};
              gemm_phase<3>(H, (const bf16_t*)(ws + OFF_WB), 1024, 132, 32, lds, e););
    RUNPH(11, EpiBf16 e{F, 1024}; gemm_phase<4>((const bf16_t*)(C + C_Y), (const bf16_t*)(ws + OFF_WO), 1024, 132, 8, lds, e););
    RUNPH(12, norm_phase(p, false, F, 5, 1.0f, p.nmpost, true, p.n2pre, 6, 7); cvt_jobs<13, 16>(p, lds););
    RUNPH(13, EpiSwiglu e{(bf16_t*)(C + C_ACT)}; gemm_phase<4>(H, (const bf16_t*)(C + C_W2GU), 1024, 132, 43, lds, e););
    RUNPH(14, EpiBf16 e{F, 1024}; gemm_phase<4>((const bf16_t*)(C + C_ACT), (const bf16_t*)(C + C_W2D), DFF, 132, 8, lds, e););
    RUNPH(15, norm_phase(p, false, F, 8, 0.5f, p.n2post, true, nullptr, 0, 0););
#undef RUNPH
}

constexpr int NPHASE = 16;

extern "C" void kernel_launch(void* const* d_in, const int* in_sizes, int n_in, void* d_out, int out_size, void* d_ws, size_t ws_size,
                              hipStream_t stream) {
    Params p{};
    const float** pp = (const float**)&p;
    for (int i = 0; i < 29; ++i) pp[i] = (const float*)d_in[i];
    p.out = (float*)d_out; p.ws = (char*)d_ws; p.plo = 0; p.phi = NPHASE;
#if MK_COOP
    static int grid_blocks = 0;
    if (!grid_blocks) {
        int dev = 0, cus = 0, per_cu = 0;
        (void)hipGetDevice(&dev);
        (void)hipDeviceGetAttribute(&cus, hipDeviceAttributeMultiprocessorCount, dev);
        (void)hipOccupancyMaxActiveBlocksPerMultiprocessor(&per_cu, mega<true>, 256, 0);
        if (per_cu > 2) per_cu = 2;
        grid_blocks = cus * per_cu;
    }
    void* args[] = {&p};
    (void)hipMemsetAsync((char*)d_ws + OFF_BAR, 0, XCD_BAR_WORDS * 4, stream);
    hipError_t e = hipLaunchCooperativeKernel((void*)mega<true>, dim3(grid_blocks), dim3(256), args, 0, stream);
    if (e != hipSuccess) fprintf(stderr, "cooperative launch failed: %s (grid %d)\n", hipGetErrorString(e), grid_blocks);
#else
    for (int ph = 0; ph < NPHASE; ++ph) {
        p.plo = ph; p.phi = ph + 1;
        hipLaunchKernelGGL(mega<false>, dim3(512), dim3(256), 0, stream, p);
    }
#endif
}
```

```cpp
#include <hip/hip_runtime.h>
#include <hip/hip_cooperative_groups.h>
#include <stdint.h>
#include <cstdio>
namespace cg = cooperative_groups;

#ifndef MK_COOP
#define MK_COOP 1
#endif
#ifndef MK_ONLY
#define MK_ONLY -1
#endif
#define PHON(k) (MK_ONLY < 0 || MK_ONLY == (k))

#define DI __device__ __forceinline__
typedef unsigned short bf16_t;
typedef short bf16x8 __attribute__((ext_vector_type(8)));
typedef short s16x4 __attribute__((ext_vector_type(4)));
typedef float f32x4 __attribute__((ext_vector_type(4)));
typedef unsigned u32x4 __attribute__((ext_vector_type(4)));
typedef unsigned u32x2 __attribute__((ext_vector_type(2)));
#define LAS __attribute__((address_space(3)))
#define MFMA16(a, b, c) __builtin_amdgcn_mfma_f32_16x16x32_bf16((a), (b), (c), 0, 0, 0)

constexpr int MP = 16384, MALL = 16896, DM = 1024, DFF = 2752;
constexpr float EPSF = 1e-6f;
constexpr size_t OFF_MOD = 0;
constexpr size_t OFF_H = 9437184;
constexpr size_t OFF_WB = 44040192;
constexpr size_t OFF_WO = 50331648;
constexpr size_t OFF_SC = 52428800;
constexpr size_t OFF_ROPE = 52953088;
constexpr size_t OFF_C = 53215744;
constexpr size_t C_F = 0;
constexpr size_t C_ACT = 69206016;
constexpr size_t C_WADA = 0;
constexpr size_t C_PU = 0;
constexpr size_t C_KDT = 103809024;
constexpr size_t C_ACH = 137363456;
constexpr size_t C_PQ = 154140672;
constexpr size_t C_PKV = 188743680;
constexpr size_t C_KCS = 206045184;
constexpr size_t C_VTP = 215482368;
constexpr size_t C_VTS = 223870976;
constexpr size_t C_PBA = 234356736;
constexpr size_t C_SSQ = 235438080;
constexpr size_t C_GAM = 235978752;
constexpr size_t C_Y = C_KDT;
constexpr size_t C_W2GU = 166723584;
constexpr size_t C_W2D = 177995776;
constexpr size_t O_Y = 0, O_SWKP = 17301504, O_SWVP = 17432576, O_CONVP = 17563648, O_DELTAP = 17600512,
                 O_SWKS = 18124800, O_SWVS = 22319104, O_CONVS = 26513408, O_DELTAS = 27693056;
constexpr size_t T_W1GU = O_SWKS * 4;
constexpr size_t T_W1D = T_W1GU + 11272192;
constexpr size_t T_WA = T_W1D + 5636096;
constexpr size_t T_UP = O_SWKS * 4;
constexpr size_t C_HALO = 235986944;

struct Params {
    const float* x_p; const float* x_s; const float* cache_k; const float* cache_v; const float* st_conv; const float* st_delta;
    const float* c_p; const float* c_s; const float* w_ada; const float* b_ada;
    const float* n1pre; const float* n1post; const float* w1g; const float* w1u; const float* w1d;
    const float* nmpre; const float* nmpost; const float* w_in; const float* conv_w; const float* a_log; const float* dt_bias;
    const float* dn_norm; const float* sinks; const float* w_out;
    const float* n2pre; const float* n2post; const float* w2g; const float* w2u; const float* w2d;
    float* out; char* ws; int plo; int phi;
};

typedef __bf16 bf16v2_t __attribute__((ext_vector_type(2)));
typedef float f32v2_t __attribute__((ext_vector_type(2)));
DI unsigned pack2(float a, float b) { const f32v2_t v = {a, b}; return __builtin_bit_cast(unsigned, __builtin_convertvector(v, bf16v2_t)); }
DI unsigned f2bf(float x) { return pack2(x, 0.f) & 0xffffu; }
DI float bf2f(unsigned h) { return __uint_as_float(h << 16); }
DI float bflo(unsigned w) { return __uint_as_float(w << 16); }
DI float bfhi(unsigned w) { return __uint_as_float(w & 0xffff0000u); }
DI float sigm(float x) { return __builtin_amdgcn_rcpf(1.f + __expf(-x)); }
DI float siluf(float x) { return x * __builtin_amdgcn_rcpf(1.f + __expf(-x)); }
DI float softplusf(float x) { return fmaxf(x, 0.f) + log1pf(__expf(-fabsf(x))); }
DI bf16x8 pack8(const f32x4& a, const f32x4& b) {
    u32x4 p; p.x = pack2(a[0], a[1]); p.y = pack2(a[2], a[3]); p.z = pack2(b[0], b[1]); p.w = pack2(b[2], b[3]);
    return __builtin_bit_cast(bf16x8, p);
}
DI bf16x8 cat4(const s16x4& lo, const s16x4& hi) { return __builtin_shufflevector(lo, hi, 0, 1, 2, 3, 4, 5, 6, 7); }

template <int NT, class Epi>
DI void gemm_phase(const bf16_t* __restrict__ A, const bf16_t* __restrict__ Bt, int K, int nmt, int nnt, char* lds, const Epi& epi) {
    const int tid = threadIdx.x, lane = tid & 63, wid = tid >> 6, fr = lane & 15, fq = lane >> 4;
    const int wm = wid >> 1, wn = wid & 1;
    constexpr int BN = NT * 32;
    constexpr int BCH = BN / 32;
    const int ntiles = nmt * nnt, nk = K >> 6;
    const int srow = tid >> 3, spos = tid & 7;
    const bool xmap = nmt >= 16 && (gridDim.x & 7) == 0;
    const int xcd = blockIdx.x & 7;
    const int mlo = xmap ? (xcd * nmt) >> 3 : 0, mcnt = xmap ? (((xcd + 1) * nmt) >> 3) - mlo : nmt;
    const int estart = xmap ? (int)(blockIdx.x >> 3) : (int)blockIdx.x, estep = xmap ? (int)(gridDim.x >> 3) : (int)gridDim.x;
    const int etotal = xmap ? mcnt * nnt : ntiles;
    for (int e = estart; e < etotal; e += estep) {
        int mt, nt;
        if (xmap) {
            const int pg = mcnt * 8, ng = e / pg, nrem = nnt - ng * 8, gw = nrem < 8 ? nrem : 8, r = e - ng * pg, mi = r / gw;
            mt = mlo + mi; nt = ng * 8 + (r - mi * gw);
        } else { mt = e % nmt; nt = e / nmt; }
        const int m0 = mt * 128, n0 = nt * BN;
        f32x4 acc[4][NT];
#pragma unroll
        for (int m = 0; m < 4; ++m)
#pragma unroll
            for (int n = 0; n < NT; ++n) acc[m][n] = (f32x4){0.f, 0.f, 0.f, 0.f};
        const bf16_t* ag[4]; const bf16_t* bg[BCH];
#pragma unroll
        for (int i = 0; i < 4; ++i) { const int row = srow + 32 * i; ag[i] = A + (size_t)(m0 + row) * K + ((spos ^ ((row >> 1) & 7)) << 3); }
#pragma unroll
        for (int i = 0; i < BCH; ++i) { const int row = srow + 32 * i; bg[i] = Bt + (size_t)(n0 + row) * K + ((spos ^ ((row >> 1) & 7)) << 3); }
        __syncthreads();
#define GEMM_ISSUE(kt_, st_) do { \
        _Pragma("unroll") for (int i = 0; i < 4; ++i) __builtin_amdgcn_global_load_lds((const unsigned*)(ag[i] + (kt_) * 64), (LAS unsigned*)(lds + (st_) * 32768 + i * 4096 + wid * 1024), 16, 0, 0); \
        _Pragma("unroll") for (int i = 0; i < BCH; ++i) __builtin_amdgcn_global_load_lds((const unsigned*)(bg[i] + (kt_) * 64), (LAS unsigned*)(lds + (st_) * 32768 + 16384 + i * 4096 + wid * 1024), 16, 0, 0); } while (0)
        GEMM_ISSUE(0, 0);
        for (int kt = 0; kt < nk; ++kt) {
            asm volatile("s_waitcnt vmcnt(0)" ::: "memory");
            __syncthreads();
            if (kt + 1 < nk) GEMM_ISSUE(kt + 1, (kt + 1) & 1);
            const char* As = lds + (kt & 1) * 32768;
            const char* Bs = As + 16384;
            bf16x8 af[2][4], bfr[2][NT];
#pragma unroll
            for (int ks = 0; ks < 2; ++ks) {
                const int ch = ks * 4 + fq;
#pragma unroll
                for (int m = 0; m < 4; ++m) { const int row = wm * 64 + m * 16 + fr; af[ks][m] = *(const bf16x8*)(As + row * 128 + ((ch ^ ((row >> 1) & 7)) << 4)); }
#pragma unroll
                for (int n = 0; n < NT; ++n) { const int row = wn * NT * 16 + n * 16 + fr; bfr[ks][n] = *(const bf16x8*)(Bs + row * 128 + ((ch ^ ((row >> 1) & 7)) << 4)); }
            }
            __builtin_amdgcn_s_setprio(1);
#pragma unroll
            for (int ks = 0; ks < 2; ++ks)
#pragma unroll
                for (int m = 0; m < 4; ++m)
#pragma unroll
                    for (int n = 0; n < NT; ++n) acc[m][n] = MFMA16(bfr[ks][n], af[ks][m], acc[m][n]);
            __builtin_amdgcn_s_setprio(0);
        }
#undef GEMM_ISSUE
        epi(acc, m0 + wm * 64 + fr, n0, wn, fq, lane);
    }
}

struct EpiF32 {
    float* C; int ldc; const float* bias;
    DI void operator()(const f32x4 (&acc)[4][4], int rowb, int n0, int wn, int fq, int) const {
#pragma unroll
        for (int m = 0; m < 4; ++m)
#pragma unroll
            for (int n = 0; n < 4; ++n) {
                const int col = n0 + wn * 64 + n * 16 + 4 * fq;
                f32x4 v = acc[m][n];
                if (bias) { const f32x4 bv = *(const f32x4*)(bias + col); v = v + bv; }
                *(f32x4*)(C + (size_t)(rowb + m * 16) * ldc + col) = v;
            }
    }
};
struct EpiBf16 {
    bf16_t* O; int ldc;
    DI void operator()(const f32x4 (&acc)[4][4], int rowb, int n0, int wn, int fq, int) const {
#pragma unroll
        for (int m = 0; m < 4; ++m)
#pragma unroll
            for (int n = 0; n < 4; ++n) {
                const f32x4 v = acc[m][n]; u32x2 w; w.x = pack2(v[0], v[1]); w.y = pack2(v[2], v[3]);
                *(u32x2*)(O + (size_t)(rowb + m * 16) * ldc + n0 + wn * 64 + n * 16 + 4 * fq) = w;
            }
    }
};
struct EpiSwiglu {
    bf16_t* O;
    DI void operator()(const f32x4 (&acc)[4][4], int rowb, int n0, int wn, int fq, int) const {
        const int cb = (n0 >> 1) + wn * 32 + 4 * fq;
#pragma unroll
        for (int m = 0; m < 4; ++m)
#pragma unroll
            for (int n2 = 0; n2 < 2; ++n2) {
                const f32x4 g = acc[m][2 * n2], u = acc[m][2 * n2 + 1];
                u32x2 w; w.x = pack2(siluf(g[0]) * u[0], siluf(g[1]) * u[1]); w.y = pack2(siluf(g[2]) * u[2], siluf(g[3]) * u[3]);
                *(u32x2*)(O + (size_t)(rowb + m * 16) * DFF + cb + n2 * 16) = w;
            }
    }
};
struct EpiP {
    bf16_t* PU; bf16_t* PQ; bf16_t* PKV; float* PBA; const float* rope; bf16_t* HALO; float* out;
    DI void operator()(const f32x4 (&acc)[4][4], int rowb, int n0, int wn, int fq, int) const {
        if (n0 < 3072) {
#pragma unroll
            for (int m = 0; m < 4; ++m)
#pragma unroll
                for (int n = 0; n < 4; ++n) {
                    const f32x4 v = acc[m][n]; u32x2 w; w.x = pack2(v[0], v[1]); w.y = pack2(v[2], v[3]);
                    const int row = rowb + m * 16, col = n0 + wn * 64 + n * 16 + 4 * fq;
                    *(u32x2*)(PU + (size_t)row * 3072 + col) = w;
                    if ((row & 63) >= 61 && row < MP && (row & 4095) < 4032)
                        *(u32x2*)(HALO + ((size_t)((row >> 6) + 1) * 3 + ((row & 63) - 61)) * 3072 + col) = w;
                    if (row < MP && (row & 4095) >= 4093)
                        *(f32x4*)(out + O_CONVP + ((size_t)(row >> 12) * 3 + ((row & 4095) - 4093)) * 3072 + col) = v;
                }
        } else if (n0 < 4608) {
            const bool isq = n0 < 4096;
            const int cw = (isq ? n0 - 3072 : n0 - 4096) + wn * 64;
            const bool rot = isq || cw < 256;
            bf16_t* dst = isq ? PQ : PKV; const int ld = isq ? 1024 : 512;
#pragma unroll
            for (int m = 0; m < 4; ++m) {
                const int row = rowb + m * 16;
                const int pidx = row < MP ? (row & 4095) : 4096 + (row & 3);
                const float* tab = rope + pidx * 16 + 4 * (fq & 1);
#pragma unroll
                for (int n = 0; n < 4; ++n) {
                    f32x4 v = acc[m][n];
                    if (n == 0) {
                        f32x4 pr;
#pragma unroll
                        for (int j = 0; j < 4; ++j) pr[j] = __shfl_xor(v[j], 32);
                        if (rot) {
#pragma unroll
                            for (int j = 0; j < 4; ++j) { const float c = tab[j], s = tab[8 + j]; v[j] = (fq < 2) ? v[j] * c - pr[j] * s : v[j] * c + pr[j] * s; }
                        }
                    }
                    u32x2 w; w.x = pack2(v[0], v[1]); w.y = pack2(v[2], v[3]);
                    *(u32x2*)(dst + (size_t)row * ld + cw + n * 16 + 4 * fq) = w;
                    if (!isq && row < MP && (row & 4095) >= 3968) {
                        const int cc = cw + n * 16 + 4 * fq;
                        *(f32x4*)(out + (cc < 256 ? O_SWKP : O_SWVP) + ((size_t)(row >> 12) * 128 + ((row & 4095) - 3968)) * 256 + (cc & 255)) = v;
                    }
                }
            }
        } else {
            if (wn == 0) {
#pragma unroll
                for (int m = 0; m < 4; ++m) *(f32x4*)(PBA + (size_t)(rowb + m * 16) * 16 + 4 * fq) = acc[m][0];
            }
        }
    }
};
struct EpiMerge {
    const bf16_t* PU; const bf16_t* PQ; const float* dng; bf16_t* Y;
    DI void operator()(const f32x4 (&acc)[4][3], int rowb, int n0, int wn, int fq, int) const {
        const int c0 = (n0 / 96) * 32 + wn * 16 + 4 * fq;
        const f32x4 gn = *(const f32x4*)(dng + (c0 & 127));
        u32x4 ov[4][4];
#pragma unroll
        for (int m = 0; m < 4; ++m) {
            const bf16_t* op = PU + (size_t)(rowb + m * 16) * 3072 + 2048 + (c0 & ~127) + fq * 32;
#pragma unroll
            for (int i = 0; i < 4; ++i) ov[m][i] = *(const u32x4*)(op + i * 8);
        }
#pragma unroll
        for (int m = 0; m < 4; ++m) {
            const int row = rowb + m * 16;
            float ss = 0.f;
#pragma unroll
            for (int i = 0; i < 4; ++i)
#pragma unroll
                for (int e = 0; e < 4; ++e) { const float a = bflo(ov[m][i][e]), b = bfhi(ov[m][i][e]); ss += a * a + b * b; }
            ss += __shfl_xor(ss, 16); ss += __shfl_xor(ss, 32);
            const float rstd = rsqrtf(ss * (1.f / 128.f) + EPSF);
            const u32x2 ou = *(const u32x2*)(PU + (size_t)row * 3072 + 2048 + c0);
            const u32x2 os = *(const u32x2*)(PQ + (size_t)row * 1024 + c0);
            const float od[4] = {bflo(ou.x), bfhi(ou.x), bflo(ou.y), bfhi(ou.y)};
            const float sw[4] = {bflo(os.x), bfhi(os.x), bflo(os.y), bfhi(os.y)};
            float y[4];
#pragma unroll
            for (int j = 0; j < 4; ++j) y[j] = sigm(acc[m][1][j]) * (od[j] * rstd * gn[j]) * siluf(acc[m][0][j]) + sigm(acc[m][2][j]) * sw[j];
            u32x2 w; w.x = pack2(y[0], y[1]); w.y = pack2(y[2], y[3]);
            *(u32x2*)(Y + (size_t)row * 1024 + c0) = w;
        }
    }
};

struct CvtJob { const float* src; int ld; int K; int col0; int ncols; bf16_t* dst; int G; int which; int rowbase; };
DI int job_tiles(const CvtJob& j) { return ((j.ncols + 63) >> 6) * (j.K >> 6); }
DI void cvt_tile(const CvtJob& j, int t, char* lds) {
    float* tl = (float*)lds;
    const int tid = threadIdx.x;
    const int nkt = j.K >> 6, ct = t / nkt, kt = t % nkt, c0 = ct * 64, k0 = kt * 64;
    __syncthreads();
#pragma unroll
    for (int i = 0; i < 16; ++i) {
        const int kr = (tid >> 6) + 4 * i, col = tid & 63;
        tl[kr * 65 + col] = (c0 + col < j.ncols) ? j.src[(size_t)(k0 + kr) * j.ld + j.col0 + c0 + col] : 0.f;
    }
    __syncthreads();
#pragma unroll
    for (int i = 0; i < 2; ++i) {
        const int col = (tid >> 3) + 32 * i, ch = tid & 7, jc = c0 + col;
        if (jc < j.ncols) {
            const int drow = j.rowbase + (jc >> 4) * (j.G * 16) + j.which * 16 + (jc & 15);
            u32x4 w;
            w.x = pack2(tl[(ch * 8 + 0) * 65 + col], tl[(ch * 8 + 1) * 65 + col]);
            w.y = pack2(tl[(ch * 8 + 2) * 65 + col], tl[(ch * 8 + 3) * 65 + col]);
            w.z = pack2(tl[(ch * 8 + 4) * 65 + col], tl[(ch * 8 + 5) * 65 + col]);
            w.w = pack2(tl[(ch * 8 + 6) * 65 + col], tl[(ch * 8 + 7) * 65 + col]);
            *(u32x4*)(j.dst + (size_t)drow * j.K + k0 + ch * 8) = w;
        }
    }
}
DI CvtJob get_job(const Params& p, int id) {
    char* ws = p.ws; char* ob = (char*)p.out;
    bf16_t* W1GU = (bf16_t*)(ob + T_W1GU); bf16_t* W1D = (bf16_t*)(ob + T_W1D); bf16_t* WA = (bf16_t*)(ob + T_WA);
    bf16_t* WB = (bf16_t*)(ws + OFF_WB); bf16_t* WO = (bf16_t*)(ws + OFF_WO); bf16_t* WADA = (bf16_t*)(ws + OFF_C + C_WADA);
    bf16_t* W2GU = (bf16_t*)(ws + OFF_C + C_W2GU); bf16_t* W2D = (bf16_t*)(ws + OFF_C + C_W2D);
    switch (id) {
        case 0: return CvtJob{p.w1g, DFF, 1024, 0, DFF, W1GU, 2, 0, 0};
        case 1: return CvtJob{p.w1u, DFF, 1024, 0, DFF, W1GU, 2, 1, 0};
        case 2: return CvtJob{p.w1d, 1024, DFF, 0, 1024, W1D, 1, 0, 0};
        case 3: return CvtJob{p.w_in, 7696, 1024, 0, 3072, WA, 1, 0, 0};
        case 4: return CvtJob{p.w_in, 7696, 1024, 3072, 1024, WB, 3, 0, 0};
        case 5: return CvtJob{p.w_in, 7696, 1024, 4096, 16, WA, 1, 0, 4608};
        case 6: return CvtJob{p.w_in, 7696, 1024, 4112, 1024, WA, 1, 0, 3072};
        case 7: return CvtJob{p.w_in, 7696, 1024, 5136, 256, WA, 1, 0, 4096};
        case 8: return CvtJob{p.w_in, 7696, 1024, 5392, 256, WA, 1, 0, 4352};
        case 9: return CvtJob{p.w_in, 7696, 1024, 5648, 1024, WB, 3, 1, 0};
        case 10: return CvtJob{p.w_in, 7696, 1024, 6672, 1024, WB, 3, 2, 0};
        case 11: return CvtJob{p.w_out, 1024, 1024, 0, 1024, WO, 1, 0, 0};
        case 12: return CvtJob{p.w_ada, 9216, 1024, 0, 9216, WADA, 1, 0, 0};
        case 13: return CvtJob{p.w2g, DFF, 1024, 0, DFF, W2GU, 2, 0, 0};
        case 14: return CvtJob{p.w2u, DFF, 1024, 0, DFF, W2GU, 2, 1, 0};
        default: return CvtJob{p.w2d, 1024, DFF, 0, 1024, W2D, 1, 0, 0};
    }
}
template <int JLO, int JHI>
DI void cvt_jobs(const Params& p, char* lds) {
    int base = 0;
#pragma unroll
    for (int id = JLO; id < JHI; ++id) {
        const CvtJob j = get_job(p, id);
        const int nt = job_tiles(j);
        int first = ((int)blockIdx.x - base) % (int)gridDim.x; if (first < 0) first += gridDim.x;
        for (int t = first; t < nt; t += gridDim.x) cvt_tile(j, t, lds);
        base += nt;
    }
    __syncthreads();
}

DI void phase_prologue(const Params& p, char* lds) {
    cvt_jobs<0, 13>(p, lds);
    const int gtid = blockIdx.x * 256 + threadIdx.x, gsz = gridDim.x * 256;
    bf16_t* SC = (bf16_t*)(p.ws + OFF_SC);
    for (int i = gtid; i < 256 * 1024; i += gsz) {
        const int row = i >> 10, col = i & 1023;
        float v = 0.f;
        if (row < 4) v = siluf(p.c_p[row * 1024 + col]); else if (row < 132) v = siluf(p.c_s[(row - 4) * 1024 + col]);
        SC[i] = (bf16_t)f2bf(v);
    }
    float* rope = (float*)(p.ws + OFF_ROPE);
    for (int i = gtid; i < 4100 * 8; i += gsz) {
        const int pi = i >> 3, k = i & 7;
        const float pos = (float)(pi < 4096 ? pi : 8192 + (pi - 4096));
        const float invf = (float)exp(-(double)k * 0.125 * log(500000.0));
        const float ang = pos * invf;
        rope[pi * 16 + k] = (float)cos((double)ang);
        rope[pi * 16 + 8 + k] = (float)sin((double)ang);
    }
}

DI void norm_phase(const Params& p, bool x_from_input, const bf16_t* f, int gate_i, float gcoef, const float* post,
                   bool write_x, const float* pre, int sh_i, int sc_i) {
    const int lane = threadIdx.x & 63, wid = threadIdx.x >> 6;
    const float* MOD = (const float*)(p.ws + OFF_MOD);
    bf16_t* H = (bf16_t*)(p.ws + OFF_H);
    for (int row = blockIdx.x * 4 + wid; row < MALL; row += gridDim.x * 4) {
        const int cidx = row < MP ? (row >> 12) : 4 + ((row - MP) >> 2);
        const float* mrow = MOD + (size_t)cidx * 9216;
        const float* xr = x_from_input ? (row < MP ? p.x_p + (size_t)row * 1024 : p.x_s + (size_t)(row - MP) * 1024) : p.out + (size_t)row * 1024;
        f32x4 x[4];
#pragma unroll
        for (int i = 0; i < 4; ++i) x[i] = *(const f32x4*)(xr + lane * 4 + 256 * i);
        if (f) {
            f32x4 fv[4]; float ss = 0.f;
#pragma unroll
            for (int i = 0; i < 4; ++i) { const u32x2 fw = *(const u32x2*)(f + (size_t)row * 1024 + lane * 4 + 256 * i);
                fv[i] = (f32x4){bflo(fw.x), bfhi(fw.x), bflo(fw.y), bfhi(fw.y)}; ss += fv[i][0] * fv[i][0] + fv[i][1] * fv[i][1] + fv[i][2] * fv[i][2] + fv[i][3] * fv[i][3]; }
#pragma unroll
            for (int o = 32; o > 0; o >>= 1) ss += __shfl_xor(ss, o);
            const float rstd = rsqrtf(ss * (1.f / 1024.f) + EPSF);
#pragma unroll
            for (int i = 0; i < 4; ++i) {
                const int col = lane * 4 + 256 * i;
                const f32x4 g = *(const f32x4*)(mrow + gate_i * 1024 + col), pg = *(const f32x4*)(post + col);
#pragma unroll
                for (int j = 0; j < 4; ++j) x[i][j] += gcoef * g[j] * (fv[i][j] * rstd * pg[j]);
            }
        }
        if (write_x) {
#pragma unroll
            for (int i = 0; i < 4; ++i) *(f32x4*)(p.out + (size_t)row * 1024 + lane * 4 + 256 * i) = x[i];
        }
        if (pre) {
            float ss = 0.f;
#pragma unroll
            for (int i = 0; i < 4; ++i) ss += x[i][0] * x[i][0] + x[i][1] * x[i][1] + x[i][2] * x[i][2] + x[i][3] * x[i][3];
#pragma unroll
            for (int o = 32; o > 0; o >>= 1) ss += __shfl_xor(ss, o);
            const float rstd = rsqrtf(ss * (1.f / 1024.f) + EPSF);
#pragma unroll
            for (int i = 0; i < 4; ++i) {
                const int col = lane * 4 + 256 * i;
                const f32x4 pg = *(const f32x4*)(pre + col), sh = *(const f32x4*)(mrow + sh_i * 1024 + col), sc = *(const f32x4*)(mrow + sc_i * 1024 + col);
                float h[4];
#pragma unroll
                for (int j = 0; j < 4; ++j) h[j] = x[i][j] * rstd * pg[j] * (1.f + sc[j]) + sh[j];
                u32x2 w; w.x = pack2(h[0], h[1]); w.y = pack2(h[2], h[3]);
                *(u32x2*)(H + (size_t)row * 1024 + col) = w;
            }
        }
    }
}

DI void phase_mixprep(const Params& p, char* lds) {
    char* C = p.ws + OFF_C;
    const bf16_t* PKV = (const bf16_t*)(C + C_PKV);
    bf16_t* KCS = (bf16_t*)(C + C_KCS); bf16_t* VTP = (bf16_t*)(C + C_VTP); bf16_t* VTS = (bf16_t*)(C + C_VTS);
    float* SSQ = (float*)(C + C_SSQ);
    const int tid = threadIdx.x, gtid = blockIdx.x * 256 + tid, gsz = gridDim.x * 256;
    bf16_t* tl = (bf16_t*)lds;
    for (int t = blockIdx.x; t < 1024; t += gridDim.x) {
        const int b = t >> 8, cb = (t >> 6) & 3, tb = t & 63;
        __syncthreads();
#pragma unroll
        for (int i = 0; i < 16; ++i) { const int tr = (tid >> 6) + 4 * i, col = tid & 63; tl[tr * 66 + col] = PKV[(size_t)(b * 4096 + tb * 64 + tr) * 512 + 256 + cb * 64 + col]; }
        __syncthreads();
#pragma unroll
        for (int i = 0; i < 2; ++i) {
            const int col = (tid >> 3) + 32 * i, ch = tid & 7;
            u32x4 w;
            w.x = tl[(ch * 8 + 0) * 66 + col] | ((unsigned)tl[(ch * 8 + 1) * 66 + col] << 16);
            w.y = tl[(ch * 8 + 2) * 66 + col] | ((unsigned)tl[(ch * 8 + 3) * 66 + col] << 16);
            w.z = tl[(ch * 8 + 4) * 66 + col] | ((unsigned)tl[(ch * 8 + 5) * 66 + col] << 16);
            w.w = tl[(ch * 8 + 6) * 66 + col] | ((unsigned)tl[(ch * 8 + 7) * 66 + col] << 16);
            *(u32x4*)(VTP + (size_t)(b * 256 + cb * 64 + col) * 4096 + tb * 64 + ch * 8) = w;
        }
    }
    for (int t = blockIdx.x; t < 512; t += gridDim.x) {
        const int seq = t >> 2, cb = t & 3;
        __syncthreads();
        for (int i = tid; i < 160 * 64; i += 256) {
            const int s = i >> 6, col = i & 63;
            unsigned v = 0;
            if (s < 128) v = f2bf(p.cache_v[(size_t)(seq * 128 + s) * 256 + cb * 64 + col]);
            else if (s < 132) v = PKV[(size_t)(MP + seq * 4 + s - 128) * 512 + 256 + cb * 64 + col];
            tl[s * 66 + col] = (bf16_t)v;
        }
        __syncthreads();
        for (int i = tid; i < 64 * 20; i += 256) {
            const int col = i / 20, ch = i % 20;
            u32x4 w;
            w.x = tl[(ch * 8 + 0) * 66 + col] | ((unsigned)tl[(ch * 8 + 1) * 66 + col] << 16);
            w.y = tl[(ch * 8 + 2) * 66 + col] | ((unsigned)tl[(ch * 8 + 3) * 66 + col] << 16);
            w.z = tl[(ch * 8 + 4) * 66 + col] | ((unsigned)tl[(ch * 8 + 5) * 66 + col] << 16);
            w.w = tl[(ch * 8 + 6) * 66 + col] | ((unsigned)tl[(ch * 8 + 7) * 66 + col] << 16);
            *(u32x4*)(VTS + (size_t)(seq * 256 + cb * 64 + col) * 160 + ch * 8) = w;
        }
    }
    __syncthreads();
    for (int i = gtid; i < 128 * 144 * 32; i += gsz) {
        const int ch = i & 31, slot = (i >> 5) % 144, seq = (i >> 5) / 144;
        u32x4 w = (u32x4){0u, 0u, 0u, 0u};
        if (slot < 128) {
            const float* s = p.cache_k + (size_t)(seq * 128 + slot) * 256 + ch * 8;
            const f32x4 a = *(const f32x4*)s, b = *(const f32x4*)(s + 4);
            w.x = pack2(a[0], a[1]); w.y = pack2(a[2], a[3]); w.z = pack2(b[0], b[1]); w.w = pack2(b[2], b[3]);
        } else if (slot < 132) w = *(const u32x4*)(PKV + (size_t)(MP + seq * 4 + slot - 128) * 512 + ch * 8);
        *(u32x4*)(KCS + (size_t)i * 8) = w;
    }
}

DI void prep_item(const Params& p, int item, char* lds) {
    char* C = p.ws + OFF_C;
    bf16_t* PU = (bf16_t*)(C + C_PU);
    const float* PBA = (const float*)(C + C_PBA);
    bf16_t* KDT = (bf16_t*)(C + C_KDT); bf16_t* ACH = (bf16_t*)(C + C_ACH); float* GAM = (float*)(C + C_GAM);
    const bf16_t* HALO = (const bf16_t*)(C + C_HALO);
    bf16_t* UP = (bf16_t*)((char*)p.out + T_UP);
    int tid = threadIdx.x; asm volatile("" : "+v"(tid));
    const int lane = tid & 63, wid = tid >> 6, fr = lane & 15, fq = lane >> 4;
    const int b = item >> 9, n = (item >> 3) & 63, h = item & 7;
    const int r0 = b * 4096 + n * 64;
    char* Qt = lds; char* Kt = lds + 16384;
    float* Ls = (float*)(lds + 32768);
    float* gc = (float*)(lds + 50176); float* be = gc + 64; float* eg = be + 64;
    const bf16_t* halo = HALO + (size_t)(b * 64 + n) * 3 * 3072;
    __syncthreads();
    {
        const int slot = tid >> 4, l16 = tid & 15, which = slot & 1, rsub = slot >> 1;
        const int cbase = which * 1024 + h * 128 + l16 * 8;
        float w[4][8];
#pragma unroll
        for (int t = 0; t < 4; ++t) {
            const f32x4 a = *(const f32x4*)(p.conv_w + t * 3072 + cbase), bb = *(const f32x4*)(p.conv_w + t * 3072 + cbase + 4);
#pragma unroll
            for (int e = 0; e < 4; ++e) { w[t][e] = a[e]; w[t][4 + e] = bb[e]; }
        }
        const float qs = which == 0 ? 0.08838834764831845f : 1.f;
        for (int ps = 0; ps < 8; ++ps) {
            const int i = ps * 8 + rsub;
            float y[8];
#pragma unroll
            for (int e = 0; e < 8; ++e) y[e] = 0.f;
#pragma unroll
            for (int t = 0; t < 4; ++t) {
                const int tr = i - 3 + t;
                const bf16_t* src = tr < 0 ? halo + (3 + tr) * 3072 + cbase : PU + (size_t)(r0 + tr) * 3072 + cbase;
                u32x4 v = *(const u32x4*)src;
                if (tr < 0 && n == 0) v = (u32x4){0u, 0u, 0u, 0u};
                y[0] += w[t][0] * bflo(v.x); y[1] += w[t][1] * bfhi(v.x); y[2] += w[t][2] * bflo(v.y); y[3] += w[t][3] * bfhi(v.y);
                y[4] += w[t][4] * bflo(v.z); y[5] += w[t][5] * bfhi(v.z); y[6] += w[t][6] * bflo(v.w); y[7] += w[t][7] * bfhi(v.w);
            }
            float ss = 0.f;
#pragma unroll
            for (int e = 0; e < 8; ++e) { y[e] = siluf(y[e]); ss += y[e] * y[e]; }
            ss += __shfl_xor(ss, 1); ss += __shfl_xor(ss, 2); ss += __shfl_xor(ss, 4); ss += __shfl_xor(ss, 8);
            const float sc = rsqrtf(ss + EPSF) * qs;
            u32x4 o; o.x = pack2(y[0] * sc, y[1] * sc); o.y = pack2(y[2] * sc, y[3] * sc); o.z = pack2(y[4] * sc, y[5] * sc); o.w = pack2(y[6] * sc, y[7] * sc);
            *(u32x4*)((which ? Kt : Qt) + i * 256 + ((l16 ^ (i & 15)) << 4)) = o;
        }
    }
    if (wid == 0) {
        const float braw = PBA[(size_t)(r0 + lane) * 16 + h], araw = PBA[(size_t)(r0 + lane) * 16 + 8 + h];
        float g = -__expf(p.a_log[h]) * softplusf(araw + p.dt_bias[h]);
#pragma unroll
        for (int o = 1; o < 64; o <<= 1) { const float t = __shfl_up(g, o); if (lane >= o) g += t; }
        gc[lane] = g; be[lane] = sigm(braw); eg[lane] = __expf(g);
    }
    __syncthreads();
    {
        f32x4 ak[4], aq[4];
#pragma unroll
        for (int nj = 0; nj < 4; ++nj) { ak[nj] = (f32x4){0.f, 0.f, 0.f, 0.f}; aq[nj] = ak[nj]; }
#pragma unroll
        for (int ks = 0; ks < 4; ++ks) {
            const int ri = wid * 16 + fr, ch = ks * 4 + fq;
            const bf16x8 fk = *(const bf16x8*)(Kt + ri * 256 + ((ch ^ (ri & 15)) << 4));
            const bf16x8 fqq = *(const bf16x8*)(Qt + ri * 256 + ((ch ^ (ri & 15)) << 4));
#pragma unroll
            for (int nj = 0; nj < 4; ++nj) {
                const int rj = nj * 16 + fr;
                const bf16x8 fb = *(const bf16x8*)(Kt + rj * 256 + ((ch ^ (rj & 15)) << 4));
                ak[nj] = MFMA16(fk, fb, ak[nj]);
                aq[nj] = MFMA16(fqq, fb, aq[nj]);
            }
        }
#pragma unroll
        for (int nj = 0; nj < 4; ++nj)
#pragma unroll
            for (int jj = 0; jj < 4; ++jj) {
                const int i = wid * 16 + 4 * fq + jj, j = nj * 16 + fr;
                const float dec = __expf(fminf(gc[i] - gc[j], 0.f));
                Ls[i * 68 + j] = i > j ? be[i] * ak[nj][jj] * dec : 0.f;
                ACH[(size_t)item * 4096 + i * 64 + j] = (bf16_t)f2bf(i >= j ? aq[nj][jj] * dec : 0.f);
            }
    }
    __syncthreads();
    asm volatile("" : "+v"(tid));
    float x[64];
    if (tid < 128) {
        const int cv = 2048 + h * 128 + tid;
        const float w0 = p.conv_w[cv], w1 = p.conv_w[3072 + cv], w2 = p.conv_w[2 * 3072 + cv], w3 = p.conv_w[3 * 3072 + cv];
        float xm3 = bf2f(halo[cv]), xm2 = bf2f(halo[3072 + cv]), xm1 = bf2f(halo[2 * 3072 + cv]);
        if (n == 0) { xm3 = 0.f; xm2 = 0.f; xm1 = 0.f; }
#pragma unroll
        for (int i = 0; i < 64; ++i) {
            const float xi = bf2f(PU[(size_t)(r0 + i) * 3072 + cv]);
            x[i] = siluf(w0 * xm3 + w1 * xm2 + w2 * xm1 + w3 * xi) * be[i];
            xm3 = xm2; xm2 = xm1; xm1 = xi;
            if ((i & 15) == 15) __builtin_amdgcn_sched_barrier(0);
        }
    } else {
        const int ck = tid - 128;
#pragma unroll
        for (int i = 0; i < 64; ++i) {
            const bf16_t kv = *(const bf16_t*)(Kt + i * 256 + (((ck >> 3) ^ (i & 15)) << 4) + (ck & 7) * 2);
            x[i] = bf2f(kv) * be[i] * eg[i];
            if ((i & 15) == 15) __builtin_amdgcn_sched_barrier(0);
        }
    }
#pragma unroll
    for (int i = 1; i < 64; ++i) {
        float a = x[i];
#pragma unroll
        for (int j4 = 0; j4 < (i + 3) / 4; ++j4) {
            const f32x4 l = *(const f32x4*)(Ls + i * 68 + j4 * 4);
            a -= l[0] * x[j4 * 4];
            if (j4 * 4 + 1 < i) a -= l[1] * x[j4 * 4 + 1];
            if (j4 * 4 + 2 < i) a -= l[2] * x[j4 * 4 + 2];
            if (j4 * 4 + 3 < i) a -= l[3] * x[j4 * 4 + 3];
        }
        x[i] = a;
        if ((i & 3) == 3) __builtin_amdgcn_sched_barrier(0);
    }
    __syncthreads();
    asm volatile("" : "+v"(tid));
    if (tid < 128) {
        const int sl = tid >> 4, f16 = tid & 15;
#pragma unroll
        for (int q4 = 0; q4 < 4; ++q4) {
            bf16_t* dst = UP + (((size_t)item * 8 + sl) * 64 + q4 * 16 + f16) * 16;
            u32x4 a, bq;
            a.x = pack2(x[0 + 4 * q4 + 0], x[0 + 4 * q4 + 1]); a.y = pack2(x[0 + 4 * q4 + 2], x[0 + 4 * q4 + 3]);
            a.z = pack2(x[16 + 4 * q4 + 0], x[16 + 4 * q4 + 1]); a.w = pack2(x[16 + 4 * q4 + 2], x[16 + 4 * q4 + 3]);
            bq.x = pack2(x[32 + 4 * q4 + 0], x[32 + 4 * q4 + 1]); bq.y = pack2(x[32 + 4 * q4 + 2], x[32 + 4 * q4 + 3]);
            bq.z = pack2(x[48 + 4 * q4 + 0], x[48 + 4 * q4 + 1]); bq.w = pack2(x[48 + 4 * q4 + 2], x[48 + 4 * q4 + 3]);
            *(u32x4*)dst = a; *(u32x4*)(dst + 8) = bq;
        }
    } else {
        const unsigned off = (unsigned)r0 * 3072u + 1024u + h * 128u + (tid - 128);
#pragma unroll
        for (int i = 0; i < 64; ++i) PU[off + (unsigned)i * 3072u] = (bf16_t)f2bf(x[i]);
    }
    {
        const int i = tid >> 2, part = tid & 3;
        const float e = eg[i];
#pragma unroll
        for (int c4 = 0; c4 < 4; ++c4) {
            const int ch = part * 4 + c4;
            const u32x4 v = *(const u32x4*)(Qt + i * 256 + ((ch ^ (i & 15)) << 4));
            u32x4 o;
            o.x = pack2(bflo(v.x) * e, bfhi(v.x) * e); o.y = pack2(bflo(v.y) * e, bfhi(v.y) * e);
            o.z = pack2(bflo(v.z) * e, bfhi(v.z) * e); o.w = pack2(bflo(v.w) * e, bfhi(v.w) * e);
            *(u32x4*)(PU + (size_t)(r0 + i) * 3072 + h * 128 + ch * 8) = o;
        }
    }
    {
        const int dk = tid & 127, ih = tid >> 7;
        const float gl = gc[63];
#pragma unroll
        for (int c4 = 0; c4 < 4; ++c4) {
            float v[8];
#pragma unroll
            for (int e = 0; e < 8; ++e) {
                const int i = ih * 32 + c4 * 8 + e;
                const bf16_t kv = *(const bf16_t*)(Kt + i * 256 + (((dk >> 3) ^ (i & 15)) << 4) + (dk & 7) * 2);
                v[e] = bf2f(kv) * __expf(gl - gc[i]);
            }
            u32x4 o; o.x = pack2(v[0], v[1]); o.y = pack2(v[2], v[3]); o.z = pack2(v[4], v[5]); o.w = pack2(v[6], v[7]);
            *(u32x4*)(KDT + ((size_t)item * 128 + dk) * 64 + ih * 32 + c4 * 8) = o;
        }
        if (tid == 0) GAM[item] = __expf(gl);
    }
}

DI bf16x8 frag_perm(const char* base, int rowbytes, int row, int c0, int fq) {
    const char* q = base + row * rowbytes + (c0 + 4 * fq) * 2;
    const s16x4 lo = *(const s16x4*)q, hi = *(const s16x4*)(q + 32);
    return cat4(lo, hi);
}
#define LDS_BARRIER() do { asm volatile("s_waitcnt lgkmcnt(0)" ::: "memory"); __builtin_amdgcn_s_barrier(); asm volatile("" ::: "memory"); } while (0)
DI void scan_block(const Params& p, int blk, char* lds) {
    char* C = p.ws + OFF_C;
    bf16_t* PU = (bf16_t*)(C + C_PU);
    const bf16_t* KDT = (const bf16_t*)(C + C_KDT); const bf16_t* ACH = (const bf16_t*)(C + C_ACH); const float* GAM = (const float*)(C + C_GAM);
    float* SSQ = (float*)(C + C_SSQ);
    const bf16_t* UP = (const bf16_t*)((const char*)p.out + T_UP);
    const int tid = threadIdx.x, lane = tid & 63, wid = tid >> 6, fr = lane & 15, fq = lane >> 4;
    const int bh = blk & 31, half = blk >> 5, b = bh >> 3, h = bh & 7;
    const int dvb = half * 64 + wid * 16;
    char* Wt = lds; char* Qt = lds + 17408; char* At = lds + 34816; char* Kd = lds + 43520;
    f32x4 S[8];
#pragma unroll
    for (int t = 0; t < 8; ++t) S[t] = (f32x4){0.f, 0.f, 0.f, 0.f};
    u32x4 rW[4], rQ[4], rA[2], rK[4];
    u32x4 rU[2];
    float gam;
#define SCAN_LOAD(nn) do { \
        int tid = threadIdx.x; asm volatile("" : "+v"(tid)); const int lane = tid & 63, wid = tid >> 6; \
        const int r0n_ = b * 4096 + (nn) * 64; const size_t it_ = (size_t)((b * 64 + (nn)) * 8 + h); \
        _Pragma("unroll") for (int i = 0; i < 4; ++i) { const int id = tid + 256 * i, row = id >> 4, ch = id & 15; \
            rW[i] = *(const u32x4*)(PU + (size_t)(r0n_ + row) * 3072 + 1024 + h * 128 + ch * 8); \
            rQ[i] = *(const u32x4*)(PU + (size_t)(r0n_ + row) * 3072 + h * 128 + ch * 8); } \
        _Pragma("unroll") for (int i = 0; i < 2; ++i) { const int id = tid + 256 * i; rA[i] = *(const u32x4*)(ACH + it_ * 4096 + (size_t)id * 8); } \
        _Pragma("unroll") for (int i = 0; i < 4; ++i) { const int id = tid + 256 * i; rK[i] = *(const u32x4*)(KDT + it_ * 8192 + (size_t)id * 8); } \
        { const bf16_t* up_ = UP + ((it_ * 8 + half * 4 + wid) * 64 + lane) * 16; rU[0] = *(const u32x4*)up_; rU[1] = *(const u32x4*)(up_ + 8); } \
        gam = GAM[it_]; } while (0)
    SCAN_LOAD(0);
    __syncthreads();
    for (int n = 0; n < 64; ++n) {
        const int r0 = b * 4096 + n * 64;
        int tid = threadIdx.x; asm volatile("" : "+v"(tid));
#pragma unroll
        for (int i = 0; i < 4; ++i) { const int id = tid + 256 * i, row = id >> 4, ch = id & 15;
            *(u32x4*)(Wt + row * 272 + ch * 16) = rW[i]; *(u32x4*)(Qt + row * 272 + ch * 16) = rQ[i]; }
#pragma unroll
        for (int i = 0; i < 2; ++i) { const int id = tid + 256 * i, row = id >> 3, ch = id & 7; char* q = At + row * 136 + ch * 16;
            *(u32x2*)q = (u32x2){rA[i].x, rA[i].y}; *(u32x2*)(q + 8) = (u32x2){rA[i].z, rA[i].w}; }
#pragma unroll
        for (int i = 0; i < 4; ++i) { const int id = tid + 256 * i, row = id >> 3, ch = id & 7; char* q = Kd + row * 136 + ch * 16;
            *(u32x2*)q = (u32x2){rK[i].x, rK[i].y}; *(u32x2*)(q + 8) = (u32x2){rK[i].z, rK[i].w}; }
        float uc[16];
#pragma unroll
        for (int i = 0; i < 8; ++i) { const unsigned w = i < 4 ? rU[0][i] : rU[1][i - 4]; uc[2 * i] = bflo(w); uc[2 * i + 1] = bfhi(w); }
        const float gcur = gam;
        LDS_BARRIER();
        if (n + 1 < 64) SCAN_LOAD(n + 1);
        bf16x8 Sb[4];
#pragma unroll
        for (int ks = 0; ks < 4; ++ks) Sb[ks] = pack8(S[2 * ks], S[2 * ks + 1]);
        f32x4 aw[4], ao[4];
#pragma unroll
        for (int m = 0; m < 4; ++m) { aw[m] = (f32x4){0.f, 0.f, 0.f, 0.f}; ao[m] = aw[m]; }
#pragma unroll
        for (int ks = 0; ks < 4; ++ks)
#pragma unroll
            for (int m = 0; m < 4; ++m) aw[m] = MFMA16(frag_perm(Wt, 272, 16 * m + fr, 32 * ks, fq), Sb[ks], aw[m]);
#pragma unroll
        for (int ks = 0; ks < 4; ++ks)
#pragma unroll
            for (int m = 0; m < 4; ++m) ao[m] = MFMA16(frag_perm(Qt, 272, 16 * m + fr, 32 * ks, fq), Sb[ks], ao[m]);
        f32x4 vn[4];
#pragma unroll
        for (int m = 0; m < 4; ++m)
#pragma unroll
            for (int jj = 0; jj < 4; ++jj) vn[m][jj] = uc[m * 4 + jj] - aw[m][jj];
        bf16x8 Vb[2];
        Vb[0] = pack8(vn[0], vn[1]); Vb[1] = pack8(vn[2], vn[3]);
#pragma unroll
        for (int t = 0; t < 8; ++t) S[t] = S[t] * gcur;
#pragma unroll
        for (int k2 = 0; k2 < 2; ++k2) {
#pragma unroll
            for (int m = 2 * k2; m < 4; ++m) ao[m] = MFMA16(frag_perm(At, 136, 16 * m + fr, 32 * k2, fq), Vb[k2], ao[m]);
#pragma unroll
            for (int t = 0; t < 8; ++t) S[t] = MFMA16(frag_perm(Kd, 136, 16 * t + fr, 32 * k2, fq), Vb[k2], S[t]);
        }
#pragma unroll
        for (int m = 0; m < 4; ++m)
#pragma unroll
            for (int j2 = 0; j2 < 2; ++j2) {
                const unsigned w = pack2(ao[m][2 * j2], ao[m][2 * j2 + 1]);
                const unsigned ob = (unsigned)(r0 + 4 * fq) * 3072u + 2048u + h * 128u + dvb + fr + (unsigned)(16 * m + 2 * j2) * 3072u;
                PU[ob] = (bf16_t)(w & 0xffffu); PU[ob + 3072u] = (bf16_t)(w >> 16);
            }
        LDS_BARRIER();
    }
#undef SCAN_LOAD
#pragma unroll
    for (int t = 0; t < 8; ++t)
#pragma unroll
        for (int jj = 0; jj < 4; ++jj)
            p.out[O_DELTAP + ((size_t)(b * 8 + h) * 128 + 16 * t + 4 * fq + jj) * 128 + dvb + fr] = S[t][jj];
}

DI void sdelta_item(const Params& p, int item, char* lds) {
    char* C = p.ws + OFF_C;
    bf16_t* PU = (bf16_t*)(C + C_PU);
    const float* PBA = (const float*)(C + C_PBA);
    float* SSQ = (float*)(C + C_SSQ);
    const int tid = threadIdx.x, lane = tid & 63, wid = tid >> 6;
    const int seq = item >> 3, h = item & 7, rs = MP + seq * 4;
    float* qs = (float*)lds;
    float* ks = qs + 512; float* vs = ks + 512;
    float* red = vs + 512;
    float* bt = red + 16; float* al = bt + 4;
    float* kSp = al + 4;
    float* op = kSp + 1024;
    const int ch = tid & 127, part = tid >> 7;
    __syncthreads();
    float yq[4];
    {
        const int nch = part == 0 ? 2 : 1;
        for (int cc = 0; cc < nch; ++cc) {
            const int c = part == 1 ? 1024 + h * 128 + ch : (cc == 0 ? h * 128 + ch : 2048 + h * 128 + ch);
            float full[7];
#pragma unroll
            for (int i = 0; i < 3; ++i) full[i] = p.st_conv[(size_t)(seq * 3 + i) * 3072 + c];
#pragma unroll
            for (int i = 0; i < 4; ++i) full[3 + i] = bf2f(PU[(size_t)(rs + i) * 3072 + c]);
#pragma unroll
            for (int i = 0; i < 3; ++i) p.out[O_CONVS + (size_t)(seq * 3 + i) * 3072 + c] = full[4 + i];
            const float w0 = p.conv_w[c], w1 = p.conv_w[3072 + c], w2 = p.conv_w[2 * 3072 + c], w3 = p.conv_w[3 * 3072 + c];
            float y[4];
#pragma unroll
            for (int t = 0; t < 4; ++t) y[t] = siluf(w0 * full[t] + w1 * full[t + 1] + w2 * full[t + 2] + w3 * full[t + 3]);
            if (part == 0 && cc == 1) {
#pragma unroll
                for (int t = 0; t < 4; ++t) vs[t * 128 + ch] = y[t];
            } else {
#pragma unroll
                for (int t = 0; t < 4; ++t) yq[t] = y[t];
            }
        }
    }
#pragma unroll
    for (int t = 0; t < 4; ++t) {
        float s = yq[t] * yq[t];
#pragma unroll
        for (int o = 32; o > 0; o >>= 1) s += __shfl_xor(s, o);
        if (lane == 0) red[wid * 4 + t] = s;
    }
    if (tid < 4) {
        const float braw = PBA[(size_t)(rs + tid) * 16 + h], araw = PBA[(size_t)(rs + tid) * 16 + 8 + h];
        bt[tid] = sigm(braw);
        al[tid] = __expf(-__expf(p.a_log[h]) * softplusf(araw + p.dt_bias[h]));
    }
    __syncthreads();
#pragma unroll
    for (int t = 0; t < 4; ++t) {
        const float tot = red[(2 * part) * 4 + t] + red[(2 * part + 1) * 4 + t];
        const float sc = rsqrtf(tot + EPSF) * (part == 0 ? 0.08838834764831845f : 1.f);
        (part == 0 ? qs : ks)[t * 128 + ch] = yq[t] * sc;
    }
    __syncthreads();
    const int dv = ch, dk0 = part * 64;
    float S[64];
    const float* s0 = p.st_delta + ((size_t)(seq * 8 + h) * 128 + dk0) * 128 + dv;
#pragma unroll
    for (int i = 0; i < 64; ++i) S[i] = s0[(size_t)i * 128];
#pragma unroll
    for (int t = 0; t < 4; ++t) {
        float pk = 0.f;
#pragma unroll
        for (int i = 0; i < 64; ++i) pk += ks[t * 128 + dk0 + i] * S[i];
        kSp[(t * 2 + part) * 128 + dv] = pk;
        __syncthreads();
        const float kS = kSp[(t * 2) * 128 + dv] + kSp[(t * 2 + 1) * 128 + dv];
        const float a = al[t];
        const float vnew = bt[t] * (vs[t * 128 + dv] - a * kS);
        float po = 0.f;
#pragma unroll
        for (int i = 0; i < 64; ++i) { S[i] = a * S[i] + ks[t * 128 + dk0 + i] * vnew; po += qs[t * 128 + dk0 + i] * S[i]; }
        op[(t * 2 + part) * 128 + dv] = po;
        __syncthreads();
        if (part == 0) {
            const float o = op[(t * 2) * 128 + dv] + op[(t * 2 + 1) * 128 + dv];
            PU[(size_t)(rs + t) * 3072 + 2048 + h * 128 + dv] = (bf16_t)f2bf(o);
        }
    }
    float* so = p.out + O_DELTAS + ((size_t)(seq * 8 + h) * 128 + dk0) * 128 + dv;
#pragma unroll
    for (int i = 0; i < 64; ++i) so[(size_t)i * 128] = S[i];
}

DI void attn_block(const Params& p, int bt) {
    char* C = p.ws + OFF_C;
    bf16_t* PQ = (bf16_t*)(C + C_PQ);
    const bf16_t* PKV = (const bf16_t*)(C + C_PKV); const bf16_t* KCS = (const bf16_t*)(C + C_KCS);
    const bf16_t* VTP = (const bf16_t*)(C + C_VTP); const bf16_t* VTS = (const bf16_t*)(C + C_VTS);
    const int lane = threadIdx.x & 63, wid = threadIdx.x >> 6, fr = lane & 15, fq = lane >> 4;
    const bool isS = bt >= 4096;
    int b = 0, kvh, t0 = 0, seq = 0, head, qrow;
    if (!isS) { b = bt >> 10; kvh = (bt >> 8) & 3; t0 = (bt & 255) * 16; head = kvh * 4 + wid; qrow = b * 4096 + t0 + fr; }
    else { seq = bt - 4096; kvh = wid; head = kvh * 4 + (fr >> 2); qrow = MP + seq * 4 + (fr & 3); }
    bf16_t* qp = PQ + (size_t)qrow * 1024 + head * 64;
    const float sink = p.sinks[head];
    bf16x8 bq[2];
    bq[0] = *(const bf16x8*)(qp + fq * 8); bq[1] = *(const bf16x8*)(qp + 32 + fq * 8);
    f32x4 sc[10];
#pragma unroll
    for (int n = 0; n < 10; ++n) {
        const bf16_t* kp;
        if (!isS) { int t = t0 - 144 + 16 * n + fr; t = t < 0 ? 0 : t; kp = PKV + (size_t)(b * 4096 + t) * 512 + kvh * 64; }
        else { int s = 16 * n + fr; s = s > 143 ? 143 : s; kp = KCS + (size_t)(seq * 144 + s) * 256 + kvh * 64; }
        f32x4 a = (f32x4){0.f, 0.f, 0.f, 0.f};
        a = MFMA16(*(const bf16x8*)(kp + fq * 8), bq[0], a);
        a = MFMA16(*(const bf16x8*)(kp + 32 + fq * 8), bq[1], a);
        sc[n] = a;
    }
    float mx = sink;
#pragma unroll
    for (int n = 0; n < 10; ++n)
#pragma unroll
        for (int jj = 0; jj < 4; ++jj) {
            const int kidx = 16 * n + 4 * fq + jj;
            bool valid;
            if (!isS) { const int t = t0 - 144 + kidx, d = 144 + fr - kidx; valid = t >= 0 && d >= 0 && d <= 128; }
            else { const int d = (fr & 3) + 128 - kidx; valid = d >= 0 && d <= 128; }
            const float s = valid ? sc[n][jj] * 0.125f : -1e30f;
            sc[n][jj] = s; mx = fmaxf(mx, s);
        }
    mx = fmaxf(mx, __shfl_xor(mx, 16)); mx = fmaxf(mx, __shfl_xor(mx, 32));
    float sum = 0.f;
#pragma unroll
    for (int n = 0; n < 10; ++n)
#pragma unroll
        for (int jj = 0; jj < 4; ++jj) { const float e = __expf(sc[n][jj] - mx); sc[n][jj] = e; sum += e; }
    sum += __shfl_xor(sum, 16); sum += __shfl_xor(sum, 32);
    const float inv = 1.f / (sum + __expf(sink - mx));
    bf16x8 bP[5];
#pragma unroll
    for (int s5 = 0; s5 < 5; ++s5) bP[s5] = pack8(sc[2 * s5] * inv, sc[2 * s5 + 1] * inv);
#pragma unroll
    for (int ds = 0; ds < 4; ++ds) {
        const bf16_t* vrow = !isS ? VTP + (size_t)(b * 256 + kvh * 64 + 16 * ds + fr) * 4096 : VTS + (size_t)(seq * 256 + kvh * 64 + 16 * ds + fr) * 160;
        f32x4 a = (f32x4){0.f, 0.f, 0.f, 0.f};
#pragma unroll
        for (int s5 = 0; s5 < 5; ++s5) {
            int g0 = 32 * s5 + 4 * fq, g1 = g0 + 16;
            if (!isS) { g0 += t0 - 144; g1 += t0 - 144; g0 = g0 < 0 ? 0 : g0; g1 = g1 < 0 ? 0 : g1; }
            const s16x4 lo = *(const s16x4*)(vrow + g0), hi = *(const s16x4*)(vrow + g1);
            a = MFMA16(cat4(lo, hi), bP[s5], a);
        }
        u32x2 w; w.x = pack2(a[0], a[1]); w.y = pack2(a[2], a[3]);
        *(u32x2*)(qp + 16 * ds + 4 * fq) = w;
    }
}

DI void sample_window_out(const Params& p) {
    const bf16_t* PKV = (const bf16_t*)(p.ws + OFF_C + C_PKV);
    const int gt = blockIdx.x * 256 + threadIdx.x, gs = gridDim.x * 256;
    for (int i = gt; i < 128 * 128 * 512; i += gs) {
        const int c = i & 511, s = (i >> 9) & 127, seq = i >> 16;
        const int cc = c & 255; const bool isv = c >= 256;
        float v;
        if (s < 124) v = (isv ? p.cache_v : p.cache_k)[(size_t)(seq * 128 + s + 4) * 256 + cc];
        else v = bf2f(PKV[(size_t)(MP + seq * 4 + s - 124) * 512 + c]);
        p.out[(isv ? O_SWVS : O_SWKS) + (size_t)(seq * 128 + s) * 256 + cc] = v;
    }
}

DI void phase_mixer(const Params& p, char* lds) {
    const int nb = gridDim.x, blk = blockIdx.x;
    const int nscan = 64;
#ifndef MK_P9
#define MK_P9 7
#endif
    if (blk < nscan) { if (MK_P9 & 1) scan_block(p, blk, lds); return; }
    const int wb = blk - nscan, nw = nb - nscan;
    if (MK_P9 & 2) for (int it = wb; it < 1024; it += nw) sdelta_item(p, it, lds);
    if (MK_P9 & 4) for (int bt = wb; bt < 4224; bt += nw) attn_block(p, bt);
}

#define XB_TMO      128
#define XB_XCNT(j)  (256  + 64 * (j))
#define XB_XSUB(j)  (1280 + 64 * (j))
#define XB_XGEN(j)  (2304 + 64 * (j))
#define XB_TOP      3328
#define XB_TOPGEN   3392
#define XCD_BAR_WORDS 3456
#define XB_SPIN_CAP (1u << 22)
DI unsigned xb_ld(unsigned* p) { return __hip_atomic_load(p, __ATOMIC_RELAXED, __HIP_MEMORY_SCOPE_AGENT); }
DI unsigned xb_add(unsigned* p, unsigned v) { return __hip_atomic_fetch_add(p, v, __ATOMIC_RELAXED, __HIP_MEMORY_SCOPE_AGENT); }
DI unsigned xb_xcc_id() { return (unsigned)__builtin_amdgcn_s_getreg((3 << 11) | 20) & 0xFu; }
#define XB_SPIN(cond, bar) do { unsigned _sp = 0; while (cond) { __builtin_amdgcn_s_sleep(1); \
    if ((++_sp & 255u) == 0u) { if (xb_ld(&(bar)[XB_TMO])) break; if (_sp > XB_SPIN_CAP) { atomicAdd(&(bar)[XB_TMO], 1u); break; } } } } while (0)
struct XcdBarrier { unsigned* bar; unsigned x; unsigned nloc; unsigned nx; };
DI XcdBarrier xcd_barrier_post(unsigned* bar) {
    XcdBarrier b; b.bar = bar; b.x = xb_xcc_id(); b.nloc = 0u; b.nx = 0u;
    if (threadIdx.x == 0) (void)xb_add(&bar[XB_XCNT(b.x)], 1u);
    return b;
}
DI void xcd_barrier_complete(unsigned* bar, unsigned x, unsigned& nloc, unsigned& nx) {
    const unsigned G = gridDim.x * gridDim.y * gridDim.z;
    unsigned sum, cnt, mine, sp = 0u;
    for (;;) {
        sum = 0u; cnt = 0u; mine = 0u;
#pragma unroll
        for (unsigned j = 0; j < 16; ++j) { const unsigned c = xb_ld(&bar[XB_XCNT(j)]); sum += c; cnt += (c > 0u) ? 1u : 0u; mine = (j == x) ? c : mine; }
        if (sum == G) break;
        __builtin_amdgcn_s_sleep(1);
        if ((++sp & 255u) == 0u) { if (xb_ld(&bar[XB_TMO])) break; if (sp > XB_SPIN_CAP) { atomicAdd(&bar[XB_TMO], 1u); break; } }
    }
    nloc = mine > 0u ? mine : 1u; nx = cnt > 0u ? cnt : 1u;
}
DI void xcd_barrier(XcdBarrier& b) {
    asm volatile("s_waitcnt vmcnt(0)" ::: "memory");
    __syncthreads();
    if (threadIdx.x == 0) {
        unsigned* bar = b.bar;
        __builtin_amdgcn_s_waitcnt(0);
        unsigned nloc = b.nloc, nx = b.nx;
        if (nloc == 0u) { xcd_barrier_complete(bar, b.x, nloc, nx); b.nloc = nloc; b.nx = nx; }
        const unsigned old = xb_add(&bar[XB_XSUB(b.x)], 1u);
        const unsigned gen = old / nloc;
        if (old + 1u == (gen + 1u) * nloc) {
            __builtin_amdgcn_fence(__ATOMIC_RELEASE, "agent");
            asm volatile("s_waitcnt vmcnt(0)" ::: "memory");
            const unsigned og = xb_add(&bar[XB_TOP], 1u);
            const unsigned tg = og / nx;
            if (og + 1u == (tg + 1u) * nx) xb_add(&bar[XB_TOPGEN], 1u);
            else XB_SPIN(xb_ld(&bar[XB_TOPGEN]) == tg, bar);
            __builtin_amdgcn_fence(__ATOMIC_ACQUIRE, "agent");
            xb_add(&bar[XB_XGEN(b.x)], 1u);
            asm volatile("s_waitcnt vmcnt(0)" ::: "memory");
        } else {
            XB_SPIN(xb_ld(&bar[XB_XGEN(b.x)]) == gen, bar);
            __builtin_amdgcn_fence(__ATOMIC_ACQUIRE, "agent");
            asm volatile("s_waitcnt vmcnt(0)" ::: "memory");
        }
    }
    __syncthreads();
}
constexpr size_t OFF_BAR = 293921280;

template <bool COOP>
__global__ void __launch_bounds__(256, 2) mega(Params p) {
    __shared__ __attribute__((aligned(16))) char lds[65536];
    XcdBarrier xb;
    if (COOP) {
        xb = xcd_barrier_post((unsigned*)(p.ws + OFF_BAR));
        if (p.plo < 0) cg::this_grid().sync();
    }
    char* ws = p.ws; char* C = ws + OFF_C; char* ob = (char*)p.out;
    bf16_t* H = (bf16_t*)(ws + OFF_H);
    bf16_t* F = (bf16_t*)(C + C_F);
#define RUNPH(k, ...) do { if (PHON(k) && p.plo <= (k) && (k) < p.phi) { __VA_ARGS__ } \
        if (COOP && p.plo <= (k) && (k) + 1 < p.phi) { xcd_barrier(xb); } } while (0)
    RUNPH(0, phase_prologue(p, lds););
    RUNPH(1, EpiF32 e{(float*)(ws + OFF_MOD), 9216, p.b_ada}; gemm_phase<4>((const bf16_t*)(ws + OFF_SC), (const bf16_t*)(C + C_WADA), 1024, 2, 72, lds, e););
    RUNPH(2, norm_phase(p, true, nullptr, 0, 0.f, nullptr, false, p.n1pre, 0, 1););
    RUNPH(3, EpiSwiglu e{(bf16_t*)(C + C_ACT)}; gemm_phase<4>(H, (const bf16_t*)(ob + T_W1GU), 1024, 132, 43, lds, e););
    RUNPH(4, EpiBf16 e{F, 1024}; gemm_phase<4>((const bf16_t*)(C + C_ACT), (const bf16_t*)(ob + T_W1D), DFF, 132, 8, lds, e););
    RUNPH(5, norm_phase(p, true, F, 2, 0.5f, p.n1post, true, p.nmpre, 3, 4););
    RUNPH(6, EpiP e{(bf16_t*)(C + C_PU), (bf16_t*)(C + C_PQ), (bf16_t*)(C + C_PKV), (float*)(C + C_PBA), (const float*)(ws + OFF_ROPE), (bf16_t*)(C + C_HALO), p.out};
             gemm_phase<4>(H, (const bf16_t*)(ob + T_WA), 1024, 132, 37, lds, e););
    RUNPH(8, for (int it = blockIdx.x; it < 2048; it += gridDim.x) prep_item(p, it, lds); __syncthreads(); phase_mixprep(p, lds););
    RUNPH(9, phase_mixer(p, lds););
    RUNPH(10, sample_window_out(p); EpiMerge e{(const bf16_t*)(C + C_PU), (const bf16_t*)(C + C_PQ), p.dn_norm, (bf16_t*)(C + C_Y)};
              gemm_phase<3>(H, (const bf16_t*)(ws + OFF_WB), 1024, 132, 32, lds, e););
    RUNPH(11, EpiBf16 e{F, 1024}; gemm_phase<4>((const bf16_t*)(C + C_Y), (const bf16_t*)(ws + OFF_WO), 1024, 132, 8, lds, e););
    RUNPH(12, norm_phase(p, false, F, 5, 1.0f, p.nmpost, true, p.n2pre, 6, 7); cvt_jobs<13, 16>(p, lds););
    RUNPH(13, EpiSwiglu e{(bf16_t*)(C + C_ACT)}; gemm_phase<4>(H, (const bf16_t*)(C + C_W2GU), 1024, 132, 43, lds, e););
    RUNPH(14, EpiBf16 e{F, 1024}; gemm_phase<4>((const bf16_t*)(C + C_ACT), (const bf16_t*)(C + C_W2D), DFF, 132, 8, lds, e););
    RUNPH(15, norm_phase(p, false, F, 8, 0.5f, p.n2post, true, nullptr, 0, 0););
#undef RUNPH
}

constexpr int NPHASE = 16;

extern "C" void kernel_launch(void* const* d_in, const int* in_sizes, int n_in, void* d_out, int out_size, void* d_ws, size_t ws_size,
                              hipStream_t stream) {
    Params p{};
    const float** pp = (const float**)&p;
    for (int i = 0; i < 29; ++i) pp[i] = (const float*)d_in[i];
    p.out = (float*)d_out; p.ws = (char*)d_ws; p.plo = 0; p.phi = NPHASE;
#if MK_COOP
    static int grid_blocks = 0;
    if (!grid_blocks) {
        int dev = 0, cus = 0, per_cu = 0;
        (void)hipGetDevice(&dev);
        (void)hipDeviceGetAttribute(&cus, hipDeviceAttributeMultiprocessorCount, dev);
        (void)hipOccupancyMaxActiveBlocksPerMultiprocessor(&per_cu, mega<true>, 256, 0);
        if (per_cu > 2) per_cu = 2;
        grid_blocks = cus * per_cu;
    }
    void* args[] = {&p};
    (void)hipMemsetAsync((char*)d_ws + OFF_BAR, 0, XCD_BAR_WORDS * 4, stream);
    hipError_t e = hipLaunchCooperativeKernel((void*)mega<true>, dim3(grid_blocks), dim3(256), args, 0, stream);
    if (e != hipSuccess) fprintf(stderr, "cooperative launch failed: %s (grid %d)\n", hipGetErrorString(e), grid_blocks);
#else
    for (int ph = 0; ph < NPHASE; ++ph) {
        p.plo = ph; p.phi = ph + 1;
        hipLaunchKernelGGL(mega<false>, dim3(512), dim3(256), 0, stream, p);
    }
#endif
}
```

```cpp
#include <hip/hip_runtime.h>
#include <hip/hip_cooperative_groups.h>
#include <stdint.h>
#include <cstdio>
namespace cg = cooperative_groups;

#ifndef MK_COOP
#define MK_COOP 1
#endif
#ifndef MK_ONLY
#define MK_ONLY -1
#endif
#define PHON(k) (MK_ONLY < 0 || MK_ONLY == (k))

#define DI __device__ __forceinline__
typedef unsigned short bf16_t;
typedef short bf16x8 __attribute__((ext_vector_type(8)));
typedef short s16x4 __attribute__((ext_vector_type(4)));
typedef float f32x4 __attribute__((ext_vector_type(4)));
typedef unsigned u32x4 __attribute__((ext_vector_type(4)));
typedef unsigned u32x2 __attribute__((ext_vector_type(2)));
#define LAS __attribute__((address_space(3)))
#define MFMA16(a, b, c) __builtin_amdgcn_mfma_f32_16x16x32_bf16((a), (b), (c), 0, 0, 0)

constexpr int MP = 16384, MALL = 16896, DM = 1024, DFF = 2752;
constexpr float EPSF = 1e-6f;
constexpr size_t OFF_MOD = 0;
constexpr size_t OFF_H = 9437184;
constexpr size_t OFF_WB = 44040192;
constexpr size_t OFF_WO = 50331648;
constexpr size_t OFF_SC = 52428800;
constexpr size_t OFF_ROPE = 52953088;
constexpr size_t OFF_C = 53215744;
constexpr size_t C_F = 0;
constexpr size_t C_ACT = 69206016;
constexpr size_t C_WADA = 0;
constexpr size_t C_PU = 0;
constexpr size_t C_KDT = 103809024;
constexpr size_t C_ACH = 137363456;
constexpr size_t C_PQ = 154140672;
constexpr size_t C_PKV = 188743680;
constexpr size_t C_KCS = 206045184;
constexpr size_t C_VTP = 215482368;
constexpr size_t C_VTS = 223870976;
constexpr size_t C_PBA = 234356736;
constexpr size_t C_SSQ = 235438080;
constexpr size_t C_GAM = 235978752;
constexpr size_t C_Y = C_KDT;
constexpr size_t C_W2GU = 166723584;
constexpr size_t C_W2D = 177995776;
constexpr size_t O_Y = 0, O_SWKP = 17301504, O_SWVP = 17432576, O_CONVP = 17563648, O_DELTAP = 17600512,
                 O_SWKS = 18124800, O_SWVS = 22319104, O_CONVS = 26513408, O_DELTAS = 27693056;
constexpr size_t T_W1GU = O_SWKS * 4;
constexpr size_t T_W1D = T_W1GU + 11272192;
constexpr size_t T_WA = T_W1D + 5636096;
constexpr size_t T_UP = O_SWKS * 4;
constexpr size_t C_HALO = 235986944;

struct Params {
    const float* x_p; const float* x_s; const float* cache_k; const float* cache_v; const float* st_conv; const float* st_delta;
    const float* c_p; const float* c_s; const float* w_ada; const float* b_ada;
    const float* n1pre; const float* n1post; const float* w1g; const float* w1u; const float* w1d;
    const float* nmpre; const float* nmpost; const float* w_in; const float* conv_w; const float* a_log; const float* dt_bias;
    const float* dn_norm; const float* sinks; const float* w_out;
    const float* n2pre; const float* n2post; const float* w2g; const float* w2u; const float* w2d;
    float* out; char* ws; int plo; int phi;
};

typedef __bf16 bf16v2_t __attribute__((ext_vector_type(2)));
typedef float f32v2_t __attribute__((ext_vector_type(2)));
DI unsigned pack2(float a, float b) { const f32v2_t v = {a, b}; return __builtin_bit_cast(unsigned, __builtin_convertvector(v, bf16v2_t)); }
DI unsigned f2bf(float x) { return pack2(x, 0.f) & 0xffffu; }
DI float bf2f(unsigned h) { return __uint_as_float(h << 16); }
DI float bflo(unsigned w) { return __uint_as_float(w << 16); }
DI float bfhi(unsigned w) { return __uint_as_float(w & 0xffff0000u); }
DI float sigm(float x) { return __builtin_amdgcn_rcpf(1.f + __expf(-x)); }
DI float siluf(float x) { return x * __builtin_amdgcn_rcpf(1.f + __expf(-x)); }
DI float softplusf(float x) { return fmaxf(x, 0.f) + log1pf(__expf(-fabsf(x))); }
DI bf16x8 pack8(const f32x4& a, const f32x4& b) {
    u32x4 p; p.x = pack2(a[0], a[1]); p.y = pack2(a[2], a[3]); p.z = pack2(b[0], b[1]); p.w = pack2(b[2], b[3]);
    return __builtin_bit_cast(bf16x8, p);
}
DI bf16x8 cat4(const s16x4& lo, const s16x4& hi) { return __builtin_shufflevector(lo, hi, 0, 1, 2, 3, 4, 5, 6, 7); }

template <int NT, class Epi>
DI void gemm_phase(const bf16_t* __restrict__ A, const bf16_t* __restrict__ Bt, int K, int nmt, int nnt, char* lds, const Epi& epi) {
    const int tid = threadIdx.x, lane = tid & 63, wid = tid >> 6, fr = lane & 15, fq = lane >> 4;
    const int wm = wid >> 1, wn = wid & 1;
    constexpr int BN = NT * 32;
    constexpr int BCH = BN / 32;
    const int ntiles = nmt * nnt, nk = K >> 6;
    const int srow = tid >> 3, spos = tid & 7;
    const bool xmap = nmt >= 16 && (gridDim.x & 7) == 0;
    const int xcd = blockIdx.x & 7;
    const int mlo = xmap ? (xcd * nmt) >> 3 : 0, mcnt = xmap ? (((xcd + 1) * nmt) >> 3) - mlo : nmt;
    const int estart = xmap ? (int)(blockIdx.x >> 3) : (int)blockIdx.x, estep = xmap ? (int)(gridDim.x >> 3) : (int)gridDim.x;
    const int etotal = xmap ? mcnt * nnt : ntiles;
    for (int e = estart; e < etotal; e += estep) {
        int mt, nt;
        if (xmap) {
            const int pg = mcnt * 8, ng = e / pg, nrem = nnt - ng * 8, gw = nrem < 8 ? nrem : 8, r = e - ng * pg, mi = r / gw;
            mt = mlo + mi; nt = ng * 8 + (r - mi * gw);
        } else { mt = e % nmt; nt = e / nmt; }
        const int m0 = mt * 128, n0 = nt * BN;
        f32x4 acc[4][NT];
#pragma unroll
        for (int m = 0; m < 4; ++m)
#pragma unroll
            for (int n = 0; n < NT; ++n) acc[m][n] = (f32x4){0.f, 0.f, 0.f, 0.f};
        const bf16_t* ag[4]; const bf16_t* bg[BCH];
#pragma unroll
        for (int i = 0; i < 4; ++i) { const int row = srow + 32 * i; ag[i] = A + (size_t)(m0 + row) * K + ((spos ^ ((row >> 1) & 7)) << 3); }
#pragma unroll
        for (int i = 0; i < BCH; ++i) { const int row = srow + 32 * i; bg[i] = Bt + (size_t)(n0 + row) * K + ((spos ^ ((row >> 1) & 7)) << 3); }
        __syncthreads();
#define GEMM_ISSUE(kt_, st_) do { \
        _Pragma("unroll") for (int i = 0; i < 4; ++i) __builtin_amdgcn_global_load_lds((const unsigned*)(ag[i] + (kt_) * 64), (LAS unsigned*)(lds + (st_) * 32768 + i * 4096 + wid * 1024), 16, 0, 0); \
        _Pragma("unroll") for (int i = 0; i < BCH; ++i) __builtin_amdgcn_global_load_lds((const unsigned*)(bg[i] + (kt_) * 64), (LAS unsigned*)(lds + (st_) * 32768 + 16384 + i * 4096 + wid * 1024), 16, 0, 0); } while (0)
        GEMM_ISSUE(0, 0);
        for (int kt = 0; kt < nk; ++kt) {
            asm volatile("s_waitcnt vmcnt(0)" ::: "memory");
            __syncthreads();
            if (kt + 1 < nk) GEMM_ISSUE(kt + 1, (kt + 1) & 1);
            const char* As = lds + (kt & 1) * 32768;
            const char* Bs = As + 16384;
            bf16x8 af[2][4], bfr[2][NT];
#pragma unroll
            for (int ks = 0; ks < 2; ++ks) {
                const int ch = ks * 4 + fq;
#pragma unroll
                for (int m = 0; m < 4; ++m) { const int row = wm * 64 + m * 16 + fr; af[ks][m] = *(const bf16x8*)(As + row * 128 + ((ch ^ ((row >> 1) & 7)) << 4)); }
#pragma unroll
                for (int n = 0; n < NT; ++n) { const int row = wn * NT * 16 + n * 16 + fr; bfr[ks][n] = *(const bf16x8*)(Bs + row * 128 + ((ch ^ ((row >> 1) & 7)) << 4)); }
            }
            __builtin_amdgcn_s_setprio(1);
#pragma unroll
            for (int ks = 0; ks < 2; ++ks)
#pragma unroll
                for (int m = 0; m < 4; ++m)
#pragma unroll
                    for (int n = 0; n < NT; ++n) acc[m][n] = MFMA16(bfr[ks][n], af[ks][m], acc[m][n]);
            __builtin_amdgcn_s_setprio(0);
        }
#undef GEMM_ISSUE
        epi(acc, m0 + wm * 64 + fr, n0, wn, fq, lane);
    }
}

struct EpiF32 {
    float* C; int ldc; const float* bias;
    DI void operator()(const f32x4 (&acc)[4][4], int rowb, int n0, int wn, int fq, int) const {
#pragma unroll
        for (int m = 0; m < 4; ++m)
#pragma unroll
            for (int n = 0; n < 4; ++n) {
                const int col = n0 + wn * 64 + n * 16 + 4 * fq;
                f32x4 v = acc[m][n];
                if (bias) { const f32x4 bv = *(const f32x4*)(bias + col); v = v + bv; }
                *(f32x4*)(C + (size_t)(rowb + m * 16) * ldc + col) = v;
            }
    }
};
struct EpiBf16 {
    bf16_t* O; int ldc;
    DI void operator()(const f32x4 (&acc)[4][4], int rowb, int n0, int wn, int fq, int) const {
#pragma unroll
        for (int m = 0; m < 4; ++m)
#pragma unroll
            for (int n = 0; n < 4; ++n) {
                const f32x4 v = acc[m][n]; u32x2 w; w.x = pack2(v[0], v[1]); w.y = pack2(v[2], v[3]);
                *(u32x2*)(O + (size_t)(rowb + m * 16) * ldc + n0 + wn * 64 + n * 16 + 4 * fq) = w;
            }
    }
};
struct EpiSwiglu {
    bf16_t* O;
    DI void operator()(const f32x4 (&acc)[4][4], int rowb, int n0, int wn, int fq, int) const {
        const int cb = (n0 >> 1) + wn * 32 + 4 * fq;
#pragma unroll
        for (int m = 0; m < 4; ++m)
#pragma unroll
            for (int n2 = 0; n2 < 2; ++n2) {
                const f32x4 g = acc[m][2 * n2], u = acc[m][2 * n2 + 1];
                u32x2 w; w.x = pack2(siluf(g[0]) * u[0], siluf(g[1]) * u[1]); w.y = pack2(siluf(g[2]) * u[2], siluf(g[3]) * u[3]);
                *(u32x2*)(O + (size_t)(rowb + m * 16) * DFF + cb + n2 * 16) = w;
            }
    }
};
struct EpiP {
    bf16_t* PU; bf16_t* PQ; bf16_t* PKV; float* PBA; const float* rope; bf16_t* HALO; float* out;
    DI void operator()(const f32x4 (&acc)[4][4], int rowb, int n0, int wn, int fq, int) const {
        if (n0 < 3072) {
#pragma unroll
            for (int m = 0; m < 4; ++m)
#pragma unroll
                for (int n = 0; n < 4; ++n) {
                    const f32x4 v = acc[m][n]; u32x2 w; w.x = pack2(v[0], v[1]); w.y = pack2(v[2], v[3]);
                    const int row = rowb + m * 16, col = n0 + wn * 64 + n * 16 + 4 * fq;
                    *(u32x2*)(PU + (size_t)row * 3072 + col) = w;
                    if ((row & 63) >= 61 && row < MP && (row & 4095) < 4032)
                        *(u32x2*)(HALO + ((size_t)((row >> 6) + 1) * 3 + ((row & 63) - 61)) * 3072 + col) = w;
                    if (row < MP && (row & 4095) >= 4093)
                        *(f32x4*)(out + O_CONVP + ((size_t)(row >> 12) * 3 + ((row & 4095) - 4093)) * 3072 + col) = v;
                }
        } else if (n0 < 4608) {
            const bool isq = n0 < 4096;
            const int cw = (isq ? n0 - 3072 : n0 - 4096) + wn * 64;
            const bool rot = isq || cw < 256;
            bf16_t* dst = isq ? PQ : PKV; const int ld = isq ? 1024 : 512;
#pragma unroll
            for (int m = 0; m < 4; ++m) {
                const int row = rowb + m * 16;
                const int pidx = row < MP ? (row & 4095) : 4096 + (row & 3);
                const float* tab = rope + pidx * 16 + 4 * (fq & 1);
#pragma unroll
                for (int n = 0; n < 4; ++n) {
                    f32x4 v = acc[m][n];
                    if (n == 0) {
                        f32x4 pr;
#pragma unroll
                        for (int j = 0; j < 4; ++j) pr[j] = __shfl_xor(v[j], 32);
                        if (rot) {
#pragma unroll
                            for (int j = 0; j < 4; ++j) { const float c = tab[j], s = tab[8 + j]; v[j] = (fq < 2) ? v[j] * c - pr[j] * s : v[j] * c + pr[j] * s; }
                        }
                    }
                    u32x2 w; w.x = pack2(v[0], v[1]); w.y = pack2(v[2], v[3]);
                    *(u32x2*)(dst + (size_t)row * ld + cw + n * 16 + 4 * fq) = w;
                    if (!isq && row < MP && (row & 4095) >= 3968) {
                        const int cc = cw + n * 16 + 4 * fq;
                        *(f32x4*)(out + (cc < 256 ? O_SWKP : O_SWVP) + ((size_t)(row >> 12) * 128 + ((row & 4095) - 3968)) * 256 + (cc & 255)) = v;
                    }
                }
            }
        } else {
            if (wn == 0) {
#pragma unroll
                for (int m = 0; m < 4; ++m) *(f32x4*)(PBA + (size_t)(rowb + m * 16) * 16 + 4 * fq) = acc[m][0];
            }
        }
    }
};
struct EpiMerge {
    const bf16_t* PU; const bf16_t* PQ; const float* dng; bf16_t* Y;
    DI void operator()(const f32x4 (&acc)[4][3], int rowb, int n0, int wn, int fq, int) const {
        const int c0 = (n0 / 96) * 32 + wn * 16 + 4 * fq;
        const f32x4 gn = *(const f32x4*)(dng + (c0 & 127));
        u32x4 ov[4][4];
#pragma unroll
        for (int m = 0; m < 4; ++m) {
            const bf16_t* op = PU + (size_t)(rowb + m * 16) * 3072 + 2048 + (c0 & ~127) + fq * 32;
#pragma unroll
            for (int i = 0; i < 4; ++i) ov[m][i] = *(const u32x4*)(op + i * 8);
        }
#pragma unroll
        for (int m = 0; m < 4; ++m) {
            const int row = rowb + m * 16;
            float ss = 0.f;
#pragma unroll
            for (int i = 0; i < 4; ++i)
#pragma unroll
                for (int e = 0; e < 4; ++e) { const float a = bflo(ov[m][i][e]), b = bfhi(ov[m][i][e]); ss += a * a + b * b; }
            ss += __shfl_xor(ss, 16); ss += __shfl_xor(ss, 32);
            const float rstd = rsqrtf(ss * (1.f / 128.f) + EPSF);
            const u32x2 ou = *(const u32x2*)(PU + (size_t)row * 3072 + 2048 + c0);
            const u32x2 os = *(const u32x2*)(PQ + (size_t)row * 1024 + c0);
            const float od[4] = {bflo(ou.x), bfhi(ou.x), bflo(ou.y), bfhi(ou.y)};
            const float sw[4] = {bflo(os.x), bfhi(os.x), bflo(os.y), bfhi(os.y)};
            float y[4];
#pragma unroll
            for (int j = 0; j < 4; ++j) y[j] = sigm(acc[m][1][j]) * (od[j] * rstd * gn[j]) * siluf(acc[m][0][j]) + sigm(acc[m][2][j]) * sw[j];
            u32x2 w; w.x = pack2(y[0], y[1]); w.y = pack2(y[2], y[3]);
            *(u32x2*)(Y + (size_t)row * 1024 + c0) = w;
        }
    }
};

struct CvtJob { const float* src; int ld; int K; int col0; int ncols; bf16_t* dst; int G; int which; int rowbase; };
DI int job_tiles(const CvtJob& j) { return ((j.ncols + 63) >> 6) * (j.K >> 6); }
DI void cvt_tile(const CvtJob& j, int t, char* lds) {
    float* tl = (float*)lds;
    const int tid = threadIdx.x;
    const int nkt = j.K >> 6, ct = t / nkt, kt = t % nkt, c0 = ct * 64, k0 = kt * 64;
    __syncthreads();
#pragma unroll
    for (int i = 0; i < 4; ++i) {
        const int kr = (tid >> 4) + 16 * i, col = (tid & 15) * 4;
        f32x4 v = (f32x4){0.f, 0.f, 0.f, 0.f};
        if (c0 + col < j.ncols) v = *(const f32x4*)(j.src + (size_t)(k0 + kr) * j.ld + j.col0 + c0 + col);
        tl[kr * 65 + col] = v[0]; tl[kr * 65 + col + 1] = v[1]; tl[kr * 65 + col + 2] = v[2]; tl[kr * 65 + col + 3] = v[3];
    }
    __syncthreads();
#pragma unroll
    for (int i = 0; i < 2; ++i) {
        const int col = (tid >> 3) + 32 * i, ch = tid & 7, jc = c0 + col;
        if (jc < j.ncols) {
            const int drow = j.rowbase + (jc >> 4) * (j.G * 16) + j.which * 16 + (jc & 15);
            u32x4 w;
            w.x = pack2(tl[(ch * 8 + 0) * 65 + col], tl[(ch * 8 + 1) * 65 + col]);
            w.y = pack2(tl[(ch * 8 + 2) * 65 + col], tl[(ch * 8 + 3) * 65 + col]);
            w.z = pack2(tl[(ch * 8 + 4) * 65 + col], tl[(ch * 8 + 5) * 65 + col]);
            w.w = pack2(tl[(ch * 8 + 6) * 65 + col], tl[(ch * 8 + 7) * 65 + col]);
            *(u32x4*)(j.dst + (size_t)drow * j.K + k0 + ch * 8) = w;
        }
    }
}
DI CvtJob get_job(const Params& p, int id) {
    char* ws = p.ws; char* ob = (char*)p.out;
    bf16_t* W1GU = (bf16_t*)(ob + T_W1GU); bf16_t* W1D = (bf16_t*)(ob + T_W1D); bf16_t* WA = (bf16_t*)(ob + T_WA);
    bf16_t* WB = (bf16_t*)(ws + OFF_WB); bf16_t* WO = (bf16_t*)(ws + OFF_WO); bf16_t* WADA = (bf16_t*)(ws + OFF_C + C_WADA);
    bf16_t* W2GU = (bf16_t*)(ws + OFF_C + C_W2GU); bf16_t* W2D = (bf16_t*)(ws + OFF_C + C_W2D);
    switch (id) {
        case 0: return CvtJob{p.w1g, DFF, 1024, 0, DFF, W1GU, 2, 0, 0};
        case 1: return CvtJob{p.w1u, DFF, 1024, 0, DFF, W1GU, 2, 1, 0};
        case 2: return CvtJob{p.w1d, 1024, DFF, 0, 1024, W1D, 1, 0, 0};
        case 3: return CvtJob{p.w_in, 7696, 1024, 0, 3072, WA, 1, 0, 0};
        case 4: return CvtJob{p.w_in, 7696, 1024, 3072, 1024, WB, 3, 0, 0};
        case 5: return CvtJob{p.w_in, 7696, 1024, 4096, 16, WA, 1, 0, 4608};
        case 6: return CvtJob{p.w_in, 7696, 1024, 4112, 1024, WA, 1, 0, 3072};
        case 7: return CvtJob{p.w_in, 7696, 1024, 5136, 256, WA, 1, 0, 4096};
        case 8: return CvtJob{p.w_in, 7696, 1024, 5392, 256, WA, 1, 0, 4352};
        case 9: return CvtJob{p.w_in, 7696, 1024, 5648, 1024, WB, 3, 1, 0};
        case 10: return CvtJob{p.w_in, 7696, 1024, 6672, 1024, WB, 3, 2, 0};
        case 11: return CvtJob{p.w_out, 1024, 1024, 0, 1024, WO, 1, 0, 0};
        case 12: return CvtJob{p.w_ada, 9216, 1024, 0, 9216, WADA, 1, 0, 0};
        case 13: return CvtJob{p.w2g, DFF, 1024, 0, DFF, W2GU, 2, 0, 0};
        case 14: return CvtJob{p.w2u, DFF, 1024, 0, DFF, W2GU, 2, 1, 0};
        default: return CvtJob{p.w2d, 1024, DFF, 0, 1024, W2D, 1, 0, 0};
    }
}
template <int JLO, int JHI>
DI void cvt_jobs(const Params& p, char* lds) {
    int base = 0;
#pragma unroll
    for (int id = JLO; id < JHI; ++id) {
        const CvtJob j = get_job(p, id);
        const int nt = job_tiles(j);
        int first = ((int)blockIdx.x - base) % (int)gridDim.x; if (first < 0) first += gridDim.x;
        for (int t = first; t < nt; t += gridDim.x) cvt_tile(j, t, lds);
        base += nt;
    }
    __syncthreads();
}

DI void phase_prologue(const Params& p, char* lds) {
    cvt_jobs<0, 13>(p, lds);
    const int gtid = blockIdx.x * 256 + threadIdx.x, gsz = gridDim.x * 256;
    bf16_t* SC = (bf16_t*)(p.ws + OFF_SC);
    for (int i = gtid; i < 256 * 1024; i += gsz) {
        const int row = i >> 10, col = i & 1023;
        float v = 0.f;
        if (row < 4) v = siluf(p.c_p[row * 1024 + col]); else if (row < 132) v = siluf(p.c_s[(row - 4) * 1024 + col]);
        SC[i] = (bf16_t)f2bf(v);
    }
    float* rope = (float*)(p.ws + OFF_ROPE);
    for (int i = gtid; i < 4100 * 8; i += gsz) {
        const int pi = i >> 3, k = i & 7;
        const float pos = (float)(pi < 4096 ? pi : 8192 + (pi - 4096));
        const float invf = (float)exp(-(double)k * 0.125 * log(500000.0));
        const float ang = pos * invf;
        rope[pi * 16 + k] = (float)cos((double)ang);
        rope[pi * 16 + 8 + k] = (float)sin((double)ang);
    }
}

DI void norm_phase(const Params& p, bool x_from_input, const bf16_t* f, int gate_i, float gcoef, const float* post,
                   bool write_x, const float* pre, int sh_i, int sc_i) {
    const int lane = threadIdx.x & 63, wid = threadIdx.x >> 6;
    const float* MOD = (const float*)(p.ws + OFF_MOD);
    bf16_t* H = (bf16_t*)(p.ws + OFF_H);
    for (int row = blockIdx.x * 4 + wid; row < MALL; row += gridDim.x * 4) {
        const int cidx = row < MP ? (row >> 12) : 4 + ((row - MP) >> 2);
        const float* mrow = MOD + (size_t)cidx * 9216;
        const float* xr = x_from_input ? (row < MP ? p.x_p + (size_t)row * 1024 : p.x_s + (size_t)(row - MP) * 1024) : p.out + (size_t)row * 1024;
        f32x4 x[4];
#pragma unroll
        for (int i = 0; i < 4; ++i) x[i] = *(const f32x4*)(xr + lane * 4 + 256 * i);
        if (f) {
            f32x4 fv[4]; float ss = 0.f;
#pragma unroll
            for (int i = 0; i < 4; ++i) { const u32x2 fw = *(const u32x2*)(f + (size_t)row * 1024 + lane * 4 + 256 * i);
                fv[i] = (f32x4){bflo(fw.x), bfhi(fw.x), bflo(fw.y), bfhi(fw.y)}; ss += fv[i][0] * fv[i][0] + fv[i][1] * fv[i][1] + fv[i][2] * fv[i][2] + fv[i][3] * fv[i][3]; }
#pragma unroll
            for (int o = 32; o > 0; o >>= 1) ss += __shfl_xor(ss, o);
            const float rstd = rsqrtf(ss * (1.f / 1024.f) + EPSF);
#pragma unroll
            for (int i = 0; i < 4; ++i) {
                const int col = lane * 4 + 256 * i;
                const f32x4 g = *(const f32x4*)(mrow + gate_i * 1024 + col), pg = *(const f32x4*)(post + col);
#pragma unroll
                for (int j = 0; j < 4; ++j) x[i][j] += gcoef * g[j] * (fv[i][j] * rstd * pg[j]);
            }
        }
        if (write_x) {
#pragma unroll
            for (int i = 0; i < 4; ++i) *(f32x4*)(p.out + (size_t)row * 1024 + lane * 4 + 256 * i) = x[i];
        }
        if (pre) {
            float ss = 0.f;
#pragma unroll
            for (int i = 0; i < 4; ++i) ss += x[i][0] * x[i][0] + x[i][1] * x[i][1] + x[i][2] * x[i][2] + x[i][3] * x[i][3];
#pragma unroll
            for (int o = 32; o > 0; o >>= 1) ss += __shfl_xor(ss, o);
            const float rstd = rsqrtf(ss * (1.f / 1024.f) + EPSF);
#pragma unroll
            for (int i = 0; i < 4; ++i) {
                const int col = lane * 4 + 256 * i;
                const f32x4 pg = *(const f32x4*)(pre + col), sh = *(const f32x4*)(mrow + sh_i * 1024 + col), sc = *(const f32x4*)(mrow + sc_i * 1024 + col);
                float h[4];
#pragma unroll
                for (int j = 0; j < 4; ++j) h[j] = x[i][j] * rstd * pg[j] * (1.f + sc[j]) + sh[j];
                u32x2 w; w.x = pack2(h[0], h[1]); w.y = pack2(h[2], h[3]);
                *(u32x2*)(H + (size_t)row * 1024 + col) = w;
            }
        }
    }
}

DI void phase_mixprep(const Params& p, char* lds) {
    char* C = p.ws + OFF_C;
    const bf16_t* PKV = (const bf16_t*)(C + C_PKV);
    bf16_t* KCS = (bf16_t*)(C + C_KCS); bf16_t* VTP = (bf16_t*)(C + C_VTP); bf16_t* VTS = (bf16_t*)(C + C_VTS);
    float* SSQ = (float*)(C + C_SSQ);
    const int tid = threadIdx.x, gtid = blockIdx.x * 256 + tid, gsz = gridDim.x * 256;
    bf16_t* tl = (bf16_t*)lds;
    for (int t = blockIdx.x; t < 1024; t += gridDim.x) {
        const int b = t >> 8, cb = (t >> 6) & 3, tb = t & 63;
        __syncthreads();
#pragma unroll
        for (int i = 0; i < 16; ++i) { const int tr = (tid >> 6) + 4 * i, col = tid & 63; tl[tr * 66 + col] = PKV[(size_t)(b * 4096 + tb * 64 + tr) * 512 + 256 + cb * 64 + col]; }
        __syncthreads();
#pragma unroll
        for (int i = 0; i < 2; ++i) {
            const int col = (tid >> 3) + 32 * i, ch = tid & 7;
            u32x4 w;
            w.x = tl[(ch * 8 + 0) * 66 + col] | ((unsigned)tl[(ch * 8 + 1) * 66 + col] << 16);
            w.y = tl[(ch * 8 + 2) * 66 + col] | ((unsigned)tl[(ch * 8 + 3) * 66 + col] << 16);
            w.z = tl[(ch * 8 + 4) * 66 + col] | ((unsigned)tl[(ch * 8 + 5) * 66 + col] << 16);
            w.w = tl[(ch * 8 + 6) * 66 + col] | ((unsigned)tl[(ch * 8 + 7) * 66 + col] << 16);
            *(u32x4*)(VTP + (size_t)(b * 256 + cb * 64 + col) * 4096 + tb * 64 + ch * 8) = w;
        }
    }
    for (int t = blockIdx.x; t < 512; t += gridDim.x) {
        const int seq = t >> 2, cb = t & 3;
        __syncthreads();
        for (int i = tid; i < 160 * 64; i += 256) {
            const int s = i >> 6, col = i & 63;
            unsigned v = 0;
            if (s < 128) v = f2bf(p.cache_v[(size_t)(seq * 128 + s) * 256 + cb * 64 + col]);
            else if (s < 132) v = PKV[(size_t)(MP + seq * 4 + s - 128) * 512 + 256 + cb * 64 + col];
            tl[s * 66 + col] = (bf16_t)v;
        }
        __syncthreads();
        for (int i = tid; i < 64 * 20; i += 256) {
            const int col = i / 20, ch = i % 20;
            u32x4 w;
            w.x = tl[(ch * 8 + 0) * 66 + col] | ((unsigned)tl[(ch * 8 + 1) * 66 + col] << 16);
            w.y = tl[(ch * 8 + 2) * 66 + col] | ((unsigned)tl[(ch * 8 + 3) * 66 + col] << 16);
            w.z = tl[(ch * 8 + 4) * 66 + col] | ((unsigned)tl[(ch * 8 + 5) * 66 + col] << 16);
            w.w = tl[(ch * 8 + 6) * 66 + col] | ((unsigned)tl[(ch * 8 + 7) * 66 + col] << 16);
            *(u32x4*)(VTS + (size_t)(seq * 256 + cb * 64 + col) * 160 + ch * 8) = w;
        }
    }
    __syncthreads();
    for (int i = gtid; i < 128 * 144 * 32; i += gsz) {
        const int ch = i & 31, slot = (i >> 5) % 144, seq = (i >> 5) / 144;
        u32x4 w = (u32x4){0u, 0u, 0u, 0u};
        if (slot < 128) {
            const float* s = p.cache_k + (size_t)(seq * 128 + slot) * 256 + ch * 8;
            const f32x4 a = *(const f32x4*)s, b = *(const f32x4*)(s + 4);
            w.x = pack2(a[0], a[1]); w.y = pack2(a[2], a[3]); w.z = pack2(b[0], b[1]); w.w = pack2(b[2], b[3]);
        } else if (slot < 132) w = *(const u32x4*)(PKV + (size_t)(MP + seq * 4 + slot - 128) * 512 + ch * 8);
        *(u32x4*)(KCS + (size_t)i * 8) = w;
    }
}

DI void prep_item(const Params& p, int item, char* lds) {
    char* C = p.ws + OFF_C;
    bf16_t* PU = (bf16_t*)(C + C_PU);
    const float* PBA = (const float*)(C + C_PBA);
    bf16_t* KDT = (bf16_t*)(C + C_KDT); bf16_t* ACH = (bf16_t*)(C + C_ACH); float* GAM = (float*)(C + C_GAM);
    const bf16_t* HALO = (const bf16_t*)(C + C_HALO);
    bf16_t* UP = (bf16_t*)((char*)p.out + T_UP);
    int tid = threadIdx.x; asm volatile("" : "+v"(tid));
    const int lane = tid & 63, wid = tid >> 6, fr = lane & 15, fq = lane >> 4;
    const int b = item >> 9, n = (item >> 3) & 63, h = item & 7;
    const int r0 = b * 4096 + n * 64;
    char* Qt = lds; char* Kt = lds + 16384;
    float* Ls = (float*)(lds + 32768);
    float* gc = (float*)(lds + 50176); float* be = gc + 64; float* eg = be + 64;
    const bf16_t* halo = HALO + (size_t)(b * 64 + n) * 3 * 3072;
    __syncthreads();
    {
        const int slot = tid >> 4, l16 = tid & 15, which = slot & 1, rsub = slot >> 1;
        const int cbase = which * 1024 + h * 128 + l16 * 8;
        float w[4][8];
#pragma unroll
        for (int t = 0; t < 4; ++t) {
            const f32x4 a = *(const f32x4*)(p.conv_w + t * 3072 + cbase), bb = *(const f32x4*)(p.conv_w + t * 3072 + cbase + 4);
#pragma unroll
            for (int e = 0; e < 4; ++e) { w[t][e] = a[e]; w[t][4 + e] = bb[e]; }
        }
        const float qs = which == 0 ? 0.08838834764831845f : 1.f;
        for (int ps = 0; ps < 8; ++ps) {
            const int i = ps * 8 + rsub;
            float y[8];
#pragma unroll
            for (int e = 0; e < 8; ++e) y[e] = 0.f;
#pragma unroll
            for (int t = 0; t < 4; ++t) {
                const int tr = i - 3 + t;
                const bf16_t* src = tr < 0 ? halo + (3 + tr) * 3072 + cbase : PU + (size_t)(r0 + tr) * 3072 + cbase;
                u32x4 v = *(const u32x4*)src;
                if (tr < 0 && n == 0) v = (u32x4){0u, 0u, 0u, 0u};
                y[0] += w[t][0] * bflo(v.x); y[1] += w[t][1] * bfhi(v.x); y[2] += w[t][2] * bflo(v.y); y[3] += w[t][3] * bfhi(v.y);
                y[4] += w[t][4] * bflo(v.z); y[5] += w[t][5] * bfhi(v.z); y[6] += w[t][6] * bflo(v.w); y[7] += w[t][7] * bfhi(v.w);
            }
            float ss = 0.f;
#pragma unroll
            for (int e = 0; e < 8; ++e) { y[e] = siluf(y[e]); ss += y[e] * y[e]; }
            ss += __shfl_xor(ss, 1); ss += __shfl_xor(ss, 2); ss += __shfl_xor(ss, 4); ss += __shfl_xor(ss, 8);
            const float sc = rsqrtf(ss + EPSF) * qs;
            u32x4 o; o.x = pack2(y[0] * sc, y[1] * sc); o.y = pack2(y[2] * sc, y[3] * sc); o.z = pack2(y[4] * sc, y[5] * sc); o.w = pack2(y[6] * sc, y[7] * sc);
            *(u32x4*)((which ? Kt : Qt) + i * 256 + ((l16 ^ (i & 15)) << 4)) = o;
        }
    }
    if (wid == 0) {
        const float braw = PBA[(size_t)(r0 + lane) * 16 + h], araw = PBA[(size_t)(r0 + lane) * 16 + 8 + h];
        float g = -__expf(p.a_log[h]) * softplusf(araw + p.dt_bias[h]);
#pragma unroll
        for (int o = 1; o < 64; o <<= 1) { const float t = __shfl_up(g, o); if (lane >= o) g += t; }
        gc[lane] = g; be[lane] = sigm(braw); eg[lane] = __expf(g);
    }
    __syncthreads();
    {
        f32x4 ak[4], aq[4];
#pragma unroll
        for (int nj = 0; nj < 4; ++nj) { ak[nj] = (f32x4){0.f, 0.f, 0.f, 0.f}; aq[nj] = ak[nj]; }
#pragma unroll
        for (int ks = 0; ks < 4; ++ks) {
            const int ri = wid * 16 + fr, ch = ks * 4 + fq;
            const bf16x8 fk = *(const bf16x8*)(Kt + ri * 256 + ((ch ^ (ri & 15)) << 4));
            const bf16x8 fqq = *(const bf16x8*)(Qt + ri * 256 + ((ch ^ (ri & 15)) << 4));
#pragma unroll
            for (int nj = 0; nj < 4; ++nj) {
                const int rj = nj * 16 + fr;
                const bf16x8 fb = *(const bf16x8*)(Kt + rj * 256 + ((ch ^ (rj & 15)) << 4));
                ak[nj] = MFMA16(fk, fb, ak[nj]);
                aq[nj] = MFMA16(fqq, fb, aq[nj]);
            }
        }
#pragma unroll
        for (int nj = 0; nj < 4; ++nj)
#pragma unroll
            for (int jj = 0; jj < 4; ++jj) {
                const int i = wid * 16 + 4 * fq + jj, j = nj * 16 + fr;
                const float dec = __expf(fminf(gc[i] - gc[j], 0.f));
                Ls[i * 68 + j] = i > j ? be[i] * ak[nj][jj] * dec : 0.f;
                ACH[(size_t)item * 4096 + i * 64 + j] = (bf16_t)f2bf(i >= j ? aq[nj][jj] * dec : 0.f);
            }
    }
    __syncthreads();
    asm volatile("" : "+v"(tid));
    float x[64];
    if (tid < 128) {
        const int cv = 2048 + h * 128 + tid;
        const float w0 = p.conv_w[cv], w1 = p.conv_w[3072 + cv], w2 = p.conv_w[2 * 3072 + cv], w3 = p.conv_w[3 * 3072 + cv];
        float xm3 = bf2f(halo[cv]), xm2 = bf2f(halo[3072 + cv]), xm1 = bf2f(halo[2 * 3072 + cv]);
        if (n == 0) { xm3 = 0.f; xm2 = 0.f; xm1 = 0.f; }
#pragma unroll
        for (int i = 0; i < 64; ++i) {
            const float xi = bf2f(PU[(size_t)(r0 + i) * 3072 + cv]);
            x[i] = siluf(w0 * xm3 + w1 * xm2 + w2 * xm1 + w3 * xi) * be[i];
            xm3 = xm2; xm2 = xm1; xm1 = xi;
            if ((i & 15) == 15) __builtin_amdgcn_sched_barrier(0);
        }
    } else {
        const int ck = tid - 128;
#pragma unroll
        for (int i = 0; i < 64; ++i) {
            const bf16_t kv = *(const bf16_t*)(Kt + i * 256 + (((ck >> 3) ^ (i & 15)) << 4) + (ck & 7) * 2);
            x[i] = bf2f(kv) * be[i] * eg[i];
            if ((i & 15) == 15) __builtin_amdgcn_sched_barrier(0);
        }
    }
#pragma unroll
    for (int i = 1; i < 64; ++i) {
        float a = x[i];
#pragma unroll
        for (int j4 = 0; j4 < (i + 3) / 4; ++j4) {
            const f32x4 l = *(const f32x4*)(Ls + i * 68 + j4 * 4);
            a -= l[0] * x[j4 * 4];
            if (j4 * 4 + 1 < i) a -= l[1] * x[j4 * 4 + 1];
            if (j4 * 4 + 2 < i) a -= l[2] * x[j4 * 4 + 2];
            if (j4 * 4 + 3 < i) a -= l[3] * x[j4 * 4 + 3];
        }
        x[i] = a;
        if ((i & 3) == 3) __builtin_amdgcn_sched_barrier(0);
    }
    __syncthreads();
    asm volatile("" : "+v"(tid));
    if (tid < 128) {
        const int sl = tid >> 4, f16 = tid & 15;
#pragma unroll
        for (int q4 = 0; q4 < 4; ++q4) {
            bf16_t* dst = UP + (((size_t)item * 8 + sl) * 64 + q4 * 16 + f16) * 16;
            u32x4 a, bq;
            a.x = pack2(x[0 + 4 * q4 + 0], x[0 + 4 * q4 + 1]); a.y = pack2(x[0 + 4 * q4 + 2], x[0 + 4 * q4 + 3]);
            a.z = pack2(x[16 + 4 * q4 + 0], x[16 + 4 * q4 + 1]); a.w = pack2(x[16 + 4 * q4 + 2], x[16 + 4 * q4 + 3]);
            bq.x = pack2(x[32 + 4 * q4 + 0], x[32 + 4 * q4 + 1]); bq.y = pack2(x[32 + 4 * q4 + 2], x[32 + 4 * q4 + 3]);
            bq.z = pack2(x[48 + 4 * q4 + 0], x[48 + 4 * q4 + 1]); bq.w = pack2(x[48 + 4 * q4 + 2], x[48 + 4 * q4 + 3]);
            *(u32x4*)dst = a; *(u32x4*)(dst + 8) = bq;
        }
    } else {
        const unsigned off = (unsigned)r0 * 3072u + 1024u + h * 128u + (tid - 128);
#pragma unroll
        for (int i = 0; i < 64; ++i) PU[off + (unsigned)i * 3072u] = (bf16_t)f2bf(x[i]);
    }
    {
        const int i = tid >> 2, part = tid & 3;
        const float e = eg[i];
#pragma unroll
        for (int c4 = 0; c4 < 4; ++c4) {
            const int ch = part * 4 + c4;
            const u32x4 v = *(const u32x4*)(Qt + i * 256 + ((ch ^ (i & 15)) << 4));
            u32x4 o;
            o.x = pack2(bflo(v.x) * e, bfhi(v.x) * e); o.y = pack2(bflo(v.y) * e, bfhi(v.y) * e);
            o.z = pack2(bflo(v.z) * e, bfhi(v.z) * e); o.w = pack2(bflo(v.w) * e, bfhi(v.w) * e);
            *(u32x4*)(PU + (size_t)(r0 + i) * 3072 + h * 128 + ch * 8) = o;
        }
    }
    {
        const int dk = tid & 127, ih = tid >> 7;
        const float gl = gc[63];
#pragma unroll
        for (int c4 = 0; c4 < 4; ++c4) {
            float v[8];
#pragma unroll
            for (int e = 0; e < 8; ++e) {
                const int i = ih * 32 + c4 * 8 + e;
                const bf16_t kv = *(const bf16_t*)(Kt + i * 256 + (((dk >> 3) ^ (i & 15)) << 4) + (dk & 7) * 2);
                v[e] = bf2f(kv) * __expf(gl - gc[i]);
            }
            u32x4 o; o.x = pack2(v[0], v[1]); o.y = pack2(v[2], v[3]); o.z = pack2(v[4], v[5]); o.w = pack2(v[6], v[7]);
            *(u32x4*)(KDT + ((size_t)item * 128 + dk) * 64 + ih * 32 + c4 * 8) = o;
        }
        if (tid == 0) GAM[item] = __expf(gl);
    }
}

DI bf16x8 frag_perm(const char* base, int rowbytes, int row, int c0, int fq) {
    const char* q = base + row * rowbytes + (c0 + 4 * fq) * 2;
    const s16x4 lo = *(const s16x4*)q, hi = *(const s16x4*)(q + 32);
    return cat4(lo, hi);
}
#define LDS_BARRIER() do { asm volatile("s_waitcnt lgkmcnt(0)" ::: "memory"); __builtin_amdgcn_s_barrier(); asm volatile("" ::: "memory"); } while (0)
DI void scan_block(const Params& p, int blk, char* lds) {
    char* C = p.ws + OFF_C;
    bf16_t* PU = (bf16_t*)(C + C_PU);
    const bf16_t* KDT = (const bf16_t*)(C + C_KDT); const bf16_t* ACH = (const bf16_t*)(C + C_ACH); const float* GAM = (const float*)(C + C_GAM);
    float* SSQ = (float*)(C + C_SSQ);
    const bf16_t* UP = (const bf16_t*)((const char*)p.out + T_UP);
    const int tid = threadIdx.x, lane = tid & 63, wid = tid >> 6, fr = lane & 15, fq = lane >> 4;
    const int bh = blk & 31, half = blk >> 5, b = bh >> 3, h = bh & 7;
    const int dvb = half * 64 + wid * 16;
    char* Wt = lds; char* Qt = lds + 17408; char* At = lds + 34816; char* Kd = lds + 43520;
    f32x4 S[8];
#pragma unroll
    for (int t = 0; t < 8; ++t) S[t] = (f32x4){0.f, 0.f, 0.f, 0.f};
    u32x4 rW[4], rQ[4], rA[2], rK[4];
    u32x4 rU[2];
    float gam;
#define SCAN_LOAD(nn) do { \
        int tid = threadIdx.x; asm volatile("" : "+v"(tid)); const int lane = tid & 63, wid = tid >> 6; \
        const int r0n_ = b * 4096 + (nn) * 64; const size_t it_ = (size_t)((b * 64 + (nn)) * 8 + h); \
        _Pragma("unroll") for (int i = 0; i < 4; ++i) { const int id = tid + 256 * i, row = id >> 4, ch = id & 15; \
            rW[i] = *(const u32x4*)(PU + (size_t)(r0n_ + row) * 3072 + 1024 + h * 128 + ch * 8); \
            rQ[i] = *(const u32x4*)(PU + (size_t)(r0n_ + row) * 3072 + h * 128 + ch * 8); } \
        _Pragma("unroll") for (int i = 0; i < 2; ++i) { const int id = tid + 256 * i; rA[i] = *(const u32x4*)(ACH + it_ * 4096 + (size_t)id * 8); } \
        _Pragma("unroll") for (int i = 0; i < 4; ++i) { const int id = tid + 256 * i; rK[i] = *(const u32x4*)(KDT + it_ * 8192 + (size_t)id * 8); } \
        { const bf16_t* up_ = UP + ((it_ * 8 + half * 4 + wid) * 64 + lane) * 16; rU[0] = *(const u32x4*)up_; rU[1] = *(const u32x4*)(up_ + 8); } \
        gam = GAM[it_]; } while (0)
    SCAN_LOAD(0);
    __syncthreads();
    for (int n = 0; n < 64; ++n) {
        const int r0 = b * 4096 + n * 64;
        int tid = threadIdx.x; asm volatile("" : "+v"(tid));
#pragma unroll
        for (int i = 0; i < 4; ++i) { const int id = tid + 256 * i, row = id >> 4, ch = id & 15;
            *(u32x4*)(Wt + row * 272 + ch * 16) = rW[i]; *(u32x4*)(Qt + row * 272 + ch * 16) = rQ[i]; }
#pragma unroll
        for (int i = 0; i < 2; ++i) { const int id = tid + 256 * i, row = id >> 3, ch = id & 7; char* q = At + row * 136 + ch * 16;
            *(u32x2*)q = (u32x2){rA[i].x, rA[i].y}; *(u32x2*)(q + 8) = (u32x2){rA[i].z, rA[i].w}; }
#pragma unroll
        for (int i = 0; i < 4; ++i) { const int id = tid + 256 * i, row = id >> 3, ch = id & 7; char* q = Kd + row * 136 + ch * 16;
            *(u32x2*)q = (u32x2){rK[i].x, rK[i].y}; *(u32x2*)(q + 8) = (u32x2){rK[i].z, rK[i].w}; }
        float uc[16];
#pragma unroll
        for (int i = 0; i < 8; ++i) { const unsigned w = i < 4 ? rU[0][i] : rU[1][i - 4]; uc[2 * i] = bflo(w); uc[2 * i + 1] = bfhi(w); }
        const float gcur = gam;
        LDS_BARRIER();
        if (n + 1 < 64) SCAN_LOAD(n + 1);
        bf16x8 Sb[4];
#pragma unroll
        for (int ks = 0; ks < 4; ++ks) Sb[ks] = pack8(S[2 * ks], S[2 * ks + 1]);
        f32x4 aw[4], ao[4];
#pragma unroll
        for (int m = 0; m < 4; ++m) { aw[m] = (f32x4){0.f, 0.f, 0.f, 0.f}; ao[m] = aw[m]; }
#pragma unroll
        for (int ks = 0; ks < 4; ++ks)
#pragma unroll
            for (int m = 0; m < 4; ++m) aw[m] = MFMA16(frag_perm(Wt, 272, 16 * m + fr, 32 * ks, fq), Sb[ks], aw[m]);
#pragma unroll
        for (int ks = 0; ks < 4; ++ks)
#pragma unroll
            for (int m = 0; m < 4; ++m) ao[m] = MFMA16(frag_perm(Qt, 272, 16 * m + fr, 32 * ks, fq), Sb[ks], ao[m]);
        f32x4 vn[4];
#pragma unroll
        for (int m = 0; m < 4; ++m)
#pragma unroll
            for (int jj = 0; jj < 4; ++jj) vn[m][jj] = uc[m * 4 + jj] - aw[m][jj];
        bf16x8 Vb[2];
        Vb[0] = pack8(vn[0], vn[1]); Vb[1] = pack8(vn[2], vn[3]);
#pragma unroll
        for (int t = 0; t < 8; ++t) S[t] = S[t] * gcur;
#pragma unroll
        for (int k2 = 0; k2 < 2; ++k2) {
#pragma unroll
            for (int m = 2 * k2; m < 4; ++m) ao[m] = MFMA16(frag_perm(At, 136, 16 * m + fr, 32 * k2, fq), Vb[k2], ao[m]);
#pragma unroll
            for (int t = 0; t < 8; ++t) S[t] = MFMA16(frag_perm(Kd, 136, 16 * t + fr, 32 * k2, fq), Vb[k2], S[t]);
        }
#pragma unroll
        for (int m = 0; m < 4; ++m)
#pragma unroll
            for (int j2 = 0; j2 < 2; ++j2) {
                const unsigned w = pack2(ao[m][2 * j2], ao[m][2 * j2 + 1]);
                const unsigned ob = (unsigned)(r0 + 4 * fq) * 3072u + 2048u + h * 128u + dvb + fr + (unsigned)(16 * m + 2 * j2) * 3072u;
                PU[ob] = (bf16_t)(w & 0xffffu); PU[ob + 3072u] = (bf16_t)(w >> 16);
            }
        LDS_BARRIER();
    }
#undef SCAN_LOAD
#pragma unroll
    for (int t = 0; t < 8; ++t)
#pragma unroll
        for (int jj = 0; jj < 4; ++jj)
            p.out[O_DELTAP + ((size_t)(b * 8 + h) * 128 + 16 * t + 4 * fq + jj) * 128 + dvb + fr] = S[t][jj];
}

DI void sdelta_item(const Params& p, int item, char* lds) {
    char* C = p.ws + OFF_C;
    bf16_t* PU = (bf16_t*)(C + C_PU);
    const float* PBA = (const float*)(C + C_PBA);
    float* SSQ = (float*)(C + C_SSQ);
    const int tid = threadIdx.x, lane = tid & 63, wid = tid >> 6;
    const int seq = item >> 3, h = item & 7, rs = MP + seq * 4;
    float* qs = (float*)lds;
    float* ks = qs + 512; float* vs = ks + 512;
    float* red = vs + 512;
    float* bt = red + 16; float* al = bt + 4;
    float* kSp = al + 4;
    float* op = kSp + 1024;
    const int ch = tid & 127, part = tid >> 7;
    __syncthreads();
    float yq[4];
    {
        const int nch = part == 0 ? 2 : 1;
        for (int cc = 0; cc < nch; ++cc) {
            const int c = part == 1 ? 1024 + h * 128 + ch : (cc == 0 ? h * 128 + ch : 2048 + h * 128 + ch);
            float full[7];
#pragma unroll
            for (int i = 0; i < 3; ++i) full[i] = p.st_conv[(size_t)(seq * 3 + i) * 3072 + c];
#pragma unroll
            for (int i = 0; i < 4; ++i) full[3 + i] = bf2f(PU[(size_t)(rs + i) * 3072 + c]);
#pragma unroll
            for (int i = 0; i < 3; ++i) p.out[O_CONVS + (size_t)(seq * 3 + i) * 3072 + c] = full[4 + i];
            const float w0 = p.conv_w[c], w1 = p.conv_w[3072 + c], w2 = p.conv_w[2 * 3072 + c], w3 = p.conv_w[3 * 3072 + c];
            float y[4];
#pragma unroll
            for (int t = 0; t < 4; ++t) y[t] = siluf(w0 * full[t] + w1 * full[t + 1] + w2 * full[t + 2] + w3 * full[t + 3]);
            if (part == 0 && cc == 1) {
#pragma unroll
                for (int t = 0; t < 4; ++t) vs[t * 128 + ch] = y[t];
            } else {
#pragma unroll
                for (int t = 0; t < 4; ++t) yq[t] = y[t];
            }
        }
    }
#pragma unroll
    for (int t = 0; t < 4; ++t) {
        float s = yq[t] * yq[t];
#pragma unroll
        for (int o = 32; o > 0; o >>= 1) s += __shfl_xor(s, o);
        if (lane == 0) red[wid * 4 + t] = s;
    }
    if (tid < 4) {
        const float braw = PBA[(size_t)(rs + tid) * 16 + h], araw = PBA[(size_t)(rs + tid) * 16 + 8 + h];
        bt[tid] = sigm(braw);
        al[tid] = __expf(-__expf(p.a_log[h]) * softplusf(araw + p.dt_bias[h]));
    }
    __syncthreads();
#pragma unroll
    for (int t = 0; t < 4; ++t) {
        const float tot = red[(2 * part) * 4 + t] + red[(2 * part + 1) * 4 + t];
        const float sc = rsqrtf(tot + EPSF) * (part == 0 ? 0.08838834764831845f : 1.f);
        (part == 0 ? qs : ks)[t * 128 + ch] = yq[t] * sc;
    }
    __syncthreads();
    const int dv = ch, dk0 = part * 64;
    float S[64];
    const float* s0 = p.st_delta + ((size_t)(seq * 8 + h) * 128 + dk0) * 128 + dv;
#pragma unroll
    for (int i = 0; i < 64; ++i) S[i] = s0[(size_t)i * 128];
#pragma unroll
    for (int t = 0; t < 4; ++t) {
        float pk = 0.f;
#pragma unroll
        for (int i = 0; i < 64; ++i) pk += ks[t * 128 + dk0 + i] * S[i];
        kSp[(t * 2 + part) * 128 + dv] = pk;
        __syncthreads();
        const float kS = kSp[(t * 2) * 128 + dv] + kSp[(t * 2 + 1) * 128 + dv];
        const float a = al[t];
        const float vnew = bt[t] * (vs[t * 128 + dv] - a * kS);
        float po = 0.f;
#pragma unroll
        for (int i = 0; i < 64; ++i) { S[i] = a * S[i] + ks[t * 128 + dk0 + i] * vnew; po += qs[t * 128 + dk0 + i] * S[i]; }
        op[(t * 2 + part) * 128 + dv] = po;
        __syncthreads();
        if (part == 0) {
            const float o = op[(t * 2) * 128 + dv] + op[(t * 2 + 1) * 128 + dv];
            PU[(size_t)(rs + t) * 3072 + 2048 + h * 128 + dv] = (bf16_t)f2bf(o);
        }
    }
    float* so = p.out + O_DELTAS + ((size_t)(seq * 8 + h) * 128 + dk0) * 128 + dv;
#pragma unroll
    for (int i = 0; i < 64; ++i) so[(size_t)i * 128] = S[i];
}

DI void attn_block(const Params& p, int bt) {
    char* C = p.ws + OFF_C;
    bf16_t* PQ = (bf16_t*)(C + C_PQ);
    const bf16_t* PKV = (const bf16_t*)(C + C_PKV); const bf16_t* KCS = (const bf16_t*)(C + C_KCS);
    const bf16_t* VTP = (const bf16_t*)(C + C_VTP); const bf16_t* VTS = (const bf16_t*)(C + C_VTS);
    const int lane = threadIdx.x & 63, wid = threadIdx.x >> 6, fr = lane & 15, fq = lane >> 4;
    const bool isS = bt >= 4096;
    int b = 0, kvh, t0 = 0, seq = 0, head, qrow;
    if (!isS) { b = bt >> 10; kvh = (bt >> 8) & 3; t0 = (bt & 255) * 16; head = kvh * 4 + wid; qrow = b * 4096 + t0 + fr; }
    else { seq = bt - 4096; kvh = wid; head = kvh * 4 + (fr >> 2); qrow = MP + seq * 4 + (fr & 3); }
    bf16_t* qp = PQ + (size_t)qrow * 1024 + head * 64;
    const float sink = p.sinks[head];
    bf16x8 bq[2];
    bq[0] = *(const bf16x8*)(qp + fq * 8); bq[1] = *(const bf16x8*)(qp + 32 + fq * 8);
    f32x4 sc[10];
#pragma unroll
    for (int n = 0; n < 10; ++n) {
        const bf16_t* kp;
        if (!isS) { int t = t0 - 144 + 16 * n + fr; t = t < 0 ? 0 : t; kp = PKV + (size_t)(b * 4096 + t) * 512 + kvh * 64; }
        else { int s = 16 * n + fr; s = s > 143 ? 143 : s; kp = KCS + (size_t)(seq * 144 + s) * 256 + kvh * 64; }
        f32x4 a = (f32x4){0.f, 0.f, 0.f, 0.f};
        a = MFMA16(*(const bf16x8*)(kp + fq * 8), bq[0], a);
        a = MFMA16(*(const bf16x8*)(kp + 32 + fq * 8), bq[1], a);
        sc[n] = a;
    }
    float mx = sink;
#pragma unroll
    for (int n = 0; n < 10; ++n)
#pragma unroll
        for (int jj = 0; jj < 4; ++jj) {
            const int kidx = 16 * n + 4 * fq + jj;
            bool valid;
            if (!isS) { const int t = t0 - 144 + kidx, d = 144 + fr - kidx; valid = t >= 0 && d >= 0 && d <= 128; }
            else { const int d = (fr & 3) + 128 - kidx; valid = d >= 0 && d <= 128; }
            const float s = valid ? sc[n][jj] * 0.125f : -1e30f;
            sc[n][jj] = s; mx = fmaxf(mx, s);
        }
    mx = fmaxf(mx, __shfl_xor(mx, 16)); mx = fmaxf(mx, __shfl_xor(mx, 32));
    float sum = 0.f;
#pragma unroll
    for (int n = 0; n < 10; ++n)
#pragma unroll
        for (int jj = 0; jj < 4; ++jj) { const float e = __expf(sc[n][jj] - mx); sc[n][jj] = e; sum += e; }
    sum += __shfl_xor(sum, 16); sum += __shfl_xor(sum, 32);
    const float inv = 1.f / (sum + __expf(sink - mx));
    bf16x8 bP[5];
#pragma unroll
    for (int s5 = 0; s5 < 5; ++s5) bP[s5] = pack8(sc[2 * s5] * inv, sc[2 * s5 + 1] * inv);
#pragma unroll
    for (int ds = 0; ds < 4; ++ds) {
        const bf16_t* vrow = !isS ? VTP + (size_t)(b * 256 + kvh * 64 + 16 * ds + fr) * 4096 : VTS + (size_t)(seq * 256 + kvh * 64 + 16 * ds + fr) * 160;
        f32x4 a = (f32x4){0.f, 0.f, 0.f, 0.f};
#pragma unroll
        for (int s5 = 0; s5 < 5; ++s5) {
            int g0 = 32 * s5 + 4 * fq, g1 = g0 + 16;
            if (!isS) { g0 += t0 - 144; g1 += t0 - 144; g0 = g0 < 0 ? 0 : g0; g1 = g1 < 0 ? 0 : g1; }
            const s16x4 lo = *(const s16x4*)(vrow + g0), hi = *(const s16x4*)(vrow + g1);
            a = MFMA16(cat4(lo, hi), bP[s5], a);
        }
        u32x2 w; w.x = pack2(a[0], a[1]); w.y = pack2(a[2], a[3]);
        *(u32x2*)(qp + 16 * ds + 4 * fq) = w;
    }
}

DI void sample_window_out(const Params& p) {
    const bf16_t* PKV = (const bf16_t*)(p.ws + OFF_C + C_PKV);
    const int gt = blockIdx.x * 256 + threadIdx.x, gs = gridDim.x * 256;
    for (int i = gt; i < 128 * 128 * 128; i += gs) {
        const int c = (i & 127) * 4, s = (i >> 7) & 127, seq = i >> 14;
        const int cc = c & 255; const bool isv = c >= 256;
        f32x4 v;
        if (s < 124) v = *(const f32x4*)((isv ? p.cache_v : p.cache_k) + (size_t)(seq * 128 + s + 4) * 256 + cc);
        else { const u32x2 w = *(const u32x2*)(PKV + (size_t)(MP + seq * 4 + s - 124) * 512 + c); v = (f32x4){bflo(w.x), bfhi(w.x), bflo(w.y), bfhi(w.y)}; }
        *(f32x4*)(p.out + (isv ? O_SWVS : O_SWKS) + (size_t)(seq * 128 + s) * 256 + cc) = v;
    }
}

DI void phase_mixer(const Params& p, char* lds) {
    const int nb = gridDim.x, blk = blockIdx.x;
    const int nscan = 64;
#ifndef MK_P9
#define MK_P9 7
#endif
    if (blk < nscan) { if (MK_P9 & 1) scan_block(p, blk, lds); return; }
    const int wb = blk - nscan, nw = nb - nscan;
    if (MK_P9 & 2) for (int it = wb; it < 1024; it += nw) sdelta_item(p, it, lds);
    if (MK_P9 & 4) for (int bt = wb; bt < 4224; bt += nw) attn_block(p, bt);
}

#define XB_TMO      128
#define XB_XCNT(j)  (256  + 64 * (j))
#define XB_XSUB(j)  (1280 + 64 * (j))
#define XB_XGEN(j)  (2304 + 64 * (j))
#define XB_TOP      3328
#define XB_TOPGEN   3392
#define XCD_BAR_WORDS 3456
#define XB_SPIN_CAP (1u << 22)
DI unsigned xb_ld(unsigned* p) { return __hip_atomic_load(p, __ATOMIC_RELAXED, __HIP_MEMORY_SCOPE_AGENT); }
DI unsigned xb_add(unsigned* p, unsigned v) { return __hip_atomic_fetch_add(p, v, __ATOMIC_RELAXED, __HIP_MEMORY_SCOPE_AGENT); }
DI unsigned xb_xcc_id() { return (unsigned)__builtin_amdgcn_s_getreg((3 << 11) | 20) & 0xFu; }
#define XB_SPIN(cond, bar) do { unsigned _sp = 0; while (cond) { __builtin_amdgcn_s_sleep(1); \
    if ((++_sp & 255u) == 0u) { if (xb_ld(&(bar)[XB_TMO])) break; if (_sp > XB_SPIN_CAP) { atomicAdd(&(bar)[XB_TMO], 1u); break; } } } } while (0)
struct XcdBarrier { unsigned* bar; unsigned x; unsigned nloc; unsigned nx; };
DI XcdBarrier xcd_barrier_post(unsigned* bar) {
    XcdBarrier b; b.bar = bar; b.x = xb_xcc_id(); b.nloc = 0u; b.nx = 0u;
    if (threadIdx.x == 0) (void)xb_add(&bar[XB_XCNT(b.x)], 1u);
    return b;
}
DI void xcd_barrier_complete(unsigned* bar, unsigned x, unsigned& nloc, unsigned& nx) {
    const unsigned G = gridDim.x * gridDim.y * gridDim.z;
    unsigned sum, cnt, mine, sp = 0u;
    for (;;) {
        sum = 0u; cnt = 0u; mine = 0u;
#pragma unroll
        for (unsigned j = 0; j < 16; ++j) { const unsigned c = xb_ld(&bar[XB_XCNT(j)]); sum += c; cnt += (c > 0u) ? 1u : 0u; mine = (j == x) ? c : mine; }
        if (sum == G) break;
        __builtin_amdgcn_s_sleep(1);
        if ((++sp & 255u) == 0u) { if (xb_ld(&bar[XB_TMO])) break; if (sp > XB_SPIN_CAP) { atomicAdd(&bar[XB_TMO], 1u); break; } }
    }
    nloc = mine > 0u ? mine : 1u; nx = cnt > 0u ? cnt : 1u;
}
DI void xcd_barrier(XcdBarrier& b) {
    asm volatile("s_waitcnt vmcnt(0)" ::: "memory");
    __syncthreads();
    if (threadIdx.x == 0) {
        unsigned* bar = b.bar;
        __builtin_amdgcn_s_waitcnt(0);
        unsigned nloc = b.nloc, nx = b.nx;
        if (nloc == 0u) { xcd_barrier_complete(bar, b.x, nloc, nx); b.nloc = nloc; b.nx = nx; }
        const unsigned old = xb_add(&bar[XB_XSUB(b.x)], 1u);
        const unsigned gen = old / nloc;
        if (old + 1u == (gen + 1u) * nloc) {
            __builtin_amdgcn_fence(__ATOMIC_RELEASE, "agent");
            asm volatile("s_waitcnt vmcnt(0)" ::: "memory");
            const unsigned og = xb_add(&bar[XB_TOP], 1u);
            const unsigned tg = og / nx;
            if (og + 1u == (tg + 1u) * nx) xb_add(&bar[XB_TOPGEN], 1u);
            else XB_SPIN(xb_ld(&bar[XB_TOPGEN]) == tg, bar);
            __builtin_amdgcn_fence(__ATOMIC_ACQUIRE, "agent");
            xb_add(&bar[XB_XGEN(b.x)], 1u);
            asm volatile("s_waitcnt vmcnt(0)" ::: "memory");
        } else {
            XB_SPIN(xb_ld(&bar[XB_XGEN(b.x)]) == gen, bar);
            __builtin_amdgcn_fence(__ATOMIC_ACQUIRE, "agent");
            asm volatile("s_waitcnt vmcnt(0)" ::: "memory");
        }
    }
    __syncthreads();
}
constexpr size_t OFF_BAR = 293921280;

template <bool COOP>
__global__ void __launch_bounds__(256, 2) mega(Params p) {
    __shared__ __attribute__((aligned(16))) char lds[65536];
    XcdBarrier xb;
    if (COOP) {
        xb = xcd_barrier_post((unsigned*)(p.ws + OFF_BAR));
        if (p.plo < 0) cg::this_grid().sync();
    }
    char* ws = p.ws; char* C = ws + OFF_C; char* ob = (char*)p.out;
    bf16_t* H = (bf16_t*)(ws + OFF_H);
    bf16_t* F = (bf16_t*)(C + C_F);
#define RUNPH(k, ...) do { if (PHON(k) && p.plo <= (k) && (k) < p.phi) { __VA_ARGS__ } \
        if (COOP && p.plo <= (k) && (k) + 1 < p.phi) { xcd_barrier(xb); } } while (0)
    RUNPH(0, phase_prologue(p, lds););
    RUNPH(1, EpiF32 e{(float*)(ws + OFF_MOD), 9216, p.b_ada}; gemm_phase<4>((const bf16_t*)(ws + OFF_SC), (const bf16_t*)(C + C_WADA), 1024, 2, 72, lds, e););
    RUNPH(2, norm_phase(p, true, nullptr, 0, 0.f, nullptr, false, p.n1pre, 0, 1););
    RUNPH(3, EpiSwiglu e{(bf16_t*)(C + C_ACT)}; gemm_phase<4>(H, (const bf16_t*)(ob + T_W1GU), 1024, 132, 43, lds, e););
    RUNPH(4, EpiBf16 e{F, 1024}; gemm_phase<4>((const bf16_t*)(C + C_ACT), (const bf16_t*)(ob + T_W1D), DFF, 132, 8, lds, e););
    RUNPH(5, norm_phase(p, true, F, 2, 0.5f, p.n1post, true, p.nmpre, 3, 4););
    RUNPH(6, EpiP e{(bf16_t*)(C + C_PU), (bf16_t*)(C + C_PQ), (bf16_t*)(C + C_PKV), (float*)(C + C_PBA), (const float*)(ws + OFF_ROPE), (bf16_t*)(C + C_HALO), p.out};
             gemm_phase<4>(H, (const bf16_t*)(ob + T_WA), 1024, 132, 37, lds, e););
    RUNPH(8, for (int it = blockIdx.x; it < 2048; it += gridDim.x) prep_item(p, it, lds); __syncthreads(); phase_mixprep(p, lds););
    RUNPH(9, phase_mixer(p, lds););
    RUNPH(10, sample_window_out(p); EpiMerge e{(const bf16_t*)(C + C_PU), (const bf16_t*)(C + C_PQ), p.dn_norm, (bf16_t*)(C + C_Y)};
              gemm_phase<3>(H, (const bf16_t*)(ws + OFF_WB), 1024, 132, 32, lds, e););
    RUNPH(11, EpiBf16 e{F, 1024}; gemm_phase<4>((const bf16_t*)(C + C_Y), (const bf16_t*)(ws + OFF_WO), 1024, 132, 8, lds, e););
    RUNPH(12, norm_phase(p, false, F, 5, 1.0f, p.nmpost, true, p.n2pre, 6, 7); cvt_jobs<13, 16>(p, lds););
    RUNPH(13, EpiSwiglu e{(bf16_t*)(C + C_ACT)}; gemm_phase<4>(H, (const bf16_t*)(C + C_W2GU), 1024, 132, 43, lds, e););
    RUNPH(14, EpiBf16 e{F, 1024}; gemm_phase<4>((const bf16_t*)(C + C_ACT), (const bf16_t*)(C + C_W2D), DFF, 132, 8, lds, e););
    RUNPH(15, norm_phase(p, false, F, 8, 0.5f, p.n2post, true, nullptr, 0, 0););
#undef RUNPH
}

constexpr int NPHASE = 16;

extern "C" void kernel_launch(void* const* d_in, const int* in_sizes, int n_in, void* d_out, int out_size, void* d_ws, size_t ws_size,
                              hipStream_t stream) {
    Params p{};
    const float** pp = (const float**)&p;
    for (int i = 0; i < 29; ++i) pp[i] = (const float*)d_in[i];
    p.out = (float*)d_out; p.ws = (char*)d_ws; p.plo = 0; p.phi = NPHASE;
#if MK_COOP
    static int grid_blocks = 0;
    if (!grid_blocks) {
        int dev = 0, cus = 0, per_cu = 0;
        (void)hipGetDevice(&dev);
        (void)hipDeviceGetAttribute(&cus, hipDeviceAttributeMultiprocessorCount, dev);
        (void)hipOccupancyMaxActiveBlocksPerMultiprocessor(&per_cu, mega<true>, 256, 0);
        if (per_cu > 2) per_cu = 2;
        grid_blocks = cus * per_cu;
    }
    void* args[] = {&p};
    (void)hipMemsetAsync((char*)d_ws + OFF_BAR, 0, XCD_BAR_WORDS * 4, stream);
    hipError_t e = hipLaunchCooperativeKernel((void*)mega<true>, dim3(grid_blocks), dim3(256), args, 0, stream);
    if (e != hipSuccess) fprintf(stderr, "cooperative launch failed: %s (grid %d)\n", hipGetErrorString(e), grid_blocks);
#else
    for (int ph = 0; ph < NPHASE; ++ph) {
        p.plo = ph; p.phi = ph + 1;
        hipLaunchKernelGGL(mega<false>, dim3(512), dim3(256), 0, stream, p);
    }
#endif
}
```

```cpp
#include <hip/hip_runtime.h>
#include <hip/hip_cooperative_groups.h>
#include <stdint.h>
#include <cstdio>
namespace cg = cooperative_groups;

#ifndef MK_COOP
#define MK_COOP 1
#endif
#ifndef MK_ONLY
#define MK_ONLY -1
#endif
#define PHON(k) (MK_ONLY < 0 || MK_ONLY == (k))

#define DI __device__ __forceinline__
typedef unsigned short bf16_t;
typedef short bf16x8 __attribute__((ext_vector_type(8)));
typedef short s16x4 __attribute__((ext_vector_type(4)));
typedef float f32x4 __attribute__((ext_vector_type(4)));
typedef unsigned u32x4 __attribute__((ext_vector_type(4)));
typedef unsigned u32x2 __attribute__((ext_vector_type(2)));
#define LAS __attribute__((address_space(3)))
#define MFMA16(a, b, c) __builtin_amdgcn_mfma_f32_16x16x32_bf16((a), (b), (c), 0, 0, 0)

constexpr int MP = 16384, MALL = 16896, DM = 1024, DFF = 2752;
constexpr float EPSF = 1e-6f;
constexpr size_t OFF_MOD = 0;
constexpr size_t OFF_H = 9437184;
constexpr size_t OFF_WB = 44040192;
constexpr size_t OFF_WO = 50331648;
constexpr size_t OFF_SC = 52428800;
constexpr size_t OFF_ROPE = 52953088;
constexpr size_t OFF_C = 53215744;
constexpr size_t C_F = 0;
constexpr size_t C_ACT = 69206016;
constexpr size_t C_WADA = 0;
constexpr size_t C_PU = 0;
constexpr size_t C_KDT = 103809024;
constexpr size_t C_ACH = 137363456;
constexpr size_t C_PQ = 154140672;
constexpr size_t C_PKV = 188743680;
constexpr size_t C_KCS = 206045184;
constexpr size_t C_VTP = 215482368;
constexpr size_t C_VTS = 223870976;
constexpr size_t C_PBA = 234356736;
constexpr size_t C_SSQ = 235438080;
constexpr size_t C_GAM = 235978752;
constexpr size_t C_Y = C_KDT;
constexpr size_t C_W2GU = 166723584;
constexpr size_t C_W2D = 177995776;
constexpr size_t O_Y = 0, O_SWKP = 17301504, O_SWVP = 17432576, O_CONVP = 17563648, O_DELTAP = 17600512,
                 O_SWKS = 18124800, O_SWVS = 22319104, O_CONVS = 26513408, O_DELTAS = 27693056;
constexpr size_t T_W1GU = O_SWKS * 4;
constexpr size_t T_W1D = T_W1GU + 11272192;
constexpr size_t T_WA = T_W1D + 5636096;
constexpr size_t T_UP = O_SWKS * 4;
constexpr size_t C_HALO = 235986944;

struct Params {
    const float* x_p; const float* x_s; const float* cache_k; const float* cache_v; const float* st_conv; const float* st_delta;
    const float* c_p; const float* c_s; const float* w_ada; const float* b_ada;
    const float* n1pre; const float* n1post; const float* w1g; const float* w1u; const float* w1d;
    const float* nmpre; const float* nmpost; const float* w_in; const float* conv_w; const float* a_log; const float* dt_bias;
    const float* dn_norm; const float* sinks; const float* w_out;
    const float* n2pre; const float* n2post; const float* w2g; const float* w2u; const float* w2d;
    float* out; char* ws; int plo; int phi;
};

typedef __bf16 bf16v2_t __attribute__((ext_vector_type(2)));
typedef float f32v2_t __attribute__((ext_vector_type(2)));
DI unsigned pack2(float a, float b) { const f32v2_t v = {a, b}; return __builtin_bit_cast(unsigned, __builtin_convertvector(v, bf16v2_t)); }
DI unsigned f2bf(float x) { return pack2(x, 0.f) & 0xffffu; }
DI float bf2f(unsigned h) { return __uint_as_float(h << 16); }
DI float bflo(unsigned w) { return __uint_as_float(w << 16); }
DI float bfhi(unsigned w) { return __uint_as_float(w & 0xffff0000u); }
DI float sigm(float x) { return __builtin_amdgcn_rcpf(1.f + __expf(-x)); }
DI float siluf(float x) { return x * __builtin_amdgcn_rcpf(1.f + __expf(-x)); }
DI float softplusf(float x) { return fmaxf(x, 0.f) + log1pf(__expf(-fabsf(x))); }
DI bf16x8 pack8(const f32x4& a, const f32x4& b) {
    u32x4 p; p.x = pack2(a[0], a[1]); p.y = pack2(a[2], a[3]); p.z = pack2(b[0], b[1]); p.w = pack2(b[2], b[3]);
    return __builtin_bit_cast(bf16x8, p);
}
DI bf16x8 cat4(const s16x4& lo, const s16x4& hi) { return __builtin_shufflevector(lo, hi, 0, 1, 2, 3, 4, 5, 6, 7); }

template <int NT, class Epi>
DI void gemm_phase(const bf16_t* __restrict__ A, const bf16_t* __restrict__ Bt, int K, int nmt, int nnt, char* lds, const Epi& epi) {
    const int tid = threadIdx.x, lane = tid & 63, wid = tid >> 6, fr = lane & 15, fq = lane >> 4;
    const int wm = wid >> 1, wn = wid & 1;
    constexpr int BN = NT * 32;
    constexpr int BCH = BN / 32;
    const int ntiles = nmt * nnt, nk = K >> 6;
    const int srow = tid >> 3, spos = tid & 7;
    const bool xmap = nmt >= 16 && (gridDim.x & 7) == 0;
    const int xcd = blockIdx.x & 7;
    const int mlo = xmap ? (xcd * nmt) >> 3 : 0, mcnt = xmap ? (((xcd + 1) * nmt) >> 3) - mlo : nmt;
    const int estart = xmap ? (int)(blockIdx.x >> 3) : (int)blockIdx.x, estep = xmap ? (int)(gridDim.x >> 3) : (int)gridDim.x;
    const int etotal = xmap ? mcnt * nnt : ntiles;
    for (int e = estart; e < etotal; e += estep) {
        int mt, nt;
        if (xmap) {
            const int pg = mcnt * 8, ng = e / pg, nrem = nnt - ng * 8, gw = nrem < 8 ? nrem : 8, r = e - ng * pg, mi = r / gw;
            mt = mlo + mi; nt = ng * 8 + (r - mi * gw);
        } else { mt = e % nmt; nt = e / nmt; }
        const int m0 = mt * 128, n0 = nt * BN;
        f32x4 acc[4][NT];
#pragma unroll
        for (int m = 0; m < 4; ++m)
#pragma unroll
            for (int n = 0; n < NT; ++n) acc[m][n] = (f32x4){0.f, 0.f, 0.f, 0.f};
        const bf16_t* ag[4]; const bf16_t* bg[BCH];
#pragma unroll
        for (int i = 0; i < 4; ++i) { const int row = srow + 32 * i; ag[i] = A + (size_t)(m0 + row) * K + ((spos ^ ((row >> 1) & 7)) << 3); }
#pragma unroll
        for (int i = 0; i < BCH; ++i) { const int row = srow + 32 * i; bg[i] = Bt + (size_t)(n0 + row) * K + ((spos ^ ((row >> 1) & 7)) << 3); }
        __syncthreads();
#define GEMM_ISSUE(kt_, st_) do { \
        _Pragma("unroll") for (int i = 0; i < 4; ++i) __builtin_amdgcn_global_load_lds((const unsigned*)(ag[i] + (kt_) * 64), (LAS unsigned*)(lds + (st_) * 32768 + i * 4096 + wid * 1024), 16, 0, 0); \
        _Pragma("unroll") for (int i = 0; i < BCH; ++i) __builtin_amdgcn_global_load_lds((const unsigned*)(bg[i] + (kt_) * 64), (LAS unsigned*)(lds + (st_) * 32768 + 16384 + i * 4096 + wid * 1024), 16, 0, 0); } while (0)
        GEMM_ISSUE(0, 0);
        for (int kt = 0; kt < nk; ++kt) {
            asm volatile("s_waitcnt vmcnt(0)" ::: "memory");
            __syncthreads();
            if (kt + 1 < nk) GEMM_ISSUE(kt + 1, (kt + 1) & 1);
            const char* As = lds + (kt & 1) * 32768;
            const char* Bs = As + 16384;
            bf16x8 af[2][4], bfr[2][NT];
#pragma unroll
            for (int ks = 0; ks < 2; ++ks) {
                const int ch = ks * 4 + fq;
#pragma unroll
                for (int m = 0; m < 4; ++m) { const int row = wm * 64 + m * 16 + fr; af[ks][m] = *(const bf16x8*)(As + row * 128 + ((ch ^ ((row >> 1) & 7)) << 4)); }
#pragma unroll
                for (int n = 0; n < NT; ++n) { const int row = wn * NT * 16 + n * 16 + fr; bfr[ks][n] = *(const bf16x8*)(Bs + row * 128 + ((ch ^ ((row >> 1) & 7)) << 4)); }
            }
            __builtin_amdgcn_s_setprio(1);
#pragma unroll
            for (int ks = 0; ks < 2; ++ks)
#pragma unroll
                for (int m = 0; m < 4; ++m)
#pragma unroll
                    for (int n = 0; n < NT; ++n) acc[m][n] = MFMA16(bfr[ks][n], af[ks][m], acc[m][n]);
            __builtin_amdgcn_s_setprio(0);
        }
#undef GEMM_ISSUE
        epi(acc, m0 + wm * 64 + fr, n0, wn, fq, lane);
    }
}

struct EpiF32 {
    float* C; int ldc; const float* bias;
    DI void operator()(const f32x4 (&acc)[4][4], int rowb, int n0, int wn, int fq, int) const {
#pragma unroll
        for (int m = 0; m < 4; ++m)
#pragma unroll
            for (int n = 0; n < 4; ++n) {
                const int col = n0 + wn * 64 + n * 16 + 4 * fq;
                f32x4 v = acc[m][n];
                if (bias) { const f32x4 bv = *(const f32x4*)(bias + col); v = v + bv; }
                *(f32x4*)(C + (size_t)(rowb + m * 16) * ldc + col) = v;
            }
    }
};
struct EpiBf16 {
    bf16_t* O; int ldc;
    DI void operator()(const f32x4 (&acc)[4][4], int rowb, int n0, int wn, int fq, int) const {
#pragma unroll
        for (int m = 0; m < 4; ++m)
#pragma unroll
            for (int n = 0; n < 4; ++n) {
                const f32x4 v = acc[m][n]; u32x2 w; w.x = pack2(v[0], v[1]); w.y = pack2(v[2], v[3]);
                *(u32x2*)(O + (size_t)(rowb + m * 16) * ldc + n0 + wn * 64 + n * 16 + 4 * fq) = w;
            }
    }
};
struct EpiSwiglu {
    bf16_t* O;
    DI void operator()(const f32x4 (&acc)[4][4], int rowb, int n0, int wn, int fq, int) const {
        const int cb = (n0 >> 1) + wn * 32 + 4 * fq;
#pragma unroll
        for (int m = 0; m < 4; ++m)
#pragma unroll
            for (int n2 = 0; n2 < 2; ++n2) {
                const f32x4 g = acc[m][2 * n2], u = acc[m][2 * n2 + 1];
                u32x2 w; w.x = pack2(siluf(g[0]) * u[0], siluf(g[1]) * u[1]); w.y = pack2(siluf(g[2]) * u[2], siluf(g[3]) * u[3]);
                *(u32x2*)(O + (size_t)(rowb + m * 16) * DFF + cb + n2 * 16) = w;
            }
    }
};
struct EpiP {
    bf16_t* PU; bf16_t* PQ; bf16_t* PKV; float* PBA; const float* rope; bf16_t* HALO; float* out;
    DI void operator()(const f32x4 (&acc)[4][4], int rowb, int n0, int wn, int fq, int) const {
        if (n0 < 3072) {
#pragma unroll
            for (int m = 0; m < 4; ++m)
#pragma unroll
                for (int n = 0; n < 4; ++n) {
                    const f32x4 v = acc[m][n]; u32x2 w; w.x = pack2(v[0], v[1]); w.y = pack2(v[2], v[3]);
                    const int row = rowb + m * 16, col = n0 + wn * 64 + n * 16 + 4 * fq;
                    *(u32x2*)(PU + (size_t)row * 3072 + col) = w;
                    if ((row & 63) >= 61 && row < MP && (row & 4095) < 4032)
                        *(u32x2*)(HALO + ((size_t)((row >> 6) + 1) * 3 + ((row & 63) - 61)) * 3072 + col) = w;
                    if (row < MP && (row & 4095) >= 4093)
                        *(f32x4*)(out + O_CONVP + ((size_t)(row >> 12) * 3 + ((row & 4095) - 4093)) * 3072 + col) = v;
                }
        } else if (n0 < 4608) {
            const bool isq = n0 < 4096;
            const int cw = (isq ? n0 - 3072 : n0 - 4096) + wn * 64;
            const bool rot = isq || cw < 256;
            bf16_t* dst = isq ? PQ : PKV; const int ld = isq ? 1024 : 512;
#pragma unroll
            for (int m = 0; m < 4; ++m) {
                const int row = rowb + m * 16;
                const int pidx = row < MP ? (row & 4095) : 4096 + (row & 3);
                const float* tab = rope + pidx * 16 + 4 * (fq & 1);
#pragma unroll
                for (int n = 0; n < 4; ++n) {
                    f32x4 v = acc[m][n];
                    if (n == 0) {
                        f32x4 pr;
#pragma unroll
                        for (int j = 0; j < 4; ++j) pr[j] = __shfl_xor(v[j], 32);
                        if (rot) {
#pragma unroll
                            for (int j = 0; j < 4; ++j) { const float c = tab[j], s = tab[8 + j]; v[j] = (fq < 2) ? v[j] * c - pr[j] * s : v[j] * c + pr[j] * s; }
                        }
                    }
                    u32x2 w; w.x = pack2(v[0], v[1]); w.y = pack2(v[2], v[3]);
                    *(u32x2*)(dst + (size_t)row * ld + cw + n * 16 + 4 * fq) = w;
                    if (!isq && row < MP && (row & 4095) >= 3968) {
                        const int cc = cw + n * 16 + 4 * fq;
                        *(f32x4*)(out + (cc < 256 ? O_SWKP : O_SWVP) + ((size_t)(row >> 12) * 128 + ((row & 4095) - 3968)) * 256 + (cc & 255)) = v;
                    }
                }
            }
        } else {
            if (wn == 0) {
#pragma unroll
                for (int m = 0; m < 4; ++m) *(f32x4*)(PBA + (size_t)(rowb + m * 16) * 16 + 4 * fq) = acc[m][0];
            }
        }
    }
};
struct EpiMerge {
    const bf16_t* PU; const bf16_t* PQ; const float* dng; bf16_t* Y;
    DI void operator()(const f32x4 (&acc)[4][3], int rowb, int n0, int wn, int fq, int) const {
        const int c0 = (n0 / 96) * 32 + wn * 16 + 4 * fq;
        const f32x4 gn = *(const f32x4*)(dng + (c0 & 127));
        u32x4 ov[4][4];
#pragma unroll
        for (int m = 0; m < 4; ++m) {
            const bf16_t* op = PU + (size_t)(rowb + m * 16) * 3072 + 2048 + (c0 & ~127) + fq * 32;
#pragma unroll
            for (int i = 0; i < 4; ++i) ov[m][i] = *(const u32x4*)(op + i * 8);
        }
#pragma unroll
        for (int m = 0; m < 4; ++m) {
            const int row = rowb + m * 16;
            float ss = 0.f;
#pragma unroll
            for (int i = 0; i < 4; ++i)
#pragma unroll
                for (int e = 0; e < 4; ++e) { const float a = bflo(ov[m][i][e]), b = bfhi(ov[m][i][e]); ss += a * a + b * b; }
            ss += __shfl_xor(ss, 16); ss += __shfl_xor(ss, 32);
            const float rstd = rsqrtf(ss * (1.f / 128.f) + EPSF);
            const u32x2 ou = *(const u32x2*)(PU + (size_t)row * 3072 + 2048 + c0);
            const u32x2 os = *(const u32x2*)(PQ + (size_t)row * 1024 + c0);
            const float od[4] = {bflo(ou.x), bfhi(ou.x), bflo(ou.y), bfhi(ou.y)};
            const float sw[4] = {bflo(os.x), bfhi(os.x), bflo(os.y), bfhi(os.y)};
            float y[4];
#pragma unroll
            for (int j = 0; j < 4; ++j) y[j] = sigm(acc[m][1][j]) * (od[j] * rstd * gn[j]) * siluf(acc[m][0][j]) + sigm(acc[m][2][j]) * sw[j];
            u32x2 w; w.x = pack2(y[0], y[1]); w.y = pack2(y[2], y[3]);
            *(u32x2*)(Y + (size_t)row * 1024 + c0) = w;
        }
    }
};

struct CvtJob { const float* src; int ld; int K; int col0; int ncols; bf16_t* dst; int G; int which; int rowbase; };
DI int job_tiles(const CvtJob& j) { return ((j.ncols + 63) >> 6) * (j.K >> 6); }
DI void cvt_tile(const CvtJob& j, int t, char* lds) {
    float* tl = (float*)lds;
    const int tid = threadIdx.x;
    const int nkt = j.K >> 6, ct = t / nkt, kt = t % nkt, c0 = ct * 64, k0 = kt * 64;
    __syncthreads();
#pragma unroll
    for (int i = 0; i < 4; ++i) {
        const int kr = (tid >> 4) + 16 * i, col = (tid & 15) * 4;
        f32x4 v = (f32x4){0.f, 0.f, 0.f, 0.f};
        if (c0 + col < j.ncols) v = *(const f32x4*)(j.src + (size_t)(k0 + kr) * j.ld + j.col0 + c0 + col);
        tl[kr * 65 + col] = v[0]; tl[kr * 65 + col + 1] = v[1]; tl[kr * 65 + col + 2] = v[2]; tl[kr * 65 + col + 3] = v[3];
    }
    __syncthreads();
#pragma unroll
    for (int i = 0; i < 2; ++i) {
        const int col = (tid >> 3) + 32 * i, ch = tid & 7, jc = c0 + col;
        if (jc < j.ncols) {
            const int drow = j.rowbase + (jc >> 4) * (j.G * 16) + j.which * 16 + (jc & 15);
            u32x4 w;
            w.x = pack2(tl[(ch * 8 + 0) * 65 + col], tl[(ch * 8 + 1) * 65 + col]);
            w.y = pack2(tl[(ch * 8 + 2) * 65 + col], tl[(ch * 8 + 3) * 65 + col]);
            w.z = pack2(tl[(ch * 8 + 4) * 65 + col], tl[(ch * 8 + 5) * 65 + col]);
            w.w = pack2(tl[(ch * 8 + 6) * 65 + col], tl[(ch * 8 + 7) * 65 + col]);
            *(u32x4*)(j.dst + (size_t)drow * j.K + k0 + ch * 8) = w;
        }
    }
}
DI CvtJob get_job(const Params& p, int id) {
    char* ws = p.ws; char* ob = (char*)p.out;
    bf16_t* W1GU = (bf16_t*)(ob + T_W1GU); bf16_t* W1D = (bf16_t*)(ob + T_W1D); bf16_t* WA = (bf16_t*)(ob + T_WA);
    bf16_t* WB = (bf16_t*)(ws + OFF_WB); bf16_t* WO = (bf16_t*)(ws + OFF_WO); bf16_t* WADA = (bf16_t*)(ws + OFF_C + C_WADA);
    bf16_t* W2GU = (bf16_t*)(ws + OFF_C + C_W2GU); bf16_t* W2D = (bf16_t*)(ws + OFF_C + C_W2D);
    switch (id) {
        case 0: return CvtJob{p.w1g, DFF, 1024, 0, DFF, W1GU, 2, 0, 0};
        case 1: return CvtJob{p.w1u, DFF, 1024, 0, DFF, W1GU, 2, 1, 0};
        case 2: return CvtJob{p.w1d, 1024, DFF, 0, 1024, W1D, 1, 0, 0};
        case 3: return CvtJob{p.w_in, 7696, 1024, 0, 3072, WA, 1, 0, 0};
        case 4: return CvtJob{p.w_in, 7696, 1024, 3072, 1024, WB, 3, 0, 0};
        case 5: return CvtJob{p.w_in, 7696, 1024, 4096, 16, WA, 1, 0, 4608};
        case 6: return CvtJob{p.w_in, 7696, 1024, 4112, 1024, WA, 1, 0, 3072};
        case 7: return CvtJob{p.w_in, 7696, 1024, 5136, 256, WA, 1, 0, 4096};
        case 8: return CvtJob{p.w_in, 7696, 1024, 5392, 256, WA, 1, 0, 4352};
        case 9: return CvtJob{p.w_in, 7696, 1024, 5648, 1024, WB, 3, 1, 0};
        case 10: return CvtJob{p.w_in, 7696, 1024, 6672, 1024, WB, 3, 2, 0};
        case 11: return CvtJob{p.w_out, 1024, 1024, 0, 1024, WO, 1, 0, 0};
        case 12: return CvtJob{p.w_ada, 9216, 1024, 0, 9216, WADA, 1, 0, 0};
        case 13: return CvtJob{p.w2g, DFF, 1024, 0, DFF, W2GU, 2, 0, 0};
        case 14: return CvtJob{p.w2u, DFF, 1024, 0, DFF, W2GU, 2, 1, 0};
        default: return CvtJob{p.w2d, 1024, DFF, 0, 1024, W2D, 1, 0, 0};
    }
}
template <int JLO, int JHI>
DI void cvt_jobs(const Params& p, char* lds) {
    int base = 0;
#pragma unroll
    for (int id = JLO; id < JHI; ++id) {
        const CvtJob j = get_job(p, id);
        const int nt = job_tiles(j);
        int first = ((int)blockIdx.x - base) % (int)gridDim.x; if (first < 0) first += gridDim.x;
        for (int t = first; t < nt; t += gridDim.x) cvt_tile(j, t, lds);
        base += nt;
    }
    __syncthreads();
}

DI void phase_prologue(const Params& p, char* lds) {
    cvt_jobs<0, 13>(p, lds);
    const int gtid = blockIdx.x * 256 + threadIdx.x, gsz = gridDim.x * 256;
    bf16_t* SC = (bf16_t*)(p.ws + OFF_SC);
    for (int i = gtid; i < 256 * 1024; i += gsz) {
        const int row = i >> 10, col = i & 1023;
        float v = 0.f;
        if (row < 4) v = siluf(p.c_p[row * 1024 + col]); else if (row < 132) v = siluf(p.c_s[(row - 4) * 1024 + col]);
        SC[i] = (bf16_t)f2bf(v);
    }
    float* rope = (float*)(p.ws + OFF_ROPE);
    for (int i = gtid; i < 4100 * 8; i += gsz) {
        const int pi = i >> 3, k = i & 7;
        const float pos = (float)(pi < 4096 ? pi : 8192 + (pi - 4096));
        const float invf = (float)exp(-(double)k * 0.125 * log(500000.0));
        const float ang = pos * invf;
        rope[pi * 16 + k] = (float)cos((double)ang);
        rope[pi * 16 + 8 + k] = (float)sin((double)ang);
    }
}

DI void norm_phase(const Params& p, bool x_from_input, const bf16_t* f, int gate_i, float gcoef, const float* post,
                   bool write_x, const float* pre, int sh_i, int sc_i) {
    const int lane = threadIdx.x & 63, wid = threadIdx.x >> 6;
    const float* MOD = (const float*)(p.ws + OFF_MOD);
    bf16_t* H = (bf16_t*)(p.ws + OFF_H);
    for (int row = blockIdx.x * 4 + wid; row < MALL; row += gridDim.x * 4) {
        const int cidx = row < MP ? (row >> 12) : 4 + ((row - MP) >> 2);
        const float* mrow = MOD + (size_t)cidx * 9216;
        const float* xr = x_from_input ? (row < MP ? p.x_p + (size_t)row * 1024 : p.x_s + (size_t)(row - MP) * 1024) : p.out + (size_t)row * 1024;
        f32x4 x[4];
#pragma unroll
        for (int i = 0; i < 4; ++i) x[i] = *(const f32x4*)(xr + lane * 4 + 256 * i);
        if (f) {
            f32x4 fv[4]; float ss = 0.f;
#pragma unroll
            for (int i = 0; i < 4; ++i) { const u32x2 fw = *(const u32x2*)(f + (size_t)row * 1024 + lane * 4 + 256 * i);
                fv[i] = (f32x4){bflo(fw.x), bfhi(fw.x), bflo(fw.y), bfhi(fw.y)}; ss += fv[i][0] * fv[i][0] + fv[i][1] * fv[i][1] + fv[i][2] * fv[i][2] + fv[i][3] * fv[i][3]; }
#pragma unroll
            for (int o = 32; o > 0; o >>= 1) ss += __shfl_xor(ss, o);
            const float rstd = rsqrtf(ss * (1.f / 1024.f) + EPSF);
#pragma unroll
            for (int i = 0; i < 4; ++i) {
                const int col = lane * 4 + 256 * i;
                const f32x4 g = *(const f32x4*)(mrow + gate_i * 1024 + col), pg = *(const f32x4*)(post + col);
#pragma unroll
                for (int j = 0; j < 4; ++j) x[i][j] += gcoef * g[j] * (fv[i][j] * rstd * pg[j]);
            }
        }
        if (write_x) {
#pragma unroll
            for (int i = 0; i < 4; ++i) *(f32x4*)(p.out + (size_t)row * 1024 + lane * 4 + 256 * i) = x[i];
        }
        if (pre) {
            float ss = 0.f;
#pragma unroll
            for (int i = 0; i < 4; ++i) ss += x[i][0] * x[i][0] + x[i][1] * x[i][1] + x[i][2] * x[i][2] + x[i][3] * x[i][3];
#pragma unroll
            for (int o = 32; o > 0; o >>= 1) ss += __shfl_xor(ss, o);
            const float rstd = rsqrtf(ss * (1.f / 1024.f) + EPSF);
#pragma unroll
            for (int i = 0; i < 4; ++i) {
                const int col = lane * 4 + 256 * i;
                const f32x4 pg = *(const f32x4*)(pre + col), sh = *(const f32x4*)(mrow + sh_i * 1024 + col), sc = *(const f32x4*)(mrow + sc_i * 1024 + col);
                float h[4];
#pragma unroll
                for (int j = 0; j < 4; ++j) h[j] = x[i][j] * rstd * pg[j] * (1.f + sc[j]) + sh[j];
                u32x2 w; w.x = pack2(h[0], h[1]); w.y = pack2(h[2], h[3]);
                *(u32x2*)(H + (size_t)row * 1024 + col) = w;
            }
        }
    }
}

DI void phase_mixprep(const Params& p, char* lds) {
    char* C = p.ws + OFF_C;
    const bf16_t* PKV = (const bf16_t*)(C + C_PKV);
    bf16_t* KCS = (bf16_t*)(C + C_KCS); bf16_t* VTP = (bf16_t*)(C + C_VTP); bf16_t* VTS = (bf16_t*)(C + C_VTS);
    float* SSQ = (float*)(C + C_SSQ);
    const int tid = threadIdx.x, gtid = blockIdx.x * 256 + tid, gsz = gridDim.x * 256;
    bf16_t* tl = (bf16_t*)lds;
    for (int t = blockIdx.x; t < 1024; t += gridDim.x) {
        const int b = t >> 8, cb = (t >> 6) & 3, tb = t & 63;
        __syncthreads();
#pragma unroll
        for (int i = 0; i < 2; ++i) {
            const int tr = (tid >> 3) + 32 * i, c8 = (tid & 7) * 8;
            const u32x4 v = *(const u32x4*)(PKV + (size_t)(b * 4096 + tb * 64 + tr) * 512 + 256 + cb * 64 + c8);
            bf16_t* d = tl + tr * 66 + c8;
            d[0] = (bf16_t)(v.x & 0xffffu); d[1] = (bf16_t)(v.x >> 16); d[2] = (bf16_t)(v.y & 0xffffu); d[3] = (bf16_t)(v.y >> 16);
            d[4] = (bf16_t)(v.z & 0xffffu); d[5] = (bf16_t)(v.z >> 16); d[6] = (bf16_t)(v.w & 0xffffu); d[7] = (bf16_t)(v.w >> 16);
        }
        __syncthreads();
#pragma unroll
        for (int i = 0; i < 2; ++i) {
            const int col = (tid >> 3) + 32 * i, ch = tid & 7;
            u32x4 w;
            w.x = tl[(ch * 8 + 0) * 66 + col] | ((unsigned)tl[(ch * 8 + 1) * 66 + col] << 16);
            w.y = tl[(ch * 8 + 2) * 66 + col] | ((unsigned)tl[(ch * 8 + 3) * 66 + col] << 16);
            w.z = tl[(ch * 8 + 4) * 66 + col] | ((unsigned)tl[(ch * 8 + 5) * 66 + col] << 16);
            w.w = tl[(ch * 8 + 6) * 66 + col] | ((unsigned)tl[(ch * 8 + 7) * 66 + col] << 16);
            *(u32x4*)(VTP + (size_t)(b * 256 + cb * 64 + col) * 4096 + tb * 64 + ch * 8) = w;
        }
    }
    for (int t = blockIdx.x; t < 512; t += gridDim.x) {
        const int seq = t >> 2, cb = t & 3;
        __syncthreads();
        for (int i = tid; i < 160 * 16; i += 256) {
            const int s = i >> 4, col = (i & 15) * 4;
            unsigned w0 = 0, w1 = 0;
            if (s < 128) { const f32x4 v = *(const f32x4*)(p.cache_v + (size_t)(seq * 128 + s) * 256 + cb * 64 + col); w0 = pack2(v[0], v[1]); w1 = pack2(v[2], v[3]); }
            else if (s < 132) { const u32x2 v = *(const u32x2*)(PKV + (size_t)(MP + seq * 4 + s - 128) * 512 + 256 + cb * 64 + col); w0 = v.x; w1 = v.y; }
            bf16_t* d = tl + s * 66 + col;
            d[0] = (bf16_t)(w0 & 0xffffu); d[1] = (bf16_t)(w0 >> 16); d[2] = (bf16_t)(w1 & 0xffffu); d[3] = (bf16_t)(w1 >> 16);
        }
        __syncthreads();
        for (int i = tid; i < 64 * 20; i += 256) {
            const int col = i / 20, ch = i % 20;
            u32x4 w;
            w.x = tl[(ch * 8 + 0) * 66 + col] | ((unsigned)tl[(ch * 8 + 1) * 66 + col] << 16);
            w.y = tl[(ch * 8 + 2) * 66 + col] | ((unsigned)tl[(ch * 8 + 3) * 66 + col] << 16);
            w.z = tl[(ch * 8 + 4) * 66 + col] | ((unsigned)tl[(ch * 8 + 5) * 66 + col] << 16);
            w.w = tl[(ch * 8 + 6) * 66 + col] | ((unsigned)tl[(ch * 8 + 7) * 66 + col] << 16);
            *(u32x4*)(VTS + (size_t)(seq * 256 + cb * 64 + col) * 160 + ch * 8) = w;
        }
    }
    __syncthreads();
    for (int i = gtid; i < 128 * 144 * 32; i += gsz) {
        const int ch = i & 31, slot = (i >> 5) % 144, seq = (i >> 5) / 144;
        u32x4 w = (u32x4){0u, 0u, 0u, 0u};
        if (slot < 128) {
            const float* s = p.cache_k + (size_t)(seq * 128 + slot) * 256 + ch * 8;
            const f32x4 a = *(const f32x4*)s, b = *(const f32x4*)(s + 4);
            w.x = pack2(a[0], a[1]); w.y = pack2(a[2], a[3]); w.z = pack2(b[0], b[1]); w.w = pack2(b[2], b[3]);
        } else if (slot < 132) w = *(const u32x4*)(PKV + (size_t)(MP + seq * 4 + slot - 128) * 512 + ch * 8);
        *(u32x4*)(KCS + (size_t)i * 8) = w;
    }
}

DI void prep_item(const Params& p, int item, char* lds) {
    char* C = p.ws + OFF_C;
    bf16_t* PU = (bf16_t*)(C + C_PU);
    const float* PBA = (const float*)(C + C_PBA);
    bf16_t* KDT = (bf16_t*)(C + C_KDT); bf16_t* ACH = (bf16_t*)(C + C_ACH); float* GAM = (float*)(C + C_GAM);
    const bf16_t* HALO = (const bf16_t*)(C + C_HALO);
    bf16_t* UP = (bf16_t*)((char*)p.out + T_UP);
    int tid = threadIdx.x; asm volatile("" : "+v"(tid));
    const int lane = tid & 63, wid = tid >> 6, fr = lane & 15, fq = lane >> 4;
    const int b = item >> 9, n = (item >> 3) & 63, h = item & 7;
    const int r0 = b * 4096 + n * 64;
    char* Qt = lds; char* Kt = lds + 16384;
    float* Ls = (float*)(lds + 32768);
    float* gc = (float*)(lds + 50176); float* be = gc + 64; float* eg = be + 64;
    const bf16_t* halo = HALO + (size_t)(b * 64 + n) * 3 * 3072;
    __syncthreads();
    {
        const int slot = tid >> 4, l16 = tid & 15, which = slot & 1, rsub = slot >> 1;
        const int cbase = which * 1024 + h * 128 + l16 * 8;
        float w[4][8];
#pragma unroll
        for (int t = 0; t < 4; ++t) {
            const f32x4 a = *(const f32x4*)(p.conv_w + t * 3072 + cbase), bb = *(const f32x4*)(p.conv_w + t * 3072 + cbase + 4);
#pragma unroll
            for (int e = 0; e < 4; ++e) { w[t][e] = a[e]; w[t][4 + e] = bb[e]; }
        }
        const float qs = which == 0 ? 0.08838834764831845f : 1.f;
        for (int ps = 0; ps < 8; ++ps) {
            const int i = ps * 8 + rsub;
            float y[8];
#pragma unroll
            for (int e = 0; e < 8; ++e) y[e] = 0.f;
#pragma unroll
            for (int t = 0; t < 4; ++t) {
                const int tr = i - 3 + t;
                const bf16_t* src = tr < 0 ? halo + (3 + tr) * 3072 + cbase : PU + (size_t)(r0 + tr) * 3072 + cbase;
                u32x4 v = *(const u32x4*)src;
                if (tr < 0 && n == 0) v = (u32x4){0u, 0u, 0u, 0u};
                y[0] += w[t][0] * bflo(v.x); y[1] += w[t][1] * bfhi(v.x); y[2] += w[t][2] * bflo(v.y); y[3] += w[t][3] * bfhi(v.y);
                y[4] += w[t][4] * bflo(v.z); y[5] += w[t][5] * bfhi(v.z); y[6] += w[t][6] * bflo(v.w); y[7] += w[t][7] * bfhi(v.w);
            }
            float ss = 0.f;
#pragma unroll
            for (int e = 0; e < 8; ++e) { y[e] = siluf(y[e]); ss += y[e] * y[e]; }
            ss += __shfl_xor(ss, 1); ss += __shfl_xor(ss, 2); ss += __shfl_xor(ss, 4); ss += __shfl_xor(ss, 8);
            const float sc = rsqrtf(ss + EPSF) * qs;
            u32x4 o; o.x = pack2(y[0] * sc, y[1] * sc); o.y = pack2(y[2] * sc, y[3] * sc); o.z = pack2(y[4] * sc, y[5] * sc); o.w = pack2(y[6] * sc, y[7] * sc);
            *(u32x4*)((which ? Kt : Qt) + i * 256 + ((l16 ^ (i & 15)) << 4)) = o;
        }
    }
    if (wid == 0) {
        const float braw = PBA[(size_t)(r0 + lane) * 16 + h], araw = PBA[(size_t)(r0 + lane) * 16 + 8 + h];
        float g = -__expf(p.a_log[h]) * softplusf(araw + p.dt_bias[h]);
#pragma unroll
        for (int o = 1; o < 64; o <<= 1) { const float t = __shfl_up(g, o); if (lane >= o) g += t; }
        gc[lane] = g; be[lane] = sigm(braw); eg[lane] = __expf(g);
    }
    __syncthreads();
    {
        f32x4 ak[4], aq[4];
#pragma unroll
        for (int nj = 0; nj < 4; ++nj) { ak[nj] = (f32x4){0.f, 0.f, 0.f, 0.f}; aq[nj] = ak[nj]; }
#pragma unroll
        for (int ks = 0; ks < 4; ++ks) {
            const int ri = wid * 16 + fr, ch = ks * 4 + fq;
            const bf16x8 fk = *(const bf16x8*)(Kt + ri * 256 + ((ch ^ (ri & 15)) << 4));
            const bf16x8 fqq = *(const bf16x8*)(Qt + ri * 256 + ((ch ^ (ri & 15)) << 4));
#pragma unroll
            for (int nj = 0; nj < 4; ++nj) {
                const int rj = nj * 16 + fr;
                const bf16x8 fb = *(const bf16x8*)(Kt + rj * 256 + ((ch ^ (rj & 15)) << 4));
                ak[nj] = MFMA16(fk, fb, ak[nj]);
                aq[nj] = MFMA16(fqq, fb, aq[nj]);
            }
        }
#pragma unroll
        for (int nj = 0; nj < 4; ++nj)
#pragma unroll
            for (int jj = 0; jj < 4; ++jj) {
                const int i = wid * 16 + 4 * fq + jj, j = nj * 16 + fr;
                const float dec = __expf(fminf(gc[i] - gc[j], 0.f));
                Ls[i * 68 + j] = i > j ? be[i] * ak[nj][jj] * dec : 0.f;
                ACH[(size_t)item * 4096 + i * 64 + j] = (bf16_t)f2bf(i >= j ? aq[nj][jj] * dec : 0.f);
            }
    }
    __syncthreads();
    asm volatile("" : "+v"(tid));
    float x[64];
    if (tid < 128) {
        const int cv = 2048 + h * 128 + tid;
        const float w0 = p.conv_w[cv], w1 = p.conv_w[3072 + cv], w2 = p.conv_w[2 * 3072 + cv], w3 = p.conv_w[3 * 3072 + cv];
        float xm3 = bf2f(halo[cv]), xm2 = bf2f(halo[3072 + cv]), xm1 = bf2f(halo[2 * 3072 + cv]);
        if (n == 0) { xm3 = 0.f; xm2 = 0.f; xm1 = 0.f; }
#pragma unroll
        for (int i = 0; i < 64; ++i) {
            const float xi = bf2f(PU[(size_t)(r0 + i) * 3072 + cv]);
            x[i] = siluf(w0 * xm3 + w1 * xm2 + w2 * xm1 + w3 * xi) * be[i];
            xm3 = xm2; xm2 = xm1; xm1 = xi;
            if ((i & 15) == 15) __builtin_amdgcn_sched_barrier(0);
        }
    } else {
        const int ck = tid - 128;
#pragma unroll
        for (int i = 0; i < 64; ++i) {
            const bf16_t kv = *(const bf16_t*)(Kt + i * 256 + (((ck >> 3) ^ (i & 15)) << 4) + (ck & 7) * 2);
            x[i] = bf2f(kv) * be[i] * eg[i];
            if ((i & 15) == 15) __builtin_amdgcn_sched_barrier(0);
        }
    }
#pragma unroll
    for (int i = 1; i < 64; ++i) {
        float a = x[i];
#pragma unroll
        for (int j4 = 0; j4 < (i + 3) / 4; ++j4) {
            const f32x4 l = *(const f32x4*)(Ls + i * 68 + j4 * 4);
            a -= l[0] * x[j4 * 4];
            if (j4 * 4 + 1 < i) a -= l[1] * x[j4 * 4 + 1];
            if (j4 * 4 + 2 < i) a -= l[2] * x[j4 * 4 + 2];
            if (j4 * 4 + 3 < i) a -= l[3] * x[j4 * 4 + 3];
        }
        x[i] = a;
        if ((i & 3) == 3) __builtin_amdgcn_sched_barrier(0);
    }
    __syncthreads();
    asm volatile("" : "+v"(tid));
    if (tid < 128) {
        const int sl = tid >> 4, f16 = tid & 15;
#pragma unroll
        for (int q4 = 0; q4 < 4; ++q4) {
            bf16_t* dst = UP + (((size_t)item * 8 + sl) * 64 + q4 * 16 + f16) * 16;
            u32x4 a, bq;
            a.x = pack2(x[0 + 4 * q4 + 0], x[0 + 4 * q4 + 1]); a.y = pack2(x[0 + 4 * q4 + 2], x[0 + 4 * q4 + 3]);
            a.z = pack2(x[16 + 4 * q4 + 0], x[16 + 4 * q4 + 1]); a.w = pack2(x[16 + 4 * q4 + 2], x[16 + 4 * q4 + 3]);
            bq.x = pack2(x[32 + 4 * q4 + 0], x[32 + 4 * q4 + 1]); bq.y = pack2(x[32 + 4 * q4 + 2], x[32 + 4 * q4 + 3]);
            bq.z = pack2(x[48 + 4 * q4 + 0], x[48 + 4 * q4 + 1]); bq.w = pack2(x[48 + 4 * q4 + 2], x[48 + 4 * q4 + 3]);
            *(u32x4*)dst = a; *(u32x4*)(dst + 8) = bq;
        }
    } else {
        const unsigned off = (unsigned)r0 * 3072u + 1024u + h * 128u + (tid - 128);
#pragma unroll
        for (int i = 0; i < 64; ++i) PU[off + (unsigned)i * 3072u] = (bf16_t)f2bf(x[i]);
    }
    {
        const int i = tid >> 2, part = tid & 3;
        const float e = eg[i];
#pragma unroll
        for (int c4 = 0; c4 < 4; ++c4) {
            const int ch = part * 4 + c4;
            const u32x4 v = *(const u32x4*)(Qt + i * 256 + ((ch ^ (i & 15)) << 4));
            u32x4 o;
            o.x = pack2(bflo(v.x) * e, bfhi(v.x) * e); o.y = pack2(bflo(v.y) * e, bfhi(v.y) * e);
            o.z = pack2(bflo(v.z) * e, bfhi(v.z) * e); o.w = pack2(bflo(v.w) * e, bfhi(v.w) * e);
            *(u32x4*)(PU + (size_t)(r0 + i) * 3072 + h * 128 + ch * 8) = o;
        }
    }
    {
        const int dk = tid & 127, ih = tid >> 7;
        const float gl = gc[63];
#pragma unroll
        for (int c4 = 0; c4 < 4; ++c4) {
            float v[8];
#pragma unroll
            for (int e = 0; e < 8; ++e) {
                const int i = ih * 32 + c4 * 8 + e;
                const bf16_t kv = *(const bf16_t*)(Kt + i * 256 + (((dk >> 3) ^ (i & 15)) << 4) + (dk & 7) * 2);
                v[e] = bf2f(kv) * __expf(gl - gc[i]);
            }
            u32x4 o; o.x = pack2(v[0], v[1]); o.y = pack2(v[2], v[3]); o.z = pack2(v[4], v[5]); o.w = pack2(v[6], v[7]);
            *(u32x4*)(KDT + ((size_t)item * 128 + dk) * 64 + ih * 32 + c4 * 8) = o;
        }
        if (tid == 0) GAM[item] = __expf(gl);
    }
}

DI bf16x8 frag_perm(const char* base, int rowbytes, int row, int c0, int fq) {
    const char* q = base + row * rowbytes + (c0 + 4 * fq) * 2;
    const s16x4 lo = *(const s16x4*)q, hi = *(const s16x4*)(q + 32);
    return cat4(lo, hi);
}
#define LDS_BARRIER() do { asm volatile("s_waitcnt lgkmcnt(0)" ::: "memory"); __builtin_amdgcn_s_barrier(); asm volatile("" ::: "memory"); } while (0)
DI void scan_block(const Params& p, int blk, char* lds) {
    char* C = p.ws + OFF_C;
    bf16_t* PU = (bf16_t*)(C + C_PU);
    const bf16_t* KDT = (const bf16_t*)(C + C_KDT); const bf16_t* ACH = (const bf16_t*)(C + C_ACH); const float* GAM = (const float*)(C + C_GAM);
    float* SSQ = (float*)(C + C_SSQ);
    const bf16_t* UP = (const bf16_t*)((const char*)p.out + T_UP);
    const int tid = threadIdx.x, lane = tid & 63, wid = tid >> 6, fr = lane & 15, fq = lane >> 4;
    const int bh = blk & 31, half = blk >> 5, b = bh >> 3, h = bh & 7;
    const int dvb = half * 64 + wid * 16;
    char* Wt = lds; char* Qt = lds + 17408; char* At = lds + 34816; char* Kd = lds + 43520;
    f32x4 S[8];
#pragma unroll
    for (int t = 0; t < 8; ++t) S[t] = (f32x4){0.f, 0.f, 0.f, 0.f};
    u32x4 rW[4], rQ[4], rA[2], rK[4];
    u32x4 rU[2];
    float gam;
#define SCAN_LOAD(nn) do { \
        int tid = threadIdx.x; asm volatile("" : "+v"(tid)); const int lane = tid & 63, wid = tid >> 6; \
        const int r0n_ = b * 4096 + (nn) * 64; const size_t it_ = (size_t)((b * 64 + (nn)) * 8 + h); \
        _Pragma("unroll") for (int i = 0; i < 4; ++i) { const int id = tid + 256 * i, row = id >> 4, ch = id & 15; \
            rW[i] = *(const u32x4*)(PU + (size_t)(r0n_ + row) * 3072 + 1024 + h * 128 + ch * 8); \
            rQ[i] = *(const u32x4*)(PU + (size_t)(r0n_ + row) * 3072 + h * 128 + ch * 8); } \
        _Pragma("unroll") for (int i = 0; i < 2; ++i) { const int id = tid + 256 * i; rA[i] = *(const u32x4*)(ACH + it_ * 4096 + (size_t)id * 8); } \
        _Pragma("unroll") for (int i = 0; i < 4; ++i) { const int id = tid + 256 * i; rK[i] = *(const u32x4*)(KDT + it_ * 8192 + (size_t)id * 8); } \
        { const bf16_t* up_ = UP + ((it_ * 8 + half * 4 + wid) * 64 + lane) * 16; rU[0] = *(const u32x4*)up_; rU[1] = *(const u32x4*)(up_ + 8); } \
        gam = GAM[it_]; } while (0)
    SCAN_LOAD(0);
    __syncthreads();
    for (int n = 0; n < 64; ++n) {
        const int r0 = b * 4096 + n * 64;
        int tid = threadIdx.x; asm volatile("" : "+v"(tid));
#pragma unroll
        for (int i = 0; i < 4; ++i) { const int id = tid + 256 * i, row = id >> 4, ch = id & 15;
            *(u32x4*)(Wt + row * 272 + ch * 16) = rW[i]; *(u32x4*)(Qt + row * 272 + ch * 16) = rQ[i]; }
#pragma unroll
        for (int i = 0; i < 2; ++i) { const int id = tid + 256 * i, row = id >> 3, ch = id & 7; char* q = At + row * 136 + ch * 16;
            *(u32x2*)q = (u32x2){rA[i].x, rA[i].y}; *(u32x2*)(q + 8) = (u32x2){rA[i].z, rA[i].w}; }
#pragma unroll
        for (int i = 0; i < 4; ++i) { const int id = tid + 256 * i, row = id >> 3, ch = id & 7; char* q = Kd + row * 136 + ch * 16;
            *(u32x2*)q = (u32x2){rK[i].x, rK[i].y}; *(u32x2*)(q + 8) = (u32x2){rK[i].z, rK[i].w}; }
        float uc[16];
#pragma unroll
        for (int i = 0; i < 8; ++i) { const unsigned w = i < 4 ? rU[0][i] : rU[1][i - 4]; uc[2 * i] = bflo(w); uc[2 * i + 1] = bfhi(w); }
        const float gcur = gam;
        LDS_BARRIER();
        if (n + 1 < 64) SCAN_LOAD(n + 1);
        bf16x8 Sb[4];
#pragma unroll
        for (int ks = 0; ks < 4; ++ks) Sb[ks] = pack8(S[2 * ks], S[2 * ks + 1]);
        f32x4 aw[4], ao[4];
#pragma unroll
        for (int m = 0; m < 4; ++m) { aw[m] = (f32x4){0.f, 0.f, 0.f, 0.f}; ao[m] = aw[m]; }
#pragma unroll
        for (int ks = 0; ks < 4; ++ks)
#pragma unroll
            for (int m = 0; m < 4; ++m) aw[m] = MFMA16(frag_perm(Wt, 272, 16 * m + fr, 32 * ks, fq), Sb[ks], aw[m]);
#pragma unroll
        for (int ks = 0; ks < 4; ++ks)
#pragma unroll
            for (int m = 0; m < 4; ++m) ao[m] = MFMA16(frag_perm(Qt, 272, 16 * m + fr, 32 * ks, fq), Sb[ks], ao[m]);
        f32x4 vn[4];
#pragma unroll
        for (int m = 0; m < 4; ++m)
#pragma unroll
            for (int jj = 0; jj < 4; ++jj) vn[m][jj] = uc[m * 4 + jj] - aw[m][jj];
        bf16x8 Vb[2];
        Vb[0] = pack8(vn[0], vn[1]); Vb[1] = pack8(vn[2], vn[3]);
#pragma unroll
        for (int t = 0; t < 8; ++t) S[t] = S[t] * gcur;
#pragma unroll
        for (int k2 = 0; k2 < 2; ++k2) {
#pragma unroll
            for (int m = 2 * k2; m < 4; ++m) ao[m] = MFMA16(frag_perm(At, 136, 16 * m + fr, 32 * k2, fq), Vb[k2], ao[m]);
#pragma unroll
            for (int t = 0; t < 8; ++t) S[t] = MFMA16(frag_perm(Kd, 136, 16 * t + fr, 32 * k2, fq), Vb[k2], S[t]);
        }
#pragma unroll
        for (int m = 0; m < 4; ++m)
#pragma unroll
            for (int j2 = 0; j2 < 2; ++j2) {
                const unsigned w = pack2(ao[m][2 * j2], ao[m][2 * j2 + 1]);
                const unsigned ob = (unsigned)(r0 + 4 * fq) * 3072u + 2048u + h * 128u + dvb + fr + (unsigned)(16 * m + 2 * j2) * 3072u;
                PU[ob] = (bf16_t)(w & 0xffffu); PU[ob + 3072u] = (bf16_t)(w >> 16);
            }
        LDS_BARRIER();
    }
#undef SCAN_LOAD
#pragma unroll
    for (int t = 0; t < 8; ++t)
#pragma unroll
        for (int jj = 0; jj < 4; ++jj)
            p.out[O_DELTAP + ((size_t)(b * 8 + h) * 128 + 16 * t + 4 * fq + jj) * 128 + dvb + fr] = S[t][jj];
}

DI void sdelta_item(const Params& p, int item, char* lds) {
    char* C = p.ws + OFF_C;
    bf16_t* PU = (bf16_t*)(C + C_PU);
    const float* PBA = (const float*)(C + C_PBA);
    float* SSQ = (float*)(C + C_SSQ);
    const int tid = threadIdx.x, lane = tid & 63, wid = tid >> 6;
    const int seq = item >> 3, h = item & 7, rs = MP + seq * 4;
    float* qs = (float*)lds;
    float* ks = qs + 512; float* vs = ks + 512;
    float* red = vs + 512;
    float* bt = red + 16; float* al = bt + 4;
    float* kSp = al + 4;
    float* op = kSp + 1024;
    const int ch = tid & 127, part = tid >> 7;
    __syncthreads();
    float yq[4];
    {
        const int nch = part == 0 ? 2 : 1;
        for (int cc = 0; cc < nch; ++cc) {
            const int c = part == 1 ? 1024 + h * 128 + ch : (cc == 0 ? h * 128 + ch : 2048 + h * 128 + ch);
            float full[7];
#pragma unroll
            for (int i = 0; i < 3; ++i) full[i] = p.st_conv[(size_t)(seq * 3 + i) * 3072 + c];
#pragma unroll
            for (int i = 0; i < 4; ++i) full[3 + i] = bf2f(PU[(size_t)(rs + i) * 3072 + c]);
#pragma unroll
            for (int i = 0; i < 3; ++i) p.out[O_CONVS + (size_t)(seq * 3 + i) * 3072 + c] = full[4 + i];
            const float w0 = p.conv_w[c], w1 = p.conv_w[3072 + c], w2 = p.conv_w[2 * 3072 + c], w3 = p.conv_w[3 * 3072 + c];
            float y[4];
#pragma unroll
            for (int t = 0; t < 4; ++t) y[t] = siluf(w0 * full[t] + w1 * full[t + 1] + w2 * full[t + 2] + w3 * full[t + 3]);
            if (part == 0 && cc == 1) {
#pragma unroll
                for (int t = 0; t < 4; ++t) vs[t * 128 + ch] = y[t];
            } else {
#pragma unroll
                for (int t = 0; t < 4; ++t) yq[t] = y[t];
            }
        }
    }
#pragma unroll
    for (int t = 0; t < 4; ++t) {
        float s = yq[t] * yq[t];
#pragma unroll
        for (int o = 32; o > 0; o >>= 1) s += __shfl_xor(s, o);
        if (lane == 0) red[wid * 4 + t] = s;
    }
    if (tid < 4) {
        const float braw = PBA[(size_t)(rs + tid) * 16 + h], araw = PBA[(size_t)(rs + tid) * 16 + 8 + h];
        bt[tid] = sigm(braw);
        al[tid] = __expf(-__expf(p.a_log[h]) * softplusf(araw + p.dt_bias[h]));
    }
    __syncthreads();
#pragma unroll
    for (int t = 0; t < 4; ++t) {
        const float tot = red[(2 * part) * 4 + t] + red[(2 * part + 1) * 4 + t];
        const float sc = rsqrtf(tot + EPSF) * (part == 0 ? 0.08838834764831845f : 1.f);
        (part == 0 ? qs : ks)[t * 128 + ch] = yq[t] * sc;
    }
    __syncthreads();
    const int dv = ch, dk0 = part * 64;
    float S[64];
    const float* s0 = p.st_delta + ((size_t)(seq * 8 + h) * 128 + dk0) * 128 + dv;
#pragma unroll
    for (int i = 0; i < 64; ++i) S[i] = s0[(size_t)i * 128];
#pragma unroll
    for (int t = 0; t < 4; ++t) {
        float pk = 0.f;
#pragma unroll
        for (int i = 0; i < 64; ++i) pk += ks[t * 128 + dk0 + i] * S[i];
        kSp[(t * 2 + part) * 128 + dv] = pk;
        __syncthreads();
        const float kS = kSp[(t * 2) * 128 + dv] + kSp[(t * 2 + 1) * 128 + dv];
        const float a = al[t];
        const float vnew = bt[t] * (vs[t * 128 + dv] - a * kS);
        float po = 0.f;
#pragma unroll
        for (int i = 0; i < 64; ++i) { S[i] = a * S[i] + ks[t * 128 + dk0 + i] * vnew; po += qs[t * 128 + dk0 + i] * S[i]; }
        op[(t * 2 + part) * 128 + dv] = po;
        __syncthreads();
        if (part == 0) {
            const float o = op[(t * 2) * 128 + dv] + op[(t * 2 + 1) * 128 + dv];
            PU[(size_t)(rs + t) * 3072 + 2048 + h * 128 + dv] = (bf16_t)f2bf(o);
        }
    }
    float* so = p.out + O_DELTAS + ((size_t)(seq * 8 + h) * 128 + dk0) * 128 + dv;
#pragma unroll
    for (int i = 0; i < 64; ++i) so[(size_t)i * 128] = S[i];
}

DI void attn_block(const Params& p, int bt) {
    char* C = p.ws + OFF_C;
    bf16_t* PQ = (bf16_t*)(C + C_PQ);
    const bf16_t* PKV = (const bf16_t*)(C + C_PKV); const bf16_t* KCS = (const bf16_t*)(C + C_KCS);
    const bf16_t* VTP = (const bf16_t*)(C + C_VTP); const bf16_t* VTS = (const bf16_t*)(C + C_VTS);
    const int lane = threadIdx.x & 63, wid = threadIdx.x >> 6, fr = lane & 15, fq = lane >> 4;
    const bool isS = bt >= 4096;
    int b = 0, kvh, t0 = 0, seq = 0, head, qrow;
    if (!isS) { b = bt >> 10; kvh = (bt >> 8) & 3; t0 = (bt & 255) * 16; head = kvh * 4 + wid; qrow = b * 4096 + t0 + fr; }
    else { seq = bt - 4096; kvh = wid; head = kvh * 4 + (fr >> 2); qrow = MP + seq * 4 + (fr & 3); }
    bf16_t* qp = PQ + (size_t)qrow * 1024 + head * 64;
    const float sink = p.sinks[head];
    bf16x8 bq[2];
    bq[0] = *(const bf16x8*)(qp + fq * 8); bq[1] = *(const bf16x8*)(qp + 32 + fq * 8);
    f32x4 sc[10];
#pragma unroll
    for (int n = 0; n < 10; ++n) {
        const bf16_t* kp;
        if (!isS) { int t = t0 - 144 + 16 * n + fr; t = t < 0 ? 0 : t; kp = PKV + (size_t)(b * 4096 + t) * 512 + kvh * 64; }
        else { int s = 16 * n + fr; s = s > 143 ? 143 : s; kp = KCS + (size_t)(seq * 144 + s) * 256 + kvh * 64; }
        f32x4 a = (f32x4){0.f, 0.f, 0.f, 0.f};
        a = MFMA16(*(const bf16x8*)(kp + fq * 8), bq[0], a);
        a = MFMA16(*(const bf16x8*)(kp + 32 + fq * 8), bq[1], a);
        sc[n] = a;
    }
    float mx = sink;
#pragma unroll
    for (int n = 0; n < 10; ++n)
#pragma unroll
        for (int jj = 0; jj < 4; ++jj) {
            const int kidx = 16 * n + 4 * fq + jj;
            bool valid;
            if (!isS) { const int t = t0 - 144 + kidx, d = 144 + fr - kidx; valid = t >= 0 && d >= 0 && d <= 128; }
            else { const int d = (fr & 3) + 128 - kidx; valid = d >= 0 && d <= 128; }
            const float s = valid ? sc[n][jj] * 0.125f : -1e30f;
            sc[n][jj] = s; mx = fmaxf(mx, s);
        }
    mx = fmaxf(mx, __shfl_xor(mx, 16)); mx = fmaxf(mx, __shfl_xor(mx, 32));
    float sum = 0.f;
#pragma unroll
    for (int n = 0; n < 10; ++n)
#pragma unroll
        for (int jj = 0; jj < 4; ++jj) { const float e = __expf(sc[n][jj] - mx); sc[n][jj] = e; sum += e; }
    sum += __shfl_xor(sum, 16); sum += __shfl_xor(sum, 32);
    const float inv = 1.f / (sum + __expf(sink - mx));
    bf16x8 bP[5];
#pragma unroll
    for (int s5 = 0; s5 < 5; ++s5) bP[s5] = pack8(sc[2 * s5] * inv, sc[2 * s5 + 1] * inv);
#pragma unroll
    for (int ds = 0; ds < 4; ++ds) {
        const bf16_t* vrow = !isS ? VTP + (size_t)(b * 256 + kvh * 64 + 16 * ds + fr) * 4096 : VTS + (size_t)(seq * 256 + kvh * 64 + 16 * ds + fr) * 160;
        f32x4 a = (f32x4){0.f, 0.f, 0.f, 0.f};
#pragma unroll
        for (int s5 = 0; s5 < 5; ++s5) {
            int g0 = 32 * s5 + 4 * fq, g1 = g0 + 16;
            if (!isS) { g0 += t0 - 144; g1 += t0 - 144; g0 = g0 < 0 ? 0 : g0; g1 = g1 < 0 ? 0 : g1; }
            const s16x4 lo = *(const s16x4*)(vrow + g0), hi = *(const s16x4*)(vrow + g1);
            a = MFMA16(cat4(lo, hi), bP[s5], a);
        }
        u32x2 w; w.x = pack2(a[0], a[1]); w.y = pack2(a[2], a[3]);
        *(u32x2*)(qp + 16 * ds + 4 * fq) = w;
    }
}

DI void sample_window_out(const Params& p) {
    const bf16_t* PKV = (const bf16_t*)(p.ws + OFF_C + C_PKV);
    const int gt = blockIdx.x * 256 + threadIdx.x, gs = gridDim.x * 256;
    for (int i = gt; i < 128 * 128 * 128; i += gs) {
        const int c = (i & 127) * 4, s = (i >> 7) & 127, seq = i >> 14;
        const int cc = c & 255; const bool isv = c >= 256;
        f32x4 v;
        if (s < 124) v = *(const f32x4*)((isv ? p.cache_v : p.cache_k) + (size_t)(seq * 128 + s + 4) * 256 + cc);
        else { const u32x2 w = *(const u32x2*)(PKV + (size_t)(MP + seq * 4 + s - 124) * 512 + c); v = (f32x4){bflo(w.x), bfhi(w.x), bflo(w.y), bfhi(w.y)}; }
        *(f32x4*)(p.out + (isv ? O_SWVS : O_SWKS) + (size_t)(seq * 128 + s) * 256 + cc) = v;
    }
}

DI void phase_mixer(const Params& p, char* lds) {
    const int nb = gridDim.x, blk = blockIdx.x;
    const int nscan = 64;
#ifndef MK_P9
#define MK_P9 7
#endif
    if (blk < nscan) { if (MK_P9 & 1) scan_block(p, blk, lds); return; }
    const int wb = blk - nscan, nw = nb - nscan;
    if (MK_P9 & 2) for (int it = wb; it < 1024; it += nw) sdelta_item(p, it, lds);
    if (MK_P9 & 4) for (int bt = wb; bt < 4224; bt += nw) attn_block(p, bt);
}

#define XB_TMO      128
#define XB_XCNT(j)  (256  + 64 * (j))
#define XB_XSUB(j)  (1280 + 64 * (j))
#define XB_XGEN(j)  (2304 + 64 * (j))
#define XB_TOP      3328
#define XB_TOPGEN   3392
#define XCD_BAR_WORDS 3456
#define XB_SPIN_CAP (1u << 22)
DI unsigned xb_ld(unsigned* p) { return __hip_atomic_load(p, __ATOMIC_RELAXED, __HIP_MEMORY_SCOPE_AGENT); }
DI unsigned xb_add(unsigned* p, unsigned v) { return __hip_atomic_fetch_add(p, v, __ATOMIC_RELAXED, __HIP_MEMORY_SCOPE_AGENT); }
DI unsigned xb_xcc_id() { return (unsigned)__builtin_amdgcn_s_getreg((3 << 11) | 20) & 0xFu; }
#define XB_SPIN(cond, bar) do { unsigned _sp = 0; while (cond) { __builtin_amdgcn_s_sleep(1); \
    if ((++_sp & 255u) == 0u) { if (xb_ld(&(bar)[XB_TMO])) break; if (_sp > XB_SPIN_CAP) { atomicAdd(&(bar)[XB_TMO], 1u); break; } } } } while (0)
struct XcdBarrier { unsigned* bar; unsigned x; unsigned nloc; unsigned nx; };
DI XcdBarrier xcd_barrier_post(unsigned* bar) {
    XcdBarrier b; b.bar = bar; b.x = xb_xcc_id(); b.nloc = 0u; b.nx = 0u;
    if (threadIdx.x == 0) (void)xb_add(&bar[XB_XCNT(b.x)], 1u);
    return b;
}
DI void xcd_barrier_complete(unsigned* bar, unsigned x, unsigned& nloc, unsigned& nx) {
    const unsigned G = gridDim.x * gridDim.y * gridDim.z;
    unsigned sum, cnt, mine, sp = 0u;
    for (;;) {
        sum = 0u; cnt = 0u; mine = 0u;
#pragma unroll
        for (unsigned j = 0; j < 16; ++j) { const unsigned c = xb_ld(&bar[XB_XCNT(j)]); sum += c; cnt += (c > 0u) ? 1u : 0u; mine = (j == x) ? c : mine; }
        if (sum == G) break;
        __builtin_amdgcn_s_sleep(1);
        if ((++sp & 255u) == 0u) { if (xb_ld(&bar[XB_TMO])) break; if (sp > XB_SPIN_CAP) { atomicAdd(&bar[XB_TMO], 1u); break; } }
    }
    nloc = mine > 0u ? mine : 1u; nx = cnt > 0u ? cnt : 1u;
}
DI void xcd_barrier(XcdBarrier& b) {
    asm volatile("s_waitcnt vmcnt(0)" ::: "memory");
    __syncthreads();
    if (threadIdx.x == 0) {
        unsigned* bar = b.bar;
        __builtin_amdgcn_s_waitcnt(0);
        unsigned nloc = b.nloc, nx = b.nx;
        if (nloc == 0u) { xcd_barrier_complete(bar, b.x, nloc, nx); b.nloc = nloc; b.nx = nx; }
        const unsigned old = xb_add(&bar[XB_XSUB(b.x)], 1u);
        const unsigned gen = old / nloc;
        if (old + 1u == (gen + 1u) * nloc) {
            __builtin_amdgcn_fence(__ATOMIC_RELEASE, "agent");
            asm volatile("s_waitcnt vmcnt(0)" ::: "memory");
            const unsigned og = xb_add(&bar[XB_TOP], 1u);
            const unsigned tg = og / nx;
            if (og + 1u == (tg + 1u) * nx) xb_add(&bar[XB_TOPGEN], 1u);
            else XB_SPIN(xb_ld(&bar[XB_TOPGEN]) == tg, bar);
            __builtin_amdgcn_fence(__ATOMIC_ACQUIRE, "agent");
            xb_add(&bar[XB_XGEN(b.x)], 1u);
            asm volatile("s_waitcnt vmcnt(0)" ::: "memory");
        } else {
            XB_SPIN(xb_ld(&bar[XB_XGEN(b.x)]) == gen, bar);
            __builtin_amdgcn_fence(__ATOMIC_ACQUIRE, "agent");
            asm volatile("s_waitcnt vmcnt(0)" ::: "memory");
        }
    }
    __syncthreads();
}
constexpr size_t OFF_BAR = 293921280;

template <bool COOP>
__global__ void __launch_bounds__(256, 2) mega(Params p) {
    __shared__ __attribute__((aligned(16))) char lds[65536];
    XcdBarrier xb;
    if (COOP) {
        xb = xcd_barrier_post((unsigned*)(p.ws + OFF_BAR));
        if (p.plo < 0) cg::this_grid().sync();
    }
    char* ws = p.ws; char* C = ws + OFF_C; char* ob = (char*)p.out;
    bf16_t* H = (bf16_t*)(ws + OFF_H);
    bf16_t* F = (bf16_t*)(C + C_F);
#define RUNPH(k, ...) do { if (PHON(k) && p.plo <= (k) && (k) < p.phi) { __VA_ARGS__ } \
        if (COOP && p.plo <= (k) && (k) + 1 < p.phi) { xcd_barrier(xb); } } while (0)
    RUNPH(0, phase_prologue(p, lds););
    RUNPH(1, EpiF32 e{(float*)(ws + OFF_MOD), 9216, p.b_ada}; gemm_phase<4>((const bf16_t*)(ws + OFF_SC), (const bf16_t*)(C + C_WADA), 1024, 2, 72, lds, e););
    RUNPH(2, norm_phase(p, true, nullptr, 0, 0.f, nullptr, false, p.n1pre, 0, 1););
    RUNPH(3, EpiSwiglu e{(bf16_t*)(C + C_ACT)}; gemm_phase<4>(H, (const bf16_t*)(ob + T_W1GU), 1024, 132, 43, lds, e););
    RUNPH(4, EpiBf16 e{F, 1024}; gemm_phase<4>((const bf16_t*)(C + C_ACT), (const bf16_t*)(ob + T_W1D), DFF, 132, 8, lds, e););
    RUNPH(5, norm_phase(p, true, F, 2, 0.5f, p.n1post, true, p.nmpre, 3, 4););
    RUNPH(6, EpiP e{(bf16_t*)(C + C_PU), (bf16_t*)(C + C_PQ), (bf16_t*)(C + C_PKV), (float*)(C + C_PBA), (const float*)(ws + OFF_ROPE), (bf16_t*)(C + C_HALO), p.out};
             gemm_phase<4>(H, (const bf16_t*)(ob + T_WA), 1024, 132, 37, lds, e););
    RUNPH(8, for (int it = blockIdx.x; it < 2048; it += gridDim.x) prep_item(p, it, lds); __syncthreads(); phase_mixprep(p, lds););
    RUNPH(9, phase_mixer(p, lds););
    RUNPH(10, sample_window_out(p); EpiMerge e{(const bf16_t*)(C + C_PU), (const bf16_t*)(C + C_PQ), p.dn_norm, (bf16_t*)(C + C_Y)};
              gemm_phase<3>(H, (const bf16_t*)(ws + OFF_WB), 1024, 132, 32, lds, e););
    RUNPH(11, EpiBf16 e{F, 1024}; gemm_phase<4>((const bf16_t*)(C + C_Y), (const bf16_t*)(ws + OFF_WO), 1024, 132, 8, lds, e););
    RUNPH(12, norm_phase(p, false, F, 5, 1.0f, p.nmpost, true, p.n2pre, 6, 7); cvt_jobs<13, 16>(p, lds););
    RUNPH(13, EpiSwiglu e{(bf16_t*)(C + C_ACT)}; gemm_phase<4>(H, (const bf16_t*)(C + C_W2GU), 1024, 132, 43, lds, e););
    RUNPH(14, EpiBf16 e{F, 1024}; gemm_phase<4>((const bf16_t*)(C + C_ACT), (const bf16_t*)(C + C_W2D), DFF, 132, 8, lds, e););
    RUNPH(15, norm_phase(p, false, F, 8, 0.5f, p.n2post, true, nullptr, 0, 0););
#undef RUNPH
}

constexpr int NPHASE = 16;

extern "C" void kernel_launch(void* const* d_in, const int* in_sizes, int n_in, void* d_out, int out_size, void* d_ws, size_t ws_size,
                              hipStream_t stream) {
    Params p{};
    const float** pp = (const float**)&p;
    for (int i = 0; i < 29; ++i) pp[i] = (const float*)d_in[i];
    p.out = (float*)d_out; p.ws = (char*)d_ws; p.plo = 0; p.phi = NPHASE;
#if MK_COOP
    static int grid_blocks = 0;
    if (!grid_blocks) {
        int dev = 0, cus = 0, per_cu = 0;
        (void)hipGetDevice(&dev);
        (void)hipDeviceGetAttribute(&cus, hipDeviceAttributeMultiprocessorCount, dev);
        (void)hipOccupancyMaxActiveBlocksPerMultiprocessor(&per_cu, mega<true>, 256, 0);
        if (per_cu > 2) per_cu = 2;
        grid_blocks = cus * per_cu;
    }
    void* args[] = {&p};
    (void)hipMemsetAsync((char*)d_ws + OFF_BAR, 0, XCD_BAR_WORDS * 4, stream);
    hipError_t e = hipLaunchCooperativeKernel((void*)mega<true>, dim3(grid_blocks), dim3(256), args, 0, stream);
    if (e != hipSuccess) fprintf(stderr, "cooperative launch failed: %s (grid %d)\n", hipGetErrorString(e), grid_blocks);
#else
    for (int ph = 0; ph < NPHASE; ++ph) {
        p.plo = ph; p.phi = ph + 1;
        hipLaunchKernelGGL(mega<false>, dim3(512), dim3(256), 0, stream, p);
    }
#endif
}
```

```cpp
#include <hip/hip_runtime.h>
#include <hip/hip_cooperative_groups.h>
#include <stdint.h>
#include <cstdio>
namespace cg = cooperative_groups;

#ifndef MK_COOP
#define MK_COOP 1
#endif
#ifndef MK_ONLY
#define MK_ONLY -1
#endif
#define PHON(k) (MK_ONLY < 0 || MK_ONLY == (k))

#define DI __device__ __forceinline__
typedef unsigned short bf16_t;
typedef short bf16x8 __attribute__((ext_vector_type(8)));
typedef short s16x4 __attribute__((ext_vector_type(4)));
typedef float f32x4 __attribute__((ext_vector_type(4)));
typedef unsigned u32x4 __attribute__((ext_vector_type(4)));
typedef unsigned u32x2 __attribute__((ext_vector_type(2)));
#define LAS __attribute__((address_space(3)))
#define MFMA16(a, b, c) __builtin_amdgcn_mfma_f32_16x16x32_bf16((a), (b), (c), 0, 0, 0)

constexpr int MP = 16384, MALL = 16896, DM = 1024, DFF = 2752;
constexpr float EPSF = 1e-6f;
constexpr size_t OFF_MOD = 0;
constexpr size_t OFF_H = 9437184;
constexpr size_t OFF_WB = 44040192;
constexpr size_t OFF_WO = 50331648;
constexpr size_t OFF_SC = 52428800;
constexpr size_t OFF_ROPE = 52953088;
constexpr size_t OFF_C = 53215744;
constexpr size_t C_F = 0;
constexpr size_t C_ACT = 69206016;
constexpr size_t C_WADA = 0;
constexpr size_t C_PU = 0;
constexpr size_t C_KDT = 103809024;
constexpr size_t C_ACH = 137363456;
constexpr size_t C_PQ = 154140672;
constexpr size_t C_PKV = 188743680;
constexpr size_t C_KCS = 206045184;
constexpr size_t C_VTP = 215482368;
constexpr size_t C_VTS = 223870976;
constexpr size_t C_PBA = 234356736;
constexpr size_t C_SSQ = 235438080;
constexpr size_t C_GAM = 235978752;
constexpr size_t C_Y = C_KDT;
constexpr size_t C_W2GU = 166723584;
constexpr size_t C_W2D = 177995776;
constexpr size_t O_Y = 0, O_SWKP = 17301504, O_SWVP = 17432576, O_CONVP = 17563648, O_DELTAP = 17600512,
                 O_SWKS = 18124800, O_SWVS = 22319104, O_CONVS = 26513408, O_DELTAS = 27693056;
constexpr size_t T_W1GU = O_SWKS * 4;
constexpr size_t T_W1D = T_W1GU + 11272192;
constexpr size_t T_WA = T_W1D + 5636096;
constexpr size_t T_UP = O_SWKS * 4;
constexpr size_t C_HALO = 235986944;

struct Params {
    const float* x_p; const float* x_s; const float* cache_k; const float* cache_v; const float* st_conv; const float* st_delta;
    const float* c_p; const float* c_s; const float* w_ada; const float* b_ada;
    const float* n1pre; const float* n1post; const float* w1g; const float* w1u; const float* w1d;
    const float* nmpre; const float* nmpost; const float* w_in; const float* conv_w; const float* a_log; const float* dt_bias;
    const float* dn_norm; const float* sinks; const float* w_out;
    const float* n2pre; const float* n2post; const float* w2g; const float* w2u; const float* w2d;
    float* out; char* ws; int plo; int phi;
};

typedef __bf16 bf16v2_t __attribute__((ext_vector_type(2)));
typedef float f32v2_t __attribute__((ext_vector_type(2)));
DI unsigned pack2(float a, float b) { const f32v2_t v = {a, b}; return __builtin_bit_cast(unsigned, __builtin_convertvector(v, bf16v2_t)); }
DI unsigned f2bf(float x) { return pack2(x, 0.f) & 0xffffu; }
DI float bf2f(unsigned h) { return __uint_as_float(h << 16); }
DI float bflo(unsigned w) { return __uint_as_float(w << 16); }
DI float bfhi(unsigned w) { return __uint_as_float(w & 0xffff0000u); }
DI float sigm(float x) { return __builtin_amdgcn_rcpf(1.f + __expf(-x)); }
DI float siluf(float x) { return x * __builtin_amdgcn_rcpf(1.f + __expf(-x)); }
DI float softplusf(float x) { return fmaxf(x, 0.f) + log1pf(__expf(-fabsf(x))); }
DI bf16x8 pack8(const f32x4& a, const f32x4& b) {
    u32x4 p; p.x = pack2(a[0], a[1]); p.y = pack2(a[2], a[3]); p.z = pack2(b[0], b[1]); p.w = pack2(b[2], b[3]);
    return __builtin_bit_cast(bf16x8, p);
}
DI bf16x8 cat4(const s16x4& lo, const s16x4& hi) { return __builtin_shufflevector(lo, hi, 0, 1, 2, 3, 4, 5, 6, 7); }

template <int NT, class Epi>
DI void gemm_phase(const bf16_t* __restrict__ A, const bf16_t* __restrict__ Bt, int K, int nmt, int nnt, char* lds, const Epi& epi) {
    const int tid = threadIdx.x, lane = tid & 63, wid = tid >> 6, fr = lane & 15, fq = lane >> 4;
    const int wm = wid >> 1, wn = wid & 1;
    constexpr int BN = NT * 32;
    constexpr int BCH = BN / 32;
    const int ntiles = nmt * nnt, nk = K >> 6;
    const int srow = tid >> 3, spos = tid & 7;
    const bool xmap = nmt >= 16 && (gridDim.x & 7) == 0;
    const int xcd = blockIdx.x & 7;
    const int mlo = xmap ? (xcd * nmt) >> 3 : 0, mcnt = xmap ? (((xcd + 1) * nmt) >> 3) - mlo : nmt;
    const int estart = xmap ? (int)(blockIdx.x >> 3) : (int)blockIdx.x, estep = xmap ? (int)(gridDim.x >> 3) : (int)gridDim.x;
    const int etotal = xmap ? mcnt * nnt : ntiles;
    for (int e = estart; e < etotal; e += estep) {
        int mt, nt;
        if (xmap) {
            const int pg = mcnt * 8, ng = e / pg, nrem = nnt - ng * 8, gw = nrem < 8 ? nrem : 8, r = e - ng * pg, mi = r / gw;
            mt = mlo + mi; nt = ng * 8 + (r - mi * gw);
        } else { mt = e % nmt; nt = e / nmt; }
        const int m0 = mt * 128, n0 = nt * BN;
        f32x4 acc[4][NT];
#pragma unroll
        for (int m = 0; m < 4; ++m)
#pragma unroll
            for (int n = 0; n < NT; ++n) acc[m][n] = (f32x4){0.f, 0.f, 0.f, 0.f};
        const bf16_t* ag[4]; const bf16_t* bg[BCH];
#pragma unroll
        for (int i = 0; i < 4; ++i) { const int row = srow + 32 * i; ag[i] = A + (size_t)(m0 + row) * K + ((spos ^ ((row >> 1) & 7)) << 3); }
#pragma unroll
        for (int i = 0; i < BCH; ++i) { const int row = srow + 32 * i; bg[i] = Bt + (size_t)(n0 + row) * K + ((spos ^ ((row >> 1) & 7)) << 3); }
        __syncthreads();
#define GEMM_ISSUE(kt_, st_) do { \
        _Pragma("unroll") for (int i = 0; i < 4; ++i) __builtin_amdgcn_global_load_lds((const unsigned*)(ag[i] + (kt_) * 64), (LAS unsigned*)(lds + (st_) * 32768 + i * 4096 + wid * 1024), 16, 0, 0); \
        _Pragma("unroll") for (int i = 0; i < BCH; ++i) __builtin_amdgcn_global_load_lds((const unsigned*)(bg[i] + (kt_) * 64), (LAS unsigned*)(lds + (st_) * 32768 + 16384 + i * 4096 + wid * 1024), 16, 0, 0); } while (0)
        GEMM_ISSUE(0, 0);
        for (int kt = 0; kt < nk; ++kt) {
            asm volatile("s_waitcnt vmcnt(0)" ::: "memory");
            __syncthreads();
            if (kt + 1 < nk) GEMM_ISSUE(kt + 1, (kt + 1) & 1);
            const char* As = lds + (kt & 1) * 32768;
            const char* Bs = As + 16384;
            bf16x8 af[2][4], bfr[2][NT];
#pragma unroll
            for (int ks = 0; ks < 2; ++ks) {
                const int ch = ks * 4 + fq;
#pragma unroll
                for (int m = 0; m < 4; ++m) { const int row = wm * 64 + m * 16 + fr; af[ks][m] = *(const bf16x8*)(As + row * 128 + ((ch ^ ((row >> 1) & 7)) << 4)); }
#pragma unroll
                for (int n = 0; n < NT; ++n) { const int row = wn * NT * 16 + n * 16 + fr; bfr[ks][n] = *(const bf16x8*)(Bs + row * 128 + ((ch ^ ((row >> 1) & 7)) << 4)); }
            }
            __builtin_amdgcn_s_setprio(1);
#pragma unroll
            for (int ks = 0; ks < 2; ++ks)
#pragma unroll
                for (int m = 0; m < 4; ++m)
#pragma unroll
                    for (int n = 0; n < NT; ++n) acc[m][n] = MFMA16(bfr[ks][n], af[ks][m], acc[m][n]);
            __builtin_amdgcn_s_setprio(0);
        }
#undef GEMM_ISSUE
        epi(acc, m0 + wm * 64 + fr, n0, wn, fq, lane);
    }
}

struct EpiF32 {
    float* C; int ldc; const float* bias;
    DI void operator()(const f32x4 (&acc)[4][4], int rowb, int n0, int wn, int fq, int) const {
#pragma unroll
        for (int m = 0; m < 4; ++m)
#pragma unroll
            for (int n = 0; n < 4; ++n) {
                const int col = n0 + wn * 64 + n * 16 + 4 * fq;
                f32x4 v = acc[m][n];
                if (bias) { const f32x4 bv = *(const f32x4*)(bias + col); v = v + bv; }
                *(f32x4*)(C + (size_t)(rowb + m * 16) * ldc + col) = v;
            }
    }
};
struct EpiBf16 {
    bf16_t* O; int ldc;
    DI void operator()(const f32x4 (&acc)[4][4], int rowb, int n0, int wn, int fq, int) const {
#pragma unroll
        for (int m = 0; m < 4; ++m)
#pragma unroll
            for (int n = 0; n < 4; ++n) {
                const f32x4 v = acc[m][n]; u32x2 w; w.x = pack2(v[0], v[1]); w.y = pack2(v[2], v[3]);
                *(u32x2*)(O + (size_t)(rowb + m * 16) * ldc + n0 + wn * 64 + n * 16 + 4 * fq) = w;
            }
    }
};
struct EpiSwiglu {
    bf16_t* O;
    DI void operator()(const f32x4 (&acc)[4][4], int rowb, int n0, int wn, int fq, int) const {
        const int cb = (n0 >> 1) + wn * 32 + 4 * fq;
#pragma unroll
        for (int m = 0; m < 4; ++m)
#pragma unroll
            for (int n2 = 0; n2 < 2; ++n2) {
                const f32x4 g = acc[m][2 * n2], u = acc[m][2 * n2 + 1];
                u32x2 w; w.x = pack2(siluf(g[0]) * u[0], siluf(g[1]) * u[1]); w.y = pack2(siluf(g[2]) * u[2], siluf(g[3]) * u[3]);
                *(u32x2*)(O + (size_t)(rowb + m * 16) * DFF + cb + n2 * 16) = w;
            }
    }
};
struct EpiP {
    bf16_t* PU; bf16_t* PQ; bf16_t* PKV; float* PBA; const float* rope; bf16_t* HALO; float* out;
    DI void operator()(const f32x4 (&acc)[4][4], int rowb, int n0, int wn, int fq, int) const {
        if (n0 < 3072) {
#pragma unroll
            for (int m = 0; m < 4; ++m)
#pragma unroll
                for (int n = 0; n < 4; ++n) {
                    const f32x4 v = acc[m][n]; u32x2 w; w.x = pack2(v[0], v[1]); w.y = pack2(v[2], v[3]);
                    const int row = rowb + m * 16, col = n0 + wn * 64 + n * 16 + 4 * fq;
                    *(u32x2*)(PU + (size_t)row * 3072 + col) = w;
                    if ((row & 63) >= 61 && row < MP && (row & 4095) < 4032)
                        *(u32x2*)(HALO + ((size_t)((row >> 6) + 1) * 3 + ((row & 63) - 61)) * 3072 + col) = w;
                    if (row < MP && (row & 4095) >= 4093)
                        *(f32x4*)(out + O_CONVP + ((size_t)(row >> 12) * 3 + ((row & 4095) - 4093)) * 3072 + col) = v;
                }
        } else if (n0 < 4608) {
            const bool isq = n0 < 4096;
            const int cw = (isq ? n0 - 3072 : n0 - 4096) + wn * 64;
            const bool rot = isq || cw < 256;
            bf16_t* dst = isq ? PQ : PKV; const int ld = isq ? 1024 : 512;
#pragma unroll
            for (int m = 0; m < 4; ++m) {
                const int row = rowb + m * 16;
                const int pidx = row < MP ? (row & 4095) : 4096 + (row & 3);
                const float* tab = rope + pidx * 16 + 4 * (fq & 1);
#pragma unroll
                for (int n = 0; n < 4; ++n) {
                    f32x4 v = acc[m][n];
                    if (n == 0) {
                        f32x4 pr;
#pragma unroll
                        for (int j = 0; j < 4; ++j) pr[j] = __shfl_xor(v[j], 32);
                        if (rot) {
#pragma unroll
                            for (int j = 0; j < 4; ++j) { const float c = tab[j], s = tab[8 + j]; v[j] = (fq < 2) ? v[j] * c - pr[j] * s : v[j] * c + pr[j] * s; }
                        }
                    }
                    u32x2 w; w.x = pack2(v[0], v[1]); w.y = pack2(v[2], v[3]);
                    *(u32x2*)(dst + (size_t)row * ld + cw + n * 16 + 4 * fq) = w;
                    if (!isq && row < MP && (row & 4095) >= 3968) {
                        const int cc = cw + n * 16 + 4 * fq;
                        *(f32x4*)(out + (cc < 256 ? O_SWKP : O_SWVP) + ((size_t)(row >> 12) * 128 + ((row & 4095) - 3968)) * 256 + (cc & 255)) = v;
                    }
                }
            }
        } else {
            if (wn == 0) {
#pragma unroll
                for (int m = 0; m < 4; ++m) *(f32x4*)(PBA + (size_t)(rowb + m * 16) * 16 + 4 * fq) = acc[m][0];
            }
        }
    }
};
struct EpiMerge {
    const bf16_t* PU; const bf16_t* PQ; const float* dng; bf16_t* Y;
    DI void operator()(const f32x4 (&acc)[4][3], int rowb, int n0, int wn, int fq, int) const {
        const int c0 = (n0 / 96) * 32 + wn * 16 + 4 * fq;
        const f32x4 gn = *(const f32x4*)(dng + (c0 & 127));
        u32x4 ov[4][4];
#pragma unroll
        for (int m = 0; m < 4; ++m) {
            const bf16_t* op = PU + (size_t)(rowb + m * 16) * 3072 + 2048 + (c0 & ~127) + fq * 32;
#pragma unroll
            for (int i = 0; i < 4; ++i) ov[m][i] = *(const u32x4*)(op + i * 8);
        }
#pragma unroll
        for (int m = 0; m < 4; ++m) {
            const int row = rowb + m * 16;
            float ss = 0.f;
#pragma unroll
            for (int i = 0; i < 4; ++i)
#pragma unroll
                for (int e = 0; e < 4; ++e) { const float a = bflo(ov[m][i][e]), b = bfhi(ov[m][i][e]); ss += a * a + b * b; }
            ss += __shfl_xor(ss, 16); ss += __shfl_xor(ss, 32);
            const float rstd = rsqrtf(ss * (1.f / 128.f) + EPSF);
            const u32x2 ou = *(const u32x2*)(PU + (size_t)row * 3072 + 2048 + c0);
            const u32x2 os = *(const u32x2*)(PQ + (size_t)row * 1024 + c0);
            const float od[4] = {bflo(ou.x), bfhi(ou.x), bflo(ou.y), bfhi(ou.y)};
            const float sw[4] = {bflo(os.x), bfhi(os.x), bflo(os.y), bfhi(os.y)};
            float y[4];
#pragma unroll
            for (int j = 0; j < 4; ++j) y[j] = sigm(acc[m][1][j]) * (od[j] * rstd * gn[j]) * siluf(acc[m][0][j]) + sigm(acc[m][2][j]) * sw[j];
            u32x2 w; w.x = pack2(y[0], y[1]); w.y = pack2(y[2], y[3]);
            *(u32x2*)(Y + (size_t)row * 1024 + c0) = w;
        }
    }
};

struct CvtJob { const float* src; int ld; int K; int col0; int ncols; bf16_t* dst; int G; int which; int rowbase; };
DI int job_tiles(const CvtJob& j) { return ((j.ncols + 63) >> 6) * (j.K >> 6); }
DI void cvt_tile(const CvtJob& j, int t, char* lds) {
    float* tl = (float*)lds;
    const int tid = threadIdx.x;
    const int nkt = j.K >> 6, ct = t / nkt, kt = t % nkt, c0 = ct * 64, k0 = kt * 64;
    __syncthreads();
#pragma unroll
    for (int i = 0; i < 4; ++i) {
        const int kr = (tid >> 4) + 16 * i, col = (tid & 15) * 4;
        f32x4 v = (f32x4){0.f, 0.f, 0.f, 0.f};
        if (c0 + col < j.ncols) v = *(const f32x4*)(j.src + (size_t)(k0 + kr) * j.ld + j.col0 + c0 + col);
        tl[kr * 65 + col] = v[0]; tl[kr * 65 + col + 1] = v[1]; tl[kr * 65 + col + 2] = v[2]; tl[kr * 65 + col + 3] = v[3];
    }
    __syncthreads();
#pragma unroll
    for (int i = 0; i < 2; ++i) {
        const int col = (tid >> 3) + 32 * i, ch = tid & 7, jc = c0 + col;
        if (jc < j.ncols) {
            const int drow = j.rowbase + (jc >> 4) * (j.G * 16) + j.which * 16 + (jc & 15);
            u32x4 w;
            w.x = pack2(tl[(ch * 8 + 0) * 65 + col], tl[(ch * 8 + 1) * 65 + col]);
            w.y = pack2(tl[(ch * 8 + 2) * 65 + col], tl[(ch * 8 + 3) * 65 + col]);
            w.z = pack2(tl[(ch * 8 + 4) * 65 + col], tl[(ch * 8 + 5) * 65 + col]);
            w.w = pack2(tl[(ch * 8 + 6) * 65 + col], tl[(ch * 8 + 7) * 65 + col]);
            *(u32x4*)(j.dst + (size_t)drow * j.K + k0 + ch * 8) = w;
        }
    }
}
DI CvtJob get_job(const Params& p, int id) {
    char* ws = p.ws; char* ob = (char*)p.out;
    bf16_t* W1GU = (bf16_t*)(ob + T_W1GU); bf16_t* W1D = (bf16_t*)(ob + T_W1D); bf16_t* WA = (bf16_t*)(ob + T_WA);
    bf16_t* WB = (bf16_t*)(ws + OFF_WB); bf16_t* WO = (bf16_t*)(ws + OFF_WO); bf16_t* WADA = (bf16_t*)(ws + OFF_C + C_WADA);
    bf16_t* W2GU = (bf16_t*)(ws + OFF_C + C_W2GU); bf16_t* W2D = (bf16_t*)(ws + OFF_C + C_W2D);
    switch (id) {
        case 0: return CvtJob{p.w1g, DFF, 1024, 0, DFF, W1GU, 2, 0, 0};
        case 1: return CvtJob{p.w1u, DFF, 1024, 0, DFF, W1GU, 2, 1, 0};
        case 2: return CvtJob{p.w1d, 1024, DFF, 0, 1024, W1D, 1, 0, 0};
        case 3: return CvtJob{p.w_in, 7696, 1024, 0, 3072, WA, 1, 0, 0};
        case 4: return CvtJob{p.w_in, 7696, 1024, 3072, 1024, WB, 3, 0, 0};
        case 5: return CvtJob{p.w_in, 7696, 1024, 4096, 16, WA, 1, 0, 4608};
        case 6: return CvtJob{p.w_in, 7696, 1024, 4112, 1024, WA, 1, 0, 3072};
        case 7: return CvtJob{p.w_in, 7696, 1024, 5136, 256, WA, 1, 0, 4096};
        case 8: return CvtJob{p.w_in, 7696, 1024, 5392, 256, WA, 1, 0, 4352};
        case 9: return CvtJob{p.w_in, 7696, 1024, 5648, 1024, WB, 3, 1, 0};
        case 10: return CvtJob{p.w_in, 7696, 1024, 6672, 1024, WB, 3, 2, 0};
        case 11: return CvtJob{p.w_out, 1024, 1024, 0, 1024, WO, 1, 0, 0};
        case 12: return CvtJob{p.w_ada, 9216, 1024, 0, 9216, WADA, 1, 0, 0};
        case 13: return CvtJob{p.w2g, DFF, 1024, 0, DFF, W2GU, 2, 0, 0};
        case 14: return CvtJob{p.w2u, DFF, 1024, 0, DFF, W2GU, 2, 1, 0};
        default: return CvtJob{p.w2d, 1024, DFF, 0, 1024, W2D, 1, 0, 0};
    }
}
template <int JLO, int JHI>
DI void cvt_jobs(const Params& p, char* lds) {
    int base = 0;
#pragma unroll
    for (int id = JLO; id < JHI; ++id) {
        const CvtJob j = get_job(p, id);
        const int nt = job_tiles(j);
        int first = ((int)blockIdx.x - base) % (int)gridDim.x; if (first < 0) first += gridDim.x;
        for (int t = first; t < nt; t += gridDim.x) cvt_tile(j, t, lds);
        base += nt;
    }
    __syncthreads();
}

DI void phase_prologue(const Params& p, char* lds) {
    cvt_jobs<0, 13>(p, lds);
    const int gtid = blockIdx.x * 256 + threadIdx.x, gsz = gridDim.x * 256;
    bf16_t* SC = (bf16_t*)(p.ws + OFF_SC);
    for (int i = gtid; i < 256 * 1024; i += gsz) {
        const int row = i >> 10, col = i & 1023;
        float v = 0.f;
        if (row < 4) v = siluf(p.c_p[row * 1024 + col]); else if (row < 132) v = siluf(p.c_s[(row - 4) * 1024 + col]);
        SC[i] = (bf16_t)f2bf(v);
    }
    float* rope = (float*)(p.ws + OFF_ROPE);
    for (int i = gtid; i < 4100 * 8; i += gsz) {
        const int pi = i >> 3, k = i & 7;
        const float pos = (float)(pi < 4096 ? pi : 8192 + (pi - 4096));
        const float invf = (float)exp(-(double)k * 0.125 * log(500000.0));
        const float ang = pos * invf;
        rope[pi * 16 + k] = (float)cos((double)ang);
        rope[pi * 16 + 8 + k] = (float)sin((double)ang);
    }
}

DI void norm_phase(const Params& p, bool x_from_input, const bf16_t* f, int gate_i, float gcoef, const float* post,
                   bool write_x, const float* pre, int sh_i, int sc_i) {
    const int lane = threadIdx.x & 63, wid = threadIdx.x >> 6;
    const float* MOD = (const float*)(p.ws + OFF_MOD);
    bf16_t* H = (bf16_t*)(p.ws + OFF_H);
    for (int row = blockIdx.x * 4 + wid; row < MALL; row += gridDim.x * 4) {
        const int cidx = row < MP ? (row >> 12) : 4 + ((row - MP) >> 2);
        const float* mrow = MOD + (size_t)cidx * 9216;
        const float* xr = x_from_input ? (row < MP ? p.x_p + (size_t)row * 1024 : p.x_s + (size_t)(row - MP) * 1024) : p.out + (size_t)row * 1024;
        f32x4 x[4];
#pragma unroll
        for (int i = 0; i < 4; ++i) x[i] = *(const f32x4*)(xr + lane * 4 + 256 * i);
        if (f) {
            f32x4 fv[4]; float ss = 0.f;
#pragma unroll
            for (int i = 0; i < 4; ++i) { const u32x2 fw = *(const u32x2*)(f + (size_t)row * 1024 + lane * 4 + 256 * i);
                fv[i] = (f32x4){bflo(fw.x), bfhi(fw.x), bflo(fw.y), bfhi(fw.y)}; ss += fv[i][0] * fv[i][0] + fv[i][1] * fv[i][1] + fv[i][2] * fv[i][2] + fv[i][3] * fv[i][3]; }
#pragma unroll
            for (int o = 32; o > 0; o >>= 1) ss += __shfl_xor(ss, o);
            const float rstd = rsqrtf(ss * (1.f / 1024.f) + EPSF);
#pragma unroll
            for (int i = 0; i < 4; ++i) {
                const int col = lane * 4 + 256 * i;
                const f32x4 g = *(const f32x4*)(mrow + gate_i * 1024 + col), pg = *(const f32x4*)(post + col);
#pragma unroll
                for (int j = 0; j < 4; ++j) x[i][j] += gcoef * g[j] * (fv[i][j] * rstd * pg[j]);
            }
        }
        if (write_x) {
#pragma unroll
            for (int i = 0; i < 4; ++i) *(f32x4*)(p.out + (size_t)row * 1024 + lane * 4 + 256 * i) = x[i];
        }
        if (pre) {
            float ss = 0.f;
#pragma unroll
            for (int i = 0; i < 4; ++i) ss += x[i][0] * x[i][0] + x[i][1] * x[i][1] + x[i][2] * x[i][2] + x[i][3] * x[i][3];
#pragma unroll
            for (int o = 32; o > 0; o >>= 1) ss += __shfl_xor(ss, o);
            const float rstd = rsqrtf(ss * (1.f / 1024.f) + EPSF);
#pragma unroll
            for (int i = 0; i < 4; ++i) {
                const int col = lane * 4 + 256 * i;
                const f32x4 pg = *(const f32x4*)(pre + col), sh = *(const f32x4*)(mrow + sh_i * 1024 + col), sc = *(const f32x4*)(mrow + sc_i * 1024 + col);
                float h[4];
#pragma unroll
                for (int j = 0; j < 4; ++j) h[j] = x[i][j] * rstd * pg[j] * (1.f + sc[j]) + sh[j];
                u32x2 w; w.x = pack2(h[0], h[1]); w.y = pack2(h[2], h[3]);
                *(u32x2*)(H + (size_t)row * 1024 + col) = w;
            }
        }
    }
}

DI void phase_mixprep(const Params& p, char* lds) {
    char* C = p.ws + OFF_C;
    const bf16_t* PKV = (const bf16_t*)(C + C_PKV);
    bf16_t* KCS = (bf16_t*)(C + C_KCS); bf16_t* VTP = (bf16_t*)(C + C_VTP); bf16_t* VTS = (bf16_t*)(C + C_VTS);
    float* SSQ = (float*)(C + C_SSQ);
    const int tid = threadIdx.x, gtid = blockIdx.x * 256 + tid, gsz = gridDim.x * 256;
    bf16_t* tl = (bf16_t*)lds;
    for (int t = blockIdx.x; t < 1024; t += gridDim.x) {
        const int b = t >> 8, cb = (t >> 6) & 3, tb = t & 63;
        __syncthreads();
#pragma unroll
        for (int i = 0; i < 2; ++i) {
            const int tr = (tid >> 3) + 32 * i, c8 = (tid & 7) * 8;
            const u32x4 v = *(const u32x4*)(PKV + (size_t)(b * 4096 + tb * 64 + tr) * 512 + 256 + cb * 64 + c8);
            bf16_t* d = tl + tr * 66 + c8;
            d[0] = (bf16_t)(v.x & 0xffffu); d[1] = (bf16_t)(v.x >> 16); d[2] = (bf16_t)(v.y & 0xffffu); d[3] = (bf16_t)(v.y >> 16);
            d[4] = (bf16_t)(v.z & 0xffffu); d[5] = (bf16_t)(v.z >> 16); d[6] = (bf16_t)(v.w & 0xffffu); d[7] = (bf16_t)(v.w >> 16);
        }
        __syncthreads();
#pragma unroll
        for (int i = 0; i < 2; ++i) {
            const int col = (tid >> 3) + 32 * i, ch = tid & 7;
            u32x4 w;
            w.x = tl[(ch * 8 + 0) * 66 + col] | ((unsigned)tl[(ch * 8 + 1) * 66 + col] << 16);
            w.y = tl[(ch * 8 + 2) * 66 + col] | ((unsigned)tl[(ch * 8 + 3) * 66 + col] << 16);
            w.z = tl[(ch * 8 + 4) * 66 + col] | ((unsigned)tl[(ch * 8 + 5) * 66 + col] << 16);
            w.w = tl[(ch * 8 + 6) * 66 + col] | ((unsigned)tl[(ch * 8 + 7) * 66 + col] << 16);
            *(u32x4*)(VTP + (size_t)(b * 256 + cb * 64 + col) * 4096 + tb * 64 + ch * 8) = w;
        }
    }
    for (int t = blockIdx.x; t < 512; t += gridDim.x) {
        const int seq = t >> 2, cb = t & 3;
        __syncthreads();
        for (int i = tid; i < 160 * 16; i += 256) {
            const int s = i >> 4, col = (i & 15) * 4;
            unsigned w0 = 0, w1 = 0;
            if (s < 128) { const f32x4 v = *(const f32x4*)(p.cache_v + (size_t)(seq * 128 + s) * 256 + cb * 64 + col); w0 = pack2(v[0], v[1]); w1 = pack2(v[2], v[3]); }
            else if (s < 132) { const u32x2 v = *(const u32x2*)(PKV + (size_t)(MP + seq * 4 + s - 128) * 512 + 256 + cb * 64 + col); w0 = v.x; w1 = v.y; }
            bf16_t* d = tl + s * 66 + col;
            d[0] = (bf16_t)(w0 & 0xffffu); d[1] = (bf16_t)(w0 >> 16); d[2] = (bf16_t)(w1 & 0xffffu); d[3] = (bf16_t)(w1 >> 16);
        }
        __syncthreads();
        for (int i = tid; i < 64 * 20; i += 256) {
            const int col = i / 20, ch = i % 20;
            u32x4 w;
            w.x = tl[(ch * 8 + 0) * 66 + col] | ((unsigned)tl[(ch * 8 + 1) * 66 + col] << 16);
            w.y = tl[(ch * 8 + 2) * 66 + col] | ((unsigned)tl[(ch * 8 + 3) * 66 + col] << 16);
            w.z = tl[(ch * 8 + 4) * 66 + col] | ((unsigned)tl[(ch * 8 + 5) * 66 + col] << 16);
            w.w = tl[(ch * 8 + 6) * 66 + col] | ((unsigned)tl[(ch * 8 + 7) * 66 + col] << 16);
            *(u32x4*)(VTS + (size_t)(seq * 256 + cb * 64 + col) * 160 + ch * 8) = w;
        }
    }
    __syncthreads();
    for (int i = gtid; i < 128 * 144 * 32; i += gsz) {
        const int ch = i & 31, slot = (i >> 5) % 144, seq = (i >> 5) / 144;
        u32x4 w = (u32x4){0u, 0u, 0u, 0u};
        if (slot < 128) {
            const float* s = p.cache_k + (size_t)(seq * 128 + slot) * 256 + ch * 8;
            const f32x4 a = *(const f32x4*)s, b = *(const f32x4*)(s + 4);
            w.x = pack2(a[0], a[1]); w.y = pack2(a[2], a[3]); w.z = pack2(b[0], b[1]); w.w = pack2(b[2], b[3]);
        } else if (slot < 132) w = *(const u32x4*)(PKV + (size_t)(MP + seq * 4 + slot - 128) * 512 + ch * 8);
        *(u32x4*)(KCS + (size_t)i * 8) = w;
    }
}

DI void prep_item(const Params& p, int item, char* lds) {
    char* C = p.ws + OFF_C;
    bf16_t* PU = (bf16_t*)(C + C_PU);
    const float* PBA = (const float*)(C + C_PBA);
    bf16_t* KDT = (bf16_t*)(C + C_KDT); bf16_t* ACH = (bf16_t*)(C + C_ACH); float* GAM = (float*)(C + C_GAM);
    const bf16_t* HALO = (const bf16_t*)(C + C_HALO);
    bf16_t* UP = (bf16_t*)((char*)p.out + T_UP);
    int tid = threadIdx.x; asm volatile("" : "+v"(tid));
    const int lane = tid & 63, wid = tid >> 6, fr = lane & 15, fq = lane >> 4;
    const int b = item >> 9, n = (item >> 3) & 63, h = item & 7;
    const int r0 = b * 4096 + n * 64;
    char* Qt = lds; char* Kt = lds + 16384;
    float* Ls = (float*)(lds + 32768);
    float* gc = (float*)(lds + 50176); float* be = gc + 64; float* eg = be + 64;
    const bf16_t* halo = HALO + (size_t)(b * 64 + n) * 3 * 3072;
    __syncthreads();
    {
        const int slot = tid >> 4, l16 = tid & 15, which = slot & 1, rsub = slot >> 1;
        const int cbase = which * 1024 + h * 128 + l16 * 8;
        float w[4][8];
#pragma unroll
        for (int t = 0; t < 4; ++t) {
            const f32x4 a = *(const f32x4*)(p.conv_w + t * 3072 + cbase), bb = *(const f32x4*)(p.conv_w + t * 3072 + cbase + 4);
#pragma unroll
            for (int e = 0; e < 4; ++e) { w[t][e] = a[e]; w[t][4 + e] = bb[e]; }
        }
        const float qs = which == 0 ? 0.08838834764831845f : 1.f;
        for (int ps = 0; ps < 8; ++ps) {
            const int i = ps * 8 + rsub;
            float y[8];
#pragma unroll
            for (int e = 0; e < 8; ++e) y[e] = 0.f;
#pragma unroll
            for (int t = 0; t < 4; ++t) {
                const int tr = i - 3 + t;
                const bf16_t* src = tr < 0 ? halo + (3 + tr) * 3072 + cbase : PU + (size_t)(r0 + tr) * 3072 + cbase;
                u32x4 v = *(const u32x4*)src;
                if (tr < 0 && n == 0) v = (u32x4){0u, 0u, 0u, 0u};
                y[0] += w[t][0] * bflo(v.x); y[1] += w[t][1] * bfhi(v.x); y[2] += w[t][2] * bflo(v.y); y[3] += w[t][3] * bfhi(v.y);
                y[4] += w[t][4] * bflo(v.z); y[5] += w[t][5] * bfhi(v.z); y[6] += w[t][6] * bflo(v.w); y[7] += w[t][7] * bfhi(v.w);
            }
            float ss = 0.f;
#pragma unroll
            for (int e = 0; e < 8; ++e) { y[e] = siluf(y[e]); ss += y[e] * y[e]; }
            ss += __shfl_xor(ss, 1); ss += __shfl_xor(ss, 2); ss += __shfl_xor(ss, 4); ss += __shfl_xor(ss, 8);
            const float sc = rsqrtf(ss + EPSF) * qs;
            u32x4 o; o.x = pack2(y[0] * sc, y[1] * sc); o.y = pack2(y[2] * sc, y[3] * sc); o.z = pack2(y[4] * sc, y[5] * sc); o.w = pack2(y[6] * sc, y[7] * sc);
            *(u32x4*)((which ? Kt : Qt) + i * 256 + ((l16 ^ (i & 15)) << 4)) = o;
        }
    }
    if (wid == 0) {
        const float braw = PBA[(size_t)(r0 + lane) * 16 + h], araw = PBA[(size_t)(r0 + lane) * 16 + 8 + h];
        float g = -__expf(p.a_log[h]) * softplusf(araw + p.dt_bias[h]);
#pragma unroll
        for (int o = 1; o < 64; o <<= 1) { const float t = __shfl_up(g, o); if (lane >= o) g += t; }
        gc[lane] = g; be[lane] = sigm(braw); eg[lane] = __expf(g);
    }
    __syncthreads();
    {
        f32x4 ak[4], aq[4];
#pragma unroll
        for (int nj = 0; nj < 4; ++nj) { ak[nj] = (f32x4){0.f, 0.f, 0.f, 0.f}; aq[nj] = ak[nj]; }
#pragma unroll
        for (int ks = 0; ks < 4; ++ks) {
            const int ri = wid * 16 + fr, ch = ks * 4 + fq;
            const bf16x8 fk = *(const bf16x8*)(Kt + ri * 256 + ((ch ^ (ri & 15)) << 4));
            const bf16x8 fqq = *(const bf16x8*)(Qt + ri * 256 + ((ch ^ (ri & 15)) << 4));
#pragma unroll
            for (int nj = 0; nj < 4; ++nj) {
                const int rj = nj * 16 + fr;
                const bf16x8 fb = *(const bf16x8*)(Kt + rj * 256 + ((ch ^ (rj & 15)) << 4));
                ak[nj] = MFMA16(fk, fb, ak[nj]);
                aq[nj] = MFMA16(fqq, fb, aq[nj]);
            }
        }
#pragma unroll
        for (int nj = 0; nj < 4; ++nj)
#pragma unroll
            for (int jj = 0; jj < 4; ++jj) {
                const int i = wid * 16 + 4 * fq + jj, j = nj * 16 + fr;
                const float dec = __expf(fminf(gc[i] - gc[j], 0.f));
                Ls[i * 68 + j] = i > j ? be[i] * ak[nj][jj] * dec : 0.f;
                ACH[(size_t)item * 4096 + i * 64 + j] = (bf16_t)f2bf(i >= j ? aq[nj][jj] * dec : 0.f);
            }
    }
    __syncthreads();
    asm volatile("" : "+v"(tid));
    float x[64];
    if (tid < 128) {
        const int cv = 2048 + h * 128 + tid;
        const float w0 = p.conv_w[cv], w1 = p.conv_w[3072 + cv], w2 = p.conv_w[2 * 3072 + cv], w3 = p.conv_w[3 * 3072 + cv];
        float xm3 = bf2f(halo[cv]), xm2 = bf2f(halo[3072 + cv]), xm1 = bf2f(halo[2 * 3072 + cv]);
        if (n == 0) { xm3 = 0.f; xm2 = 0.f; xm1 = 0.f; }
#pragma unroll
        for (int i = 0; i < 64; ++i) {
            const float xi = bf2f(PU[(size_t)(r0 + i) * 3072 + cv]);
            x[i] = siluf(w0 * xm3 + w1 * xm2 + w2 * xm1 + w3 * xi) * be[i];
            xm3 = xm2; xm2 = xm1; xm1 = xi;
            if ((i & 15) == 15) __builtin_amdgcn_sched_barrier(0);
        }
    } else {
        const int ck = tid - 128;
#pragma unroll
        for (int i = 0; i < 64; ++i) {
            const bf16_t kv = *(const bf16_t*)(Kt + i * 256 + (((ck >> 3) ^ (i & 15)) << 4) + (ck & 7) * 2);
            x[i] = bf2f(kv) * be[i] * eg[i];
            if ((i & 15) == 15) __builtin_amdgcn_sched_barrier(0);
        }
    }
#pragma unroll
    for (int i = 1; i < 64; ++i) {
        float a = x[i];
#pragma unroll
        for (int j4 = 0; j4 < (i + 3) / 4; ++j4) {
            const f32x4 l = *(const f32x4*)(Ls + i * 68 + j4 * 4);
            a -= l[0] * x[j4 * 4];
            if (j4 * 4 + 1 < i) a -= l[1] * x[j4 * 4 + 1];
            if (j4 * 4 + 2 < i) a -= l[2] * x[j4 * 4 + 2];
            if (j4 * 4 + 3 < i) a -= l[3] * x[j4 * 4 + 3];
        }
        x[i] = a;
        if ((i & 3) == 3) __builtin_amdgcn_sched_barrier(0);
    }
    __syncthreads();
    asm volatile("" : "+v"(tid));
    if (tid < 128) {
        const int sl = tid >> 4, f16 = tid & 15;
#pragma unroll
        for (int q4 = 0; q4 < 4; ++q4) {
            bf16_t* dst = UP + (((size_t)item * 8 + sl) * 64 + q4 * 16 + f16) * 16;
            u32x4 a, bq;
            a.x = pack2(x[0 + 4 * q4 + 0], x[0 + 4 * q4 + 1]); a.y = pack2(x[0 + 4 * q4 + 2], x[0 + 4 * q4 + 3]);
            a.z = pack2(x[16 + 4 * q4 + 0], x[16 + 4 * q4 + 1]); a.w = pack2(x[16 + 4 * q4 + 2], x[16 + 4 * q4 + 3]);
            bq.x = pack2(x[32 + 4 * q4 + 0], x[32 + 4 * q4 + 1]); bq.y = pack2(x[32 + 4 * q4 + 2], x[32 + 4 * q4 + 3]);
            bq.z = pack2(x[48 + 4 * q4 + 0], x[48 + 4 * q4 + 1]); bq.w = pack2(x[48 + 4 * q4 + 2], x[48 + 4 * q4 + 3]);
            *(u32x4*)dst = a; *(u32x4*)(dst + 8) = bq;
        }
    } else {
        const unsigned off = (unsigned)r0 * 3072u + 1024u + h * 128u + (tid - 128);
#pragma unroll
        for (int i = 0; i < 64; ++i) PU[off + (unsigned)i * 3072u] = (bf16_t)f2bf(x[i]);
    }
    {
        const int i = tid >> 2, part = tid & 3;
        const float e = eg[i];
#pragma unroll
        for (int c4 = 0; c4 < 4; ++c4) {
            const int ch = part * 4 + c4;
            const u32x4 v = *(const u32x4*)(Qt + i * 256 + ((ch ^ (i & 15)) << 4));
            u32x4 o;
            o.x = pack2(bflo(v.x) * e, bfhi(v.x) * e); o.y = pack2(bflo(v.y) * e, bfhi(v.y) * e);
            o.z = pack2(bflo(v.z) * e, bfhi(v.z) * e); o.w = pack2(bflo(v.w) * e, bfhi(v.w) * e);
            *(u32x4*)(PU + (size_t)(r0 + i) * 3072 + h * 128 + ch * 8) = o;
        }
    }
    {
        const int dk = tid & 127, ih = tid >> 7;
        const float gl = gc[63];
#pragma unroll
        for (int c4 = 0; c4 < 4; ++c4) {
            float v[8];
#pragma unroll
            for (int e = 0; e < 8; ++e) {
                const int i = ih * 32 + c4 * 8 + e;
                const bf16_t kv = *(const bf16_t*)(Kt + i * 256 + (((dk >> 3) ^ (i & 15)) << 4) + (dk & 7) * 2);
                v[e] = bf2f(kv) * __expf(gl - gc[i]);
            }
            u32x4 o; o.x = pack2(v[0], v[1]); o.y = pack2(v[2], v[3]); o.z = pack2(v[4], v[5]); o.w = pack2(v[6], v[7]);
            *(u32x4*)(KDT + ((size_t)item * 128 + dk) * 64 + ih * 32 + c4 * 8) = o;
        }
        if (tid == 0) GAM[item] = __expf(gl);
    }
}

DI bf16x8 frag_perm(const char* base, int rowbytes, int row, int c0, int fq) {
    const char* q = base + row * rowbytes + (c0 + 4 * fq) * 2;
    const s16x4 lo = *(const s16x4*)q, hi = *(const s16x4*)(q + 32);
    return cat4(lo, hi);
}
#define LDS_BARRIER() do { asm volatile("s_waitcnt lgkmcnt(0)" ::: "memory"); __builtin_amdgcn_s_barrier(); asm volatile("" ::: "memory"); } while (0)
DI void scan_block(const Params& p, int blk, char* lds) {
    char* C = p.ws + OFF_C;
    bf16_t* PU = (bf16_t*)(C + C_PU);
    const bf16_t* KDT = (const bf16_t*)(C + C_KDT); const bf16_t* ACH = (const bf16_t*)(C + C_ACH); const float* GAM = (const float*)(C + C_GAM);
    float* SSQ = (float*)(C + C_SSQ);
    const bf16_t* UP = (const bf16_t*)((const char*)p.out + T_UP);
    const int tid = threadIdx.x, lane = tid & 63, wid = tid >> 6, fr = lane & 15, fq = lane >> 4;
    const int bh = blk & 31, half = blk >> 5, b = bh >> 3, h = bh & 7;
    const int dvb = half * 64 + wid * 16;
    char* Wt = lds; char* Qt = lds + 17408; char* At = lds + 34816; char* Kd = lds + 43520;
    f32x4 S[8];
#pragma unroll
    for (int t = 0; t < 8; ++t) S[t] = (f32x4){0.f, 0.f, 0.f, 0.f};
    u32x4 rW[4], rQ[4], rA[2], rK[4];
    u32x4 rU[2];
    float gam;
#define SCAN_LOAD(nn) do { \
        int tid = threadIdx.x; asm volatile("" : "+v"(tid)); const int lane = tid & 63, wid = tid >> 6; \
        const int r0n_ = b * 4096 + (nn) * 64; const size_t it_ = (size_t)((b * 64 + (nn)) * 8 + h); \
        _Pragma("unroll") for (int i = 0; i < 4; ++i) { const int id = tid + 256 * i, row = id >> 4, ch = id & 15; \
            rW[i] = *(const u32x4*)(PU + (size_t)(r0n_ + row) * 3072 + 1024 + h * 128 + ch * 8); \
            rQ[i] = *(const u32x4*)(PU + (size_t)(r0n_ + row) * 3072 + h * 128 + ch * 8); } \
        _Pragma("unroll") for (int i = 0; i < 2; ++i) { const int id = tid + 256 * i; rA[i] = *(const u32x4*)(ACH + it_ * 4096 + (size_t)id * 8); } \
        _Pragma("unroll") for (int i = 0; i < 4; ++i) { const int id = tid + 256 * i; rK[i] = *(const u32x4*)(KDT + it_ * 8192 + (size_t)id * 8); } \
        { const bf16_t* up_ = UP + ((it_ * 8 + half * 4 + wid) * 64 + lane) * 16; rU[0] = *(const u32x4*)up_; rU[1] = *(const u32x4*)(up_ + 8); } \
        gam = GAM[it_]; } while (0)
    SCAN_LOAD(0);
    __syncthreads();
    for (int n = 0; n < 64; ++n) {
        const int r0 = b * 4096 + n * 64;
        int tid = threadIdx.x; asm volatile("" : "+v"(tid));
#pragma unroll
        for (int i = 0; i < 4; ++i) { const int id = tid + 256 * i, row = id >> 4, ch = id & 15;
            *(u32x4*)(Wt + row * 272 + ch * 16) = rW[i]; *(u32x4*)(Qt + row * 272 + ch * 16) = rQ[i]; }
#pragma unroll
        for (int i = 0; i < 2; ++i) { const int id = tid + 256 * i, row = id >> 3, ch = id & 7; char* q = At + row * 136 + ch * 16;
            *(u32x2*)q = (u32x2){rA[i].x, rA[i].y}; *(u32x2*)(q + 8) = (u32x2){rA[i].z, rA[i].w}; }
#pragma unroll
        for (int i = 0; i < 4; ++i) { const int id = tid + 256 * i, row = id >> 3, ch = id & 7; char* q = Kd + row * 136 + ch * 16;
            *(u32x2*)q = (u32x2){rK[i].x, rK[i].y}; *(u32x2*)(q + 8) = (u32x2){rK[i].z, rK[i].w}; }
        float uc[16];
#pragma unroll
        for (int i = 0; i < 8; ++i) { const unsigned w = i < 4 ? rU[0][i] : rU[1][i - 4]; uc[2 * i] = bflo(w); uc[2 * i + 1] = bfhi(w); }
        const float gcur = gam;
        LDS_BARRIER();
        if (n + 1 < 64) SCAN_LOAD(n + 1);
        bf16x8 Sb[4];
#pragma unroll
        for (int ks = 0; ks < 4; ++ks) Sb[ks] = pack8(S[2 * ks], S[2 * ks + 1]);
        f32x4 aw[4], ao[4];
#pragma unroll
        for (int m = 0; m < 4; ++m) { aw[m] = (f32x4){0.f, 0.f, 0.f, 0.f}; ao[m] = aw[m]; }
#pragma unroll
        for (int ks = 0; ks < 4; ++ks)
#pragma unroll
            for (int m = 0; m < 4; ++m) aw[m] = MFMA16(frag_perm(Wt, 272, 16 * m + fr, 32 * ks, fq), Sb[ks], aw[m]);
#pragma unroll
        for (int ks = 0; ks < 4; ++ks)
#pragma unroll
            for (int m = 0; m < 4; ++m) ao[m] = MFMA16(frag_perm(Qt, 272, 16 * m + fr, 32 * ks, fq), Sb[ks], ao[m]);
        f32x4 vn[4];
#pragma unroll
        for (int m = 0; m < 4; ++m)
#pragma unroll
            for (int jj = 0; jj < 4; ++jj) vn[m][jj] = uc[m * 4 + jj] - aw[m][jj];
        bf16x8 Vb[2];
        Vb[0] = pack8(vn[0], vn[1]); Vb[1] = pack8(vn[2], vn[3]);
#pragma unroll
        for (int t = 0; t < 8; ++t) S[t] = S[t] * gcur;
#pragma unroll
        for (int k2 = 0; k2 < 2; ++k2) {
#pragma unroll
            for (int m = 2 * k2; m < 4; ++m) ao[m] = MFMA16(frag_perm(At, 136, 16 * m + fr, 32 * k2, fq), Vb[k2], ao[m]);
#pragma unroll
            for (int t = 0; t < 8; ++t) S[t] = MFMA16(frag_perm(Kd, 136, 16 * t + fr, 32 * k2, fq), Vb[k2], S[t]);
        }
#pragma unroll
        for (int m = 0; m < 4; ++m)
#pragma unroll
            for (int j2 = 0; j2 < 2; ++j2) {
                const unsigned w = pack2(ao[m][2 * j2], ao[m][2 * j2 + 1]);
                const unsigned ob = (unsigned)(r0 + 4 * fq) * 3072u + 2048u + h * 128u + dvb + fr + (unsigned)(16 * m + 2 * j2) * 3072u;
                PU[ob] = (bf16_t)(w & 0xffffu); PU[ob + 3072u] = (bf16_t)(w >> 16);
            }
        LDS_BARRIER();
    }
#undef SCAN_LOAD
#pragma unroll
    for (int t = 0; t < 8; ++t)
#pragma unroll
        for (int jj = 0; jj < 4; ++jj)
            p.out[O_DELTAP + ((size_t)(b * 8 + h) * 128 + 16 * t + 4 * fq + jj) * 128 + dvb + fr] = S[t][jj];
}

DI void sdelta_item(const Params& p, int item, char* lds) {
    char* C = p.ws + OFF_C;
    bf16_t* PU = (bf16_t*)(C + C_PU);
    const float* PBA = (const float*)(C + C_PBA);
    float* SSQ = (float*)(C + C_SSQ);
    const int tid = threadIdx.x, lane = tid & 63, wid = tid >> 6;
    const int seq = item >> 3, h = item & 7, rs = MP + seq * 4;
    float* qs = (float*)lds;
    float* ks = qs + 512; float* vs = ks + 512;
    float* red = vs + 512;
    float* bt = red + 16; float* al = bt + 4;
    float* kSp = al + 4;
    float* op = kSp + 1024;
    const int ch = tid & 127, part = tid >> 7;
    __syncthreads();
    float yq[4];
    {
        const int nch = part == 0 ? 2 : 1;
        for (int cc = 0; cc < nch; ++cc) {
            const int c = part == 1 ? 1024 + h * 128 + ch : (cc == 0 ? h * 128 + ch : 2048 + h * 128 + ch);
            float full[7];
#pragma unroll
            for (int i = 0; i < 3; ++i) full[i] = p.st_conv[(size_t)(seq * 3 + i) * 3072 + c];
#pragma unroll
            for (int i = 0; i < 4; ++i) full[3 + i] = bf2f(PU[(size_t)(rs + i) * 3072 + c]);
#pragma unroll
            for (int i = 0; i < 3; ++i) p.out[O_CONVS + (size_t)(seq * 3 + i) * 3072 + c] = full[4 + i];
            const float w0 = p.conv_w[c], w1 = p.conv_w[3072 + c], w2 = p.conv_w[2 * 3072 + c], w3 = p.conv_w[3 * 3072 + c];
            float y[4];
#pragma unroll
            for (int t = 0; t < 4; ++t) y[t] = siluf(w0 * full[t] + w1 * full[t + 1] + w2 * full[t + 2] + w3 * full[t + 3]);
            if (part == 0 && cc == 1) {
#pragma unroll
                for (int t = 0; t < 4; ++t) vs[t * 128 + ch] = y[t];
            } else {
#pragma unroll
                for (int t = 0; t < 4; ++t) yq[t] = y[t];
            }
        }
    }
#pragma unroll
    for (int t = 0; t < 4; ++t) {
        float s = yq[t] * yq[t];
#pragma unroll
        for (int o = 32; o > 0; o >>= 1) s += __shfl_xor(s, o);
        if (lane == 0) red[wid * 4 + t] = s;
    }
    if (tid < 4) {
        const float braw = PBA[(size_t)(rs + tid) * 16 + h], araw = PBA[(size_t)(rs + tid) * 16 + 8 + h];
        bt[tid] = sigm(braw);
        al[tid] = __expf(-__expf(p.a_log[h]) * softplusf(araw + p.dt_bias[h]));
    }
    __syncthreads();
#pragma unroll
    for (int t = 0; t < 4; ++t) {
        const float tot = red[(2 * part) * 4 + t] + red[(2 * part + 1) * 4 + t];
        const float sc = rsqrtf(tot + EPSF) * (part == 0 ? 0.08838834764831845f : 1.f);
        (part == 0 ? qs : ks)[t * 128 + ch] = yq[t] * sc;
    }
    __syncthreads();
    const int dv = ch, dk0 = part * 64;
    float S[64];
    const float* s0 = p.st_delta + ((size_t)(seq * 8 + h) * 128 + dk0) * 128 + dv;
#pragma unroll
    for (int i = 0; i < 64; ++i) S[i] = s0[(size_t)i * 128];
#pragma unroll
    for (int t = 0; t < 4; ++t) {
        float pk = 0.f;
#pragma unroll
        for (int i = 0; i < 64; ++i) pk += ks[t * 128 + dk0 + i] * S[i];
        kSp[(t * 2 + part) * 128 + dv] = pk;
        __syncthreads();
        const float kS = kSp[(t * 2) * 128 + dv] + kSp[(t * 2 + 1) * 128 + dv];
        const float a = al[t];
        const float vnew = bt[t] * (vs[t * 128 + dv] - a * kS);
        float po = 0.f;
#pragma unroll
        for (int i = 0; i < 64; ++i) { S[i] = a * S[i] + ks[t * 128 + dk0 + i] * vnew; po += qs[t * 128 + dk0 + i] * S[i]; }
        op[(t * 2 + part) * 128 + dv] = po;
        __syncthreads();
        if (part == 0) {
            const float o = op[(t * 2) * 128 + dv] + op[(t * 2 + 1) * 128 + dv];
            PU[(size_t)(rs + t) * 3072 + 2048 + h * 128 + dv] = (bf16_t)f2bf(o);
        }
    }
    float* so = p.out + O_DELTAS + ((size_t)(seq * 8 + h) * 128 + dk0) * 128 + dv;
#pragma unroll
    for (int i = 0; i < 64; ++i) so[(size_t)i * 128] = S[i];
}

DI void attn_block(const Params& p, int bt) {
    char* C = p.ws + OFF_C;
    bf16_t* PQ = (bf16_t*)(C + C_PQ);
    const bf16_t* PKV = (const bf16_t*)(C + C_PKV); const bf16_t* KCS = (const bf16_t*)(C + C_KCS);
    const bf16_t* VTP = (const bf16_t*)(C + C_VTP); const bf16_t* VTS = (const bf16_t*)(C + C_VTS);
    const int lane = threadIdx.x & 63, wid = threadIdx.x >> 6, fr = lane & 15, fq = lane >> 4;
    const bool isS = bt >= 4096;
    int b = 0, kvh, t0 = 0, seq = 0, head, qrow;
    if (!isS) { b = bt >> 10; kvh = (bt >> 8) & 3; t0 = (bt & 255) * 16; head = kvh * 4 + wid; qrow = b * 4096 + t0 + fr; }
    else { seq = bt - 4096; kvh = wid; head = kvh * 4 + (fr >> 2); qrow = MP + seq * 4 + (fr & 3); }
    bf16_t* qp = PQ + (size_t)qrow * 1024 + head * 64;
    const float sink = p.sinks[head];
    bf16x8 bq[2];
    bq[0] = *(const bf16x8*)(qp + fq * 8); bq[1] = *(const bf16x8*)(qp + 32 + fq * 8);
    f32x4 sc[10];
#pragma unroll
    for (int n = 0; n < 10; ++n) {
        const bf16_t* kp;
        if (!isS) { int t = t0 - 144 + 16 * n + fr; t = t < 0 ? 0 : t; kp = PKV + (size_t)(b * 4096 + t) * 512 + kvh * 64; }
        else { int s = 16 * n + fr; s = s > 143 ? 143 : s; kp = KCS + (size_t)(seq * 144 + s) * 256 + kvh * 64; }
        f32x4 a = (f32x4){0.f, 0.f, 0.f, 0.f};
        a = MFMA16(*(const bf16x8*)(kp + fq * 8), bq[0], a);
        a = MFMA16(*(const bf16x8*)(kp + 32 + fq * 8), bq[1], a);
        sc[n] = a;
    }
    float mx = sink;
#pragma unroll
    for (int n = 0; n < 10; ++n)
#pragma unroll
        for (int jj = 0; jj < 4; ++jj) {
            const int kidx = 16 * n + 4 * fq + jj;
            bool valid;
            if (!isS) { const int t = t0 - 144 + kidx, d = 144 + fr - kidx; valid = t >= 0 && d >= 0 && d <= 128; }
            else { const int d = (fr & 3) + 128 - kidx; valid = d >= 0 && d <= 128; }
            const float s = valid ? sc[n][jj] * 0.125f : -1e30f;
            sc[n][jj] = s; mx = fmaxf(mx, s);
        }
    mx = fmaxf(mx, __shfl_xor(mx, 16)); mx = fmaxf(mx, __shfl_xor(mx, 32));
    float sum = 0.f;
#pragma unroll
    for (int n = 0; n < 10; ++n)
#pragma unroll
        for (int jj = 0; jj < 4; ++jj) { const float e = __expf(sc[n][jj] - mx); sc[n][jj] = e; sum += e; }
    sum += __shfl_xor(sum, 16); sum += __shfl_xor(sum, 32);
    const float inv = 1.f / (sum + __expf(sink - mx));
    bf16x8 bP[5];
#pragma unroll
    for (int s5 = 0; s5 < 5; ++s5) bP[s5] = pack8(sc[2 * s5] * inv, sc[2 * s5 + 1] * inv);
#pragma unroll
    for (int ds = 0; ds < 4; ++ds) {
        const bf16_t* vrow = !isS ? VTP + (size_t)(b * 256 + kvh * 64 + 16 * ds + fr) * 4096 : VTS + (size_t)(seq * 256 + kvh * 64 + 16 * ds + fr) * 160;
        f32x4 a = (f32x4){0.f, 0.f, 0.f, 0.f};
#pragma unroll
        for (int s5 = 0; s5 < 5; ++s5) {
            int g0 = 32 * s5 + 4 * fq, g1 = g0 + 16;
            if (!isS) { g0 += t0 - 144; g1 += t0 - 144; g0 = g0 < 0 ? 0 : g0; g1 = g1 < 0 ? 0 : g1; }
            const s16x4 lo = *(const s16x4*)(vrow + g0), hi = *(const s16x4*)(vrow + g1);
            a = MFMA16(cat4(lo, hi), bP[s5], a);
        }
        u32x2 w; w.x = pack2(a[0], a[1]); w.y = pack2(a[2], a[3]);
        *(u32x2*)(qp + 16 * ds + 4 * fq) = w;
    }
}

DI void sample_window_out(const Params& p) {
    const bf16_t* PKV = (const bf16_t*)(p.ws + OFF_C + C_PKV);
    const int gt = blockIdx.x * 256 + threadIdx.x, gs = gridDim.x * 256;
    for (int i = gt; i < 128 * 128 * 128; i += gs) {
        const int c = (i & 127) * 4, s = (i >> 7) & 127, seq = i >> 14;
        const int cc = c & 255; const bool isv = c >= 256;
        f32x4 v;
        if (s < 124) v = *(const f32x4*)((isv ? p.cache_v : p.cache_k) + (size_t)(seq * 128 + s + 4) * 256 + cc);
        else { const u32x2 w = *(const u32x2*)(PKV + (size_t)(MP + seq * 4 + s - 124) * 512 + c); v = (f32x4){bflo(w.x), bfhi(w.x), bflo(w.y), bfhi(w.y)}; }
        *(f32x4*)(p.out + (isv ? O_SWVS : O_SWKS) + (size_t)(seq * 128 + s) * 256 + cc) = v;
    }
}

DI void phase_mixer(const Params& p, char* lds) {
    const int nb = gridDim.x, blk = blockIdx.x;
    const int nscan = 64;
#ifndef MK_P9
#define MK_P9 7
#endif
    if (blk < nscan) { if (MK_P9 & 1) scan_block(p, blk, lds); return; }
    const int halfg = nb >> 1;
    if (nb == 512 && blk >= halfg && blk < halfg + nscan) return;
    const int wb = (nb == 512) ? (blk < halfg ? blk - nscan : blk - 2 * nscan) : blk - nscan, nw = (nb == 512) ? nb - 2 * nscan : nb - nscan;
    if (MK_P9 & 2) for (int it = wb; it < 1024; it += nw) sdelta_item(p, it, lds);
    if (MK_P9 & 4) for (int bt = wb; bt < 4224; bt += nw) attn_block(p, bt);
}

#define XB_TMO      128
#define XB_XCNT(j)  (256  + 64 * (j))
#define XB_XSUB(j)  (1280 + 64 * (j))
#define XB_XGEN(j)  (2304 + 64 * (j))
#define XB_TOP      3328
#define XB_TOPGEN   3392
#define XCD_BAR_WORDS 3456
#define XB_SPIN_CAP (1u << 22)
DI unsigned xb_ld(unsigned* p) { return __hip_atomic_load(p, __ATOMIC_RELAXED, __HIP_MEMORY_SCOPE_AGENT); }
DI unsigned xb_add(unsigned* p, unsigned v) { return __hip_atomic_fetch_add(p, v, __ATOMIC_RELAXED, __HIP_MEMORY_SCOPE_AGENT); }
DI unsigned xb_xcc_id() { return (unsigned)__builtin_amdgcn_s_getreg((3 << 11) | 20) & 0xFu; }
#define XB_SPIN(cond, bar) do { unsigned _sp = 0; while (cond) { __builtin_amdgcn_s_sleep(1); \
    if ((++_sp & 255u) == 0u) { if (xb_ld(&(bar)[XB_TMO])) break; if (_sp > XB_SPIN_CAP) { atomicAdd(&(bar)[XB_TMO], 1u); break; } } } } while (0)
struct XcdBarrier { unsigned* bar; unsigned x; unsigned nloc; unsigned nx; };
DI XcdBarrier xcd_barrier_post(unsigned* bar) {
    XcdBarrier b; b.bar = bar; b.x = xb_xcc_id(); b.nloc = 0u; b.nx = 0u;
    if (threadIdx.x == 0) (void)xb_add(&bar[XB_XCNT(b.x)], 1u);
    return b;
}
DI void xcd_barrier_complete(unsigned* bar, unsigned x, unsigned& nloc, unsigned& nx) {
    const unsigned G = gridDim.x * gridDim.y * gridDim.z;
    unsigned sum, cnt, mine, sp = 0u;
    for (;;) {
        sum = 0u; cnt = 0u; mine = 0u;
#pragma unroll
        for (unsigned j = 0; j < 16; ++j) { const unsigned c = xb_ld(&bar[XB_XCNT(j)]); sum += c; cnt += (c > 0u) ? 1u : 0u; mine = (j == x) ? c : mine; }
        if (sum == G) break;
        __builtin_amdgcn_s_sleep(1);
        if ((++sp & 255u) == 0u) { if (xb_ld(&bar[XB_TMO])) break; if (sp > XB_SPIN_CAP) { atomicAdd(&bar[XB_TMO], 1u); break; } }
    }
    nloc = mine > 0u ? mine : 1u; nx = cnt > 0u ? cnt : 1u;
}
DI void xcd_barrier(XcdBarrier& b) {
    asm volatile("s_waitcnt vmcnt(0)" ::: "memory");
    __syncthreads();
    if (threadIdx.x == 0) {
        unsigned* bar = b.bar;
        __builtin_amdgcn_s_waitcnt(0);
        unsigned nloc = b.nloc, nx = b.nx;
        if (nloc == 0u) { xcd_barrier_complete(bar, b.x, nloc, nx); b.nloc = nloc; b.nx = nx; }
        const unsigned old = xb_add(&bar[XB_XSUB(b.x)], 1u);
        const unsigned gen = old / nloc;
        if (old + 1u == (gen + 1u) * nloc) {
            __builtin_amdgcn_fence(__ATOMIC_RELEASE, "agent");
            asm volatile("s_waitcnt vmcnt(0)" ::: "memory");
            const unsigned og = xb_add(&bar[XB_TOP], 1u);
            const unsigned tg = og / nx;
            if (og + 1u == (tg + 1u) * nx) xb_add(&bar[XB_TOPGEN], 1u);
            else XB_SPIN(xb_ld(&bar[XB_TOPGEN]) == tg, bar);
            __builtin_amdgcn_fence(__ATOMIC_ACQUIRE, "agent");
            xb_add(&bar[XB_XGEN(b.x)], 1u);
            asm volatile("s_waitcnt vmcnt(0)" ::: "memory");
        } else {
            XB_SPIN(xb_ld(&bar[XB_XGEN(b.x)]) == gen, bar);
            __builtin_amdgcn_fence(__ATOMIC_ACQUIRE, "agent");
            asm volatile("s_waitcnt vmcnt(0)" ::: "memory");
        }
    }
    __syncthreads();
}
constexpr size_t OFF_BAR = 293921280;

template <bool COOP>
__global__ void __launch_bounds__(256, 2) mega(Params p) {
    __shared__ __attribute__((aligned(16))) char lds[65536];
    XcdBarrier xb;
    if (COOP) {
        xb = xcd_barrier_post((unsigned*)(p.ws + OFF_BAR));
        if (p.plo < 0) cg::this_grid().sync();
    }
    char* ws = p.ws; char* C = ws + OFF_C; char* ob = (char*)p.out;
    bf16_t* H = (bf16_t*)(ws + OFF_H);
    bf16_t* F = (bf16_t*)(C + C_F);
#define RUNPH(k, ...) do { if (PHON(k) && p.plo <= (k) && (k) < p.phi) { __VA_ARGS__ } \
        if (COOP && p.plo <= (k) && (k) + 1 < p.phi) { xcd_barrier(xb); } } while (0)
    RUNPH(0, phase_prologue(p, lds););
    RUNPH(1, EpiF32 e{(float*)(ws + OFF_MOD), 9216, p.b_ada}; gemm_phase<4>((const bf16_t*)(ws + OFF_SC), (const bf16_t*)(C + C_WADA), 1024, 2, 72, lds, e););
    RUNPH(2, norm_phase(p, true, nullptr, 0, 0.f, nullptr, false, p.n1pre, 0, 1););
    RUNPH(3, EpiSwiglu e{(bf16_t*)(C + C_ACT)}; gemm_phase<4>(H, (const bf16_t*)(ob + T_W1GU), 1024, 132, 43, lds, e););
    RUNPH(4, EpiBf16 e{F, 1024}; gemm_phase<4>((const bf16_t*)(C + C_ACT), (const bf16_t*)(ob + T_W1D), DFF, 132, 8, lds, e););
    RUNPH(5, norm_phase(p, true, F, 2, 0.5f, p.n1post, true, p.nmpre, 3, 4););
    RUNPH(6, EpiP e{(bf16_t*)(C + C_PU), (bf16_t*)(C + C_PQ), (bf16_t*)(C + C_PKV), (float*)(C + C_PBA), (const float*)(ws + OFF_ROPE), (bf16_t*)(C + C_HALO), p.out};
             gemm_phase<4>(H, (const bf16_t*)(ob + T_WA), 1024, 132, 37, lds, e););
    RUNPH(8, for (int it = blockIdx.x; it < 2048; it += gridDim.x) prep_item(p, it, lds); __syncthreads(); phase_mixprep(p, lds););
    RUNPH(9, phase_mixer(p, lds););
    RUNPH(10, sample_window_out(p); EpiMerge e{(const bf16_t*)(C + C_PU), (const bf16_t*)(C + C_PQ), p.dn_norm, (bf16_t*)(C + C_Y)};
              gemm_phase<3>(H, (const bf16_t*)(ws + OFF_WB), 1024, 132, 32, lds, e););
    RUNPH(11, EpiBf16 e{F, 1024}; gemm_phase<4>((const bf16_t*)(C + C_Y), (const bf16_t*)(ws + OFF_WO), 1024, 132, 8, lds, e););
    RUNPH(12, norm_phase(p, false, F, 5, 1.0f, p.nmpost, true, p.n2pre, 6, 7); cvt_jobs<13, 16>(p, lds););
    RUNPH(13, EpiSwiglu e{(bf16_t*)(C + C_ACT)}; gemm_phase<4>(H, (const bf16_t*)(C + C_W2GU), 1024, 132, 43, lds, e););
    RUNPH(14, EpiBf16 e{F, 1024}; gemm_phase<4>((const bf16_t*)(C + C_ACT), (const bf16_t*)(C + C_W2D), DFF, 132, 8, lds, e););
    RUNPH(15, norm_phase(p, false, F, 8, 0.5f, p.n2post, true, nullptr, 0, 0););
#undef RUNPH
}

constexpr int NPHASE = 16;

extern "C" void kernel_launch(void* const* d_in, const int* in_sizes, int n_in, void* d_out, int out_size, void* d_ws, size_t ws_size,
                              hipStream_t stream) {
    Params p{};
    const float** pp = (const float**)&p;
    for (int i = 0; i < 29; ++i) pp[i] = (const float*)d_in[i];
    p.out = (float*)d_out; p.ws = (char*)d_ws; p.plo = 0; p.phi = NPHASE;
#if MK_COOP
    static int grid_blocks = 0;
    if (!grid_blocks) {
        int dev = 0, cus = 0, per_cu = 0;
        (void)hipGetDevice(&dev);
        (void)hipDeviceGetAttribute(&cus, hipDeviceAttributeMultiprocessorCount, dev);
        (void)hipOccupancyMaxActiveBlocksPerMultiprocessor(&per_cu, mega<true>, 256, 0);
        if (per_cu > 2) per_cu = 2;
        grid_blocks = cus * per_cu;
    }
    void* args[] = {&p};
    (void)hipMemsetAsync((char*)d_ws + OFF_BAR, 0, XCD_BAR_WORDS * 4, stream);
    hipError_t e = hipLaunchCooperativeKernel((void*)mega<true>, dim3(grid_blocks), dim3(256), args, 0, stream);
    if (e != hipSuccess) fprintf(stderr, "cooperative launch failed: %s (grid %d)\n", hipGetErrorString(e), grid_blocks);
#else
    for (int ph = 0; ph < NPHASE; ++ph) {
        p.plo = ph; p.phi = ph + 1;
        hipLaunchKernelGGL(mega<false>, dim3(512), dim3(256), 0, stream, p);
    }
#endif
}
```

```cpp
#include <hip/hip_runtime.h>
#include <hip/hip_cooperative_groups.h>
#include <stdint.h>
#include <cstdio>
namespace cg = cooperative_groups;

#ifndef MK_COOP
#define MK_COOP 1
#endif
#ifndef MK_ONLY
#define MK_ONLY -1
#endif
#define PHON(k) (MK_ONLY < 0 || MK_ONLY == (k))

#define DI __device__ __forceinline__
typedef unsigned short bf16_t;
typedef short bf16x8 __attribute__((ext_vector_type(8)));
typedef short s16x4 __attribute__((ext_vector_type(4)));
typedef float f32x4 __attribute__((ext_vector_type(4)));
typedef unsigned u32x4 __attribute__((ext_vector_type(4)));
typedef unsigned u32x2 __attribute__((ext_vector_type(2)));
#define LAS __attribute__((address_space(3)))
#define MFMA16(a, b, c) __builtin_amdgcn_mfma_f32_16x16x32_bf16((a), (b), (c), 0, 0, 0)

constexpr int MP = 16384, MALL = 16896, DM = 1024, DFF = 2752;
constexpr float EPSF = 1e-6f;
constexpr size_t OFF_MOD = 0;
constexpr size_t OFF_H = 9437184;
constexpr size_t OFF_WB = 44040192;
constexpr size_t OFF_WO = 50331648;
constexpr size_t OFF_SC = 52428800;
constexpr size_t OFF_ROPE = 52953088;
constexpr size_t OFF_C = 53215744;
constexpr size_t C_F = 0;
constexpr size_t C_ACT = 69206016;
constexpr size_t C_WADA = 0;
constexpr size_t C_PU = 0;
constexpr size_t C_KDT = 103809024;
constexpr size_t C_ACH = 137363456;
constexpr size_t C_PQ = 154140672;
constexpr size_t C_PKV = 188743680;
constexpr size_t C_KCS = 206045184;
constexpr size_t C_VTP = 215482368;
constexpr size_t C_VTS = 223870976;
constexpr size_t C_PBA = 234356736;
constexpr size_t C_SSQ = 235438080;
constexpr size_t C_GAM = 235978752;
constexpr size_t C_Y = C_KDT;
constexpr size_t C_W2GU = 166723584;
constexpr size_t C_W2D = 177995776;
constexpr size_t O_Y = 0, O_SWKP = 17301504, O_SWVP = 17432576, O_CONVP = 17563648, O_DELTAP = 17600512,
                 O_SWKS = 18124800, O_SWVS = 22319104, O_CONVS = 26513408, O_DELTAS = 27693056;
constexpr size_t T_W1GU = O_SWKS * 4;
constexpr size_t T_W1D = T_W1GU + 11272192;
constexpr size_t T_WA = T_W1D + 5636096;
constexpr size_t T_UP = O_SWKS * 4;
constexpr size_t C_HALO = 235986944;

struct Params {
    const float* x_p; const float* x_s; const float* cache_k; const float* cache_v; const float* st_conv; const float* st_delta;
    const float* c_p; const float* c_s; const float* w_ada; const float* b_ada;
    const float* n1pre; const float* n1post; const float* w1g; const float* w1u; const float* w1d;
    const float* nmpre; const float* nmpost; const float* w_in; const float* conv_w; const float* a_log; const float* dt_bias;
    const float* dn_norm; const float* sinks; const float* w_out;
    const float* n2pre; const float* n2post; const float* w2g; const float* w2u; const float* w2d;
    float* out; char* ws; int plo; int phi;
};

typedef __bf16 bf16v2_t __attribute__((ext_vector_type(2)));
typedef float f32v2_t __attribute__((ext_vector_type(2)));
DI unsigned pack2(float a, float b) { const f32v2_t v = {a, b}; return __builtin_bit_cast(unsigned, __builtin_convertvector(v, bf16v2_t)); }
DI unsigned f2bf(float x) { return pack2(x, 0.f) & 0xffffu; }
DI float bf2f(unsigned h) { return __uint_as_float(h << 16); }
DI float bflo(unsigned w) { return __uint_as_float(w << 16); }
DI float bfhi(unsigned w) { return __uint_as_float(w & 0xffff0000u); }
DI float sigm(float x) { return __builtin_amdgcn_rcpf(1.f + __expf(-x)); }
DI float siluf(float x) { return x * __builtin_amdgcn_rcpf(1.f + __expf(-x)); }
DI float softplusf(float x) { return fmaxf(x, 0.f) + log1pf(__expf(-fabsf(x))); }
DI bf16x8 pack8(const f32x4& a, const f32x4& b) {
    u32x4 p; p.x = pack2(a[0], a[1]); p.y = pack2(a[2], a[3]); p.z = pack2(b[0], b[1]); p.w = pack2(b[2], b[3]);
    return __builtin_bit_cast(bf16x8, p);
}
DI bf16x8 cat4(const s16x4& lo, const s16x4& hi) { return __builtin_shufflevector(lo, hi, 0, 1, 2, 3, 4, 5, 6, 7); }

template <int NT, class Epi>
DI void gemm_phase(const bf16_t* __restrict__ A, const bf16_t* __restrict__ Bt, int K, int nmt, int nnt, char* lds, const Epi& epi) {
    const int tid = threadIdx.x, lane = tid & 63, wid = tid >> 6, fr = lane & 15, fq = lane >> 4;
    const int wm = wid >> 1, wn = wid & 1;
    constexpr int BN = NT * 32;
    constexpr int BCH = BN / 32;
    const int ntiles = nmt * nnt, nk = K >> 6;
    const int srow = tid >> 3, spos = tid & 7;
    const bool xmap = nmt >= 16 && (gridDim.x & 7) == 0;
    const int xcd = blockIdx.x & 7;
    const int mlo = xmap ? (xcd * nmt) >> 3 : 0, mcnt = xmap ? (((xcd + 1) * nmt) >> 3) - mlo : nmt;
    const int estart = xmap ? (int)(blockIdx.x >> 3) : (int)blockIdx.x, estep = xmap ? (int)(gridDim.x >> 3) : (int)gridDim.x;
    const int etotal = xmap ? mcnt * nnt : ntiles;
    for (int e = estart; e < etotal; e += estep) {
        int mt, nt;
        if (xmap) {
            const int pg = mcnt * 8, ng = e / pg, nrem = nnt - ng * 8, gw = nrem < 8 ? nrem : 8, r = e - ng * pg, mi = r / gw;
            mt = mlo + mi; nt = ng * 8 + (r - mi * gw);
        } else { mt = e % nmt; nt = e / nmt; }
        const int m0 = mt * 128, n0 = nt * BN;
        f32x4 acc[4][NT];
#pragma unroll
        for (int m = 0; m < 4; ++m)
#pragma unroll
            for (int n = 0; n < NT; ++n) acc[m][n] = (f32x4){0.f, 0.f, 0.f, 0.f};
        const bf16_t* ag[4]; const bf16_t* bg[BCH];
#pragma unroll
        for (int i = 0; i < 4; ++i) { const int row = srow + 32 * i; ag[i] = A + (size_t)(m0 + row) * K + ((spos ^ ((row >> 1) & 7)) << 3); }
#pragma unroll
        for (int i = 0; i < BCH; ++i) { const int row = srow + 32 * i; bg[i] = Bt + (size_t)(n0 + row) * K + ((spos ^ ((row >> 1) & 7)) << 3); }
        __syncthreads();
#define GEMM_ISSUE(kt_, st_) do { \
        _Pragma("unroll") for (int i = 0; i < 4; ++i) __builtin_amdgcn_global_load_lds((const unsigned*)(ag[i] + (kt_) * 64), (LAS unsigned*)(lds + (st_) * 32768 + i * 4096 + wid * 1024), 16, 0, 0); \
        _Pragma("unroll") for (int i = 0; i < BCH; ++i) __builtin_amdgcn_global_load_lds((const unsigned*)(bg[i] + (kt_) * 64), (LAS unsigned*)(lds + (st_) * 32768 + 16384 + i * 4096 + wid * 1024), 16, 0, 0); } while (0)
        GEMM_ISSUE(0, 0);
        for (int kt = 0; kt < nk; ++kt) {
            asm volatile("s_waitcnt vmcnt(0)" ::: "memory");
            __syncthreads();
            if (kt + 1 < nk) GEMM_ISSUE(kt + 1, (kt + 1) & 1);
            const char* As = lds + (kt & 1) * 32768;
            const char* Bs = As + 16384;
            bf16x8 af[2][4], bfr[2][NT];
#pragma unroll
            for (int ks = 0; ks < 2; ++ks) {
                const int ch = ks * 4 + fq;
#pragma unroll
                for (int m = 0; m < 4; ++m) { const int row = wm * 64 + m * 16 + fr; af[ks][m] = *(const bf16x8*)(As + row * 128 + ((ch ^ ((row >> 1) & 7)) << 4)); }
#pragma unroll
                for (int n = 0; n < NT; ++n) { const int row = wn * NT * 16 + n * 16 + fr; bfr[ks][n] = *(const bf16x8*)(Bs + row * 128 + ((ch ^ ((row >> 1) & 7)) << 4)); }
            }
            __builtin_amdgcn_s_setprio(1);
#pragma unroll
            for (int ks = 0; ks < 2; ++ks)
#pragma unroll
                for (int m = 0; m < 4; ++m)
#pragma unroll
                    for (int n = 0; n < NT; ++n) acc[m][n] = MFMA16(bfr[ks][n], af[ks][m], acc[m][n]);
            __builtin_amdgcn_s_setprio(0);
        }
#undef GEMM_ISSUE
        epi(acc, m0 + wm * 64 + fr, n0, wn, fq, lane);
    }
}

struct EpiF32 {
    float* C; int ldc; const float* bias;
    DI void operator()(const f32x4 (&acc)[4][4], int rowb, int n0, int wn, int fq, int) const {
#pragma unroll
        for (int m = 0; m < 4; ++m)
#pragma unroll
            for (int n = 0; n < 4; ++n) {
                const int col = n0 + wn * 64 + n * 16 + 4 * fq;
                f32x4 v = acc[m][n];
                if (bias) { const f32x4 bv = *(const f32x4*)(bias + col); v = v + bv; }
                *(f32x4*)(C + (size_t)(rowb + m * 16) * ldc + col) = v;
            }
    }
};
struct EpiBf16 {
    bf16_t* O; int ldc;
    DI void operator()(const f32x4 (&acc)[4][4], int rowb, int n0, int wn, int fq, int) const {
#pragma unroll
        for (int m = 0; m < 4; ++m)
#pragma unroll
            for (int n = 0; n < 4; ++n) {
                const f32x4 v = acc[m][n]; u32x2 w; w.x = pack2(v[0], v[1]); w.y = pack2(v[2], v[3]);
                *(u32x2*)(O + (size_t)(rowb + m * 16) * ldc + n0 + wn * 64 + n * 16 + 4 * fq) = w;
            }
    }
};
struct EpiSwiglu {
    bf16_t* O;
    DI void operator()(const f32x4 (&acc)[4][4], int rowb, int n0, int wn, int fq, int) const {
        const int cb = (n0 >> 1) + wn * 32 + 4 * fq;
#pragma unroll
        for (int m = 0; m < 4; ++m)
#pragma unroll
            for (int n2 = 0; n2 < 2; ++n2) {
                const f32x4 g = acc[m][2 * n2], u = acc[m][2 * n2 + 1];
                u32x2 w; w.x = pack2(siluf(g[0]) * u[0], siluf(g[1]) * u[1]); w.y = pack2(siluf(g[2]) * u[2], siluf(g[3]) * u[3]);
                *(u32x2*)(O + (size_t)(rowb + m * 16) * DFF + cb + n2 * 16) = w;
            }
    }
};
struct EpiP {
    bf16_t* PU; bf16_t* PQ; bf16_t* PKV; float* PBA; const float* rope; bf16_t* HALO; float* out;
    DI void operator()(const f32x4 (&acc)[4][4], int rowb, int n0, int wn, int fq, int) const {
        if (n0 < 3072) {
#pragma unroll
            for (int m = 0; m < 4; ++m)
#pragma unroll
                for (int n = 0; n < 4; ++n) {
                    const f32x4 v = acc[m][n]; u32x2 w; w.x = pack2(v[0], v[1]); w.y = pack2(v[2], v[3]);
                    const int row = rowb + m * 16, col = n0 + wn * 64 + n * 16 + 4 * fq;
                    *(u32x2*)(PU + (size_t)row * 3072 + col) = w;
                    if ((row & 63) >= 61 && row < MP && (row & 4095) < 4032)
                        *(u32x2*)(HALO + ((size_t)((row >> 6) + 1) * 3 + ((row & 63) - 61)) * 3072 + col) = w;
                    if (row < MP && (row & 4095) >= 4093)
                        *(f32x4*)(out + O_CONVP + ((size_t)(row >> 12) * 3 + ((row & 4095) - 4093)) * 3072 + col) = v;
                }
        } else if (n0 < 4608) {
            const bool isq = n0 < 4096;
            const int cw = (isq ? n0 - 3072 : n0 - 4096) + wn * 64;
            const bool rot = isq || cw < 256;
            bf16_t* dst = isq ? PQ : PKV; const int ld = isq ? 1024 : 512;
#pragma unroll
            for (int m = 0; m < 4; ++m) {
                const int row = rowb + m * 16;
                const int pidx = row < MP ? (row & 4095) : 4096 + (row & 3);
                const float* tab = rope + pidx * 16 + 4 * (fq & 1);
#pragma unroll
                for (int n = 0; n < 4; ++n) {
                    f32x4 v = acc[m][n];
                    if (n == 0) {
                        f32x4 pr;
#pragma unroll
                        for (int j = 0; j < 4; ++j) pr[j] = __shfl_xor(v[j], 32);
                        if (rot) {
#pragma unroll
                            for (int j = 0; j < 4; ++j) { const float c = tab[j], s = tab[8 + j]; v[j] = (fq < 2) ? v[j] * c - pr[j] * s : v[j] * c + pr[j] * s; }
                        }
                    }
                    u32x2 w; w.x = pack2(v[0], v[1]); w.y = pack2(v[2], v[3]);
                    *(u32x2*)(dst + (size_t)row * ld + cw + n * 16 + 4 * fq) = w;
                    if (!isq && row < MP && (row & 4095) >= 3968) {
                        const int cc = cw + n * 16 + 4 * fq;
                        *(f32x4*)(out + (cc < 256 ? O_SWKP : O_SWVP) + ((size_t)(row >> 12) * 128 + ((row & 4095) - 3968)) * 256 + (cc & 255)) = v;
                    }
                }
            }
        } else {
            if (wn == 0) {
#pragma unroll
                for (int m = 0; m < 4; ++m) *(f32x4*)(PBA + (size_t)(rowb + m * 16) * 16 + 4 * fq) = acc[m][0];
            }
        }
    }
};
struct EpiMerge {
    const bf16_t* PU; const bf16_t* PQ; const float* dng; bf16_t* Y;
    DI void operator()(const f32x4 (&acc)[4][3], int rowb, int n0, int wn, int fq, int) const {
        const int c0 = (n0 / 96) * 32 + wn * 16 + 4 * fq;
        const f32x4 gn = *(const f32x4*)(dng + (c0 & 127));
        u32x4 ov[4][4];
#pragma unroll
        for (int m = 0; m < 4; ++m) {
            const bf16_t* op = PU + (size_t)(rowb + m * 16) * 3072 + 2048 + (c0 & ~127) + fq * 32;
#pragma unroll
            for (int i = 0; i < 4; ++i) ov[m][i] = *(const u32x4*)(op + i * 8);
        }
#pragma unroll
        for (int m = 0; m < 4; ++m) {
            const int row = rowb + m * 16;
            float ss = 0.f;
#pragma unroll
            for (int i = 0; i < 4; ++i)
#pragma unroll
                for (int e = 0; e < 4; ++e) { const float a = bflo(ov[m][i][e]), b = bfhi(ov[m][i][e]); ss += a * a + b * b; }
            ss += __shfl_xor(ss, 16); ss += __shfl_xor(ss, 32);
            const float rstd = rsqrtf(ss * (1.f / 128.f) + EPSF);
            const u32x2 ou = *(const u32x2*)(PU + (size_t)row * 3072 + 2048 + c0);
            const u32x2 os = *(const u32x2*)(PQ + (size_t)row * 1024 + c0);
            const float od[4] = {bflo(ou.x), bfhi(ou.x), bflo(ou.y), bfhi(ou.y)};
            const float sw[4] = {bflo(os.x), bfhi(os.x), bflo(os.y), bfhi(os.y)};
            float y[4];
#pragma unroll
            for (int j = 0; j < 4; ++j) y[j] = sigm(acc[m][1][j]) * (od[j] * rstd * gn[j]) * siluf(acc[m][0][j]) + sigm(acc[m][2][j]) * sw[j];
            u32x2 w; w.x = pack2(y[0], y[1]); w.y = pack2(y[2], y[3]);
            *(u32x2*)(Y + (size_t)row * 1024 + c0) = w;
        }
    }
};

struct CvtJob { const float* src; int ld; int K; int col0; int ncols; bf16_t* dst; int G; int which; int rowbase; };
DI int job_tiles(const CvtJob& j) { return ((j.ncols + 63) >> 6) * (j.K >> 6); }
DI void cvt_tile(const CvtJob& j, int t, char* lds) {
    float* tl = (float*)lds;
    const int tid = threadIdx.x;
    const int nkt = j.K >> 6, ct = t / nkt, kt = t % nkt, c0 = ct * 64, k0 = kt * 64;
    __syncthreads();
#pragma unroll
    for (int i = 0; i < 4; ++i) {
        const int kr = (tid >> 4) + 16 * i, col = (tid & 15) * 4;
        f32x4 v = (f32x4){0.f, 0.f, 0.f, 0.f};
        if (c0 + col < j.ncols) v = *(const f32x4*)(j.src + (size_t)(k0 + kr) * j.ld + j.col0 + c0 + col);
        tl[kr * 65 + col] = v[0]; tl[kr * 65 + col + 1] = v[1]; tl[kr * 65 + col + 2] = v[2]; tl[kr * 65 + col + 3] = v[3];
    }
    __syncthreads();
#pragma unroll
    for (int i = 0; i < 2; ++i) {
        const int col = (tid >> 3) + 32 * i, ch = tid & 7, jc = c0 + col;
        if (jc < j.ncols) {
            const int drow = j.rowbase + (jc >> 4) * (j.G * 16) + j.which * 16 + (jc & 15);
            u32x4 w;
            w.x = pack2(tl[(ch * 8 + 0) * 65 + col], tl[(ch * 8 + 1) * 65 + col]);
            w.y = pack2(tl[(ch * 8 + 2) * 65 + col], tl[(ch * 8 + 3) * 65 + col]);
            w.z = pack2(tl[(ch * 8 + 4) * 65 + col], tl[(ch * 8 + 5) * 65 + col]);
            w.w = pack2(tl[(ch * 8 + 6) * 65 + col], tl[(ch * 8 + 7) * 65 + col]);
            *(u32x4*)(j.dst + (size_t)drow * j.K + k0 + ch * 8) = w;
        }
    }
}
DI CvtJob get_job(const Params& p, int id) {
    char* ws = p.ws; char* ob = (char*)p.out;
    bf16_t* W1GU = (bf16_t*)(ob + T_W1GU); bf16_t* W1D = (bf16_t*)(ob + T_W1D); bf16_t* WA = (bf16_t*)(ob + T_WA);
    bf16_t* WB = (bf16_t*)(ws + OFF_WB); bf16_t* WO = (bf16_t*)(ws + OFF_WO); bf16_t* WADA = (bf16_t*)(ws + OFF_C + C_WADA);
    bf16_t* W2GU = (bf16_t*)(ws + OFF_C + C_W2GU); bf16_t* W2D = (bf16_t*)(ws + OFF_C + C_W2D);
    switch (id) {
        case 0: return CvtJob{p.w1g, DFF, 1024, 0, DFF, W1GU, 2, 0, 0};
        case 1: return CvtJob{p.w1u, DFF, 1024, 0, DFF, W1GU, 2, 1, 0};
        case 2: return CvtJob{p.w1d, 1024, DFF, 0, 1024, W1D, 1, 0, 0};
        case 3: return CvtJob{p.w_in, 7696, 1024, 0, 3072, WA, 1, 0, 0};
        case 4: return CvtJob{p.w_in, 7696, 1024, 3072, 1024, WB, 3, 0, 0};
        case 5: return CvtJob{p.w_in, 7696, 1024, 4096, 16, WA, 1, 0, 4608};
        case 6: return CvtJob{p.w_in, 7696, 1024, 4112, 1024, WA, 1, 0, 3072};
        case 7: return CvtJob{p.w_in, 7696, 1024, 5136, 256, WA, 1, 0, 4096};
        case 8: return CvtJob{p.w_in, 7696, 1024, 5392, 256, WA, 1, 0, 4352};
        case 9: return CvtJob{p.w_in, 7696, 1024, 5648, 1024, WB, 3, 1, 0};
        case 10: return CvtJob{p.w_in, 7696, 1024, 6672, 1024, WB, 3, 2, 0};
        case 11: return CvtJob{p.w_out, 1024, 1024, 0, 1024, WO, 1, 0, 0};
        case 12: return CvtJob{p.w_ada, 9216, 1024, 0, 9216, WADA, 1, 0, 0};
        case 13: return CvtJob{p.w2g, DFF, 1024, 0, DFF, W2GU, 2, 0, 0};
        case 14: return CvtJob{p.w2u, DFF, 1024, 0, DFF, W2GU, 2, 1, 0};
        default: return CvtJob{p.w2d, 1024, DFF, 0, 1024, W2D, 1, 0, 0};
    }
}
template <int JLO, int JHI>
DI void cvt_jobs(const Params& p, char* lds) {
    int base = 0;
#pragma unroll
    for (int id = JLO; id < JHI; ++id) {
        const CvtJob j = get_job(p, id);
        const int nt = job_tiles(j);
        int first = ((int)blockIdx.x - base) % (int)gridDim.x; if (first < 0) first += gridDim.x;
        for (int t = first; t < nt; t += gridDim.x) cvt_tile(j, t, lds);
        base += nt;
    }
    __syncthreads();
}

DI void phase_prologue(const Params& p, char* lds) {
    cvt_jobs<0, 13>(p, lds);
    const int gtid = blockIdx.x * 256 + threadIdx.x, gsz = gridDim.x * 256;
    bf16_t* SC = (bf16_t*)(p.ws + OFF_SC);
    for (int i = gtid; i < 256 * 1024; i += gsz) {
        const int row = i >> 10, col = i & 1023;
        float v = 0.f;
        if (row < 4) v = siluf(p.c_p[row * 1024 + col]); else if (row < 132) v = siluf(p.c_s[(row - 4) * 1024 + col]);
        SC[i] = (bf16_t)f2bf(v);
    }
    float* rope = (float*)(p.ws + OFF_ROPE);
    for (int i = gtid; i < 4100 * 8; i += gsz) {
        const int pi = i >> 3, k = i & 7;
        const float pos = (float)(pi < 4096 ? pi : 8192 + (pi - 4096));
        const float invf = (float)exp(-(double)k * 0.125 * log(500000.0));
        const float ang = pos * invf;
        rope[pi * 16 + k] = (float)cos((double)ang);
        rope[pi * 16 + 8 + k] = (float)sin((double)ang);
    }
}

DI void norm_phase(const Params& p, bool x_from_input, const bf16_t* f, int gate_i, float gcoef, const float* post,
                   bool write_x, const float* pre, int sh_i, int sc_i) {
    const int lane = threadIdx.x & 63, wid = threadIdx.x >> 6;
    const float* MOD = (const float*)(p.ws + OFF_MOD);
    bf16_t* H = (bf16_t*)(p.ws + OFF_H);
    for (int row = blockIdx.x * 4 + wid; row < MALL; row += gridDim.x * 4) {
        const int cidx = row < MP ? (row >> 12) : 4 + ((row - MP) >> 2);
        const float* mrow = MOD + (size_t)cidx * 9216;
        const float* xr = x_from_input ? (row < MP ? p.x_p + (size_t)row * 1024 : p.x_s + (size_t)(row - MP) * 1024) : p.out + (size_t)row * 1024;
        f32x4 x[4];
#pragma unroll
        for (int i = 0; i < 4; ++i) x[i] = *(const f32x4*)(xr + lane * 4 + 256 * i);
        if (f) {
            f32x4 fv[4]; float ss = 0.f;
#pragma unroll
            for (int i = 0; i < 4; ++i) { const u32x2 fw = *(const u32x2*)(f + (size_t)row * 1024 + lane * 4 + 256 * i);
                fv[i] = (f32x4){bflo(fw.x), bfhi(fw.x), bflo(fw.y), bfhi(fw.y)}; ss += fv[i][0] * fv[i][0] + fv[i][1] * fv[i][1] + fv[i][2] * fv[i][2] + fv[i][3] * fv[i][3]; }
#pragma unroll
            for (int o = 32; o > 0; o >>= 1) ss += __shfl_xor(ss, o);
            const float rstd = rsqrtf(ss * (1.f / 1024.f) + EPSF);
#pragma unroll
            for (int i = 0; i < 4; ++i) {
                const int col = lane * 4 + 256 * i;
                const f32x4 g = *(const f32x4*)(mrow + gate_i * 1024 + col), pg = *(const f32x4*)(post + col);
#pragma unroll
                for (int j = 0; j < 4; ++j) x[i][j] += gcoef * g[j] * (fv[i][j] * rstd * pg[j]);
            }
        }
        if (write_x) {
#pragma unroll
            for (int i = 0; i < 4; ++i) *(f32x4*)(p.out + (size_t)row * 1024 + lane * 4 + 256 * i) = x[i];
        }
        if (pre) {
            float ss = 0.f;
#pragma unroll
            for (int i = 0; i < 4; ++i) ss += x[i][0] * x[i][0] + x[i][1] * x[i][1] + x[i][2] * x[i][2] + x[i][3] * x[i][3];
#pragma unroll
            for (int o = 32; o > 0; o >>= 1) ss += __shfl_xor(ss, o);
            const float rstd = rsqrtf(ss * (1.f / 1024.f) + EPSF);
#pragma unroll
            for (int i = 0; i < 4; ++i) {
                const int col = lane * 4 + 256 * i;
                const f32x4 pg = *(const f32x4*)(pre + col), sh = *(const f32x4*)(mrow + sh_i * 1024 + col), sc = *(const f32x4*)(mrow + sc_i * 1024 + col);
                float h[4];
#pragma unroll
                for (int j = 0; j < 4; ++j) h[j] = x[i][j] * rstd * pg[j] * (1.f + sc[j]) + sh[j];
                u32x2 w; w.x = pack2(h[0], h[1]); w.y = pack2(h[2], h[3]);
                *(u32x2*)(H + (size_t)row * 1024 + col) = w;
            }
        }
    }
}

DI void phase_mixprep(const Params& p, char* lds) {
    char* C = p.ws + OFF_C;
    const bf16_t* PKV = (const bf16_t*)(C + C_PKV);
    bf16_t* KCS = (bf16_t*)(C + C_KCS); bf16_t* VTP = (bf16_t*)(C + C_VTP); bf16_t* VTS = (bf16_t*)(C + C_VTS);
    float* SSQ = (float*)(C + C_SSQ);
    const int tid = threadIdx.x, gtid = blockIdx.x * 256 + tid, gsz = gridDim.x * 256;
    bf16_t* tl = (bf16_t*)lds;
    for (int t = blockIdx.x; t < 1024; t += gridDim.x) {
        const int b = t >> 8, cb = (t >> 6) & 3, tb = t & 63;
        __syncthreads();
#pragma unroll
        for (int i = 0; i < 2; ++i) {
            const int tr = (tid >> 3) + 32 * i, c8 = (tid & 7) * 8;
            const u32x4 v = *(const u32x4*)(PKV + (size_t)(b * 4096 + tb * 64 + tr) * 512 + 256 + cb * 64 + c8);
            bf16_t* d = tl + tr * 66 + c8;
            d[0] = (bf16_t)(v.x & 0xffffu); d[1] = (bf16_t)(v.x >> 16); d[2] = (bf16_t)(v.y & 0xffffu); d[3] = (bf16_t)(v.y >> 16);
            d[4] = (bf16_t)(v.z & 0xffffu); d[5] = (bf16_t)(v.z >> 16); d[6] = (bf16_t)(v.w & 0xffffu); d[7] = (bf16_t)(v.w >> 16);
        }
        __syncthreads();
#pragma unroll
        for (int i = 0; i < 2; ++i) {
            const int col = (tid >> 3) + 32 * i, ch = tid & 7;
            u32x4 w;
            w.x = tl[(ch * 8 + 0) * 66 + col] | ((unsigned)tl[(ch * 8 + 1) * 66 + col] << 16);
            w.y = tl[(ch * 8 + 2) * 66 + col] | ((unsigned)tl[(ch * 8 + 3) * 66 + col] << 16);
            w.z = tl[(ch * 8 + 4) * 66 + col] | ((unsigned)tl[(ch * 8 + 5) * 66 + col] << 16);
            w.w = tl[(ch * 8 + 6) * 66 + col] | ((unsigned)tl[(ch * 8 + 7) * 66 + col] << 16);
            *(u32x4*)(VTP + (size_t)(b * 256 + cb * 64 + col) * 4096 + tb * 64 + ch * 8) = w;
        }
    }
    for (int t = blockIdx.x; t < 512; t += gridDim.x) {
        const int seq = t >> 2, cb = t & 3;
        __syncthreads();
        for (int i = tid; i < 160 * 16; i += 256) {
            const int s = i >> 4, col = (i & 15) * 4;
            unsigned w0 = 0, w1 = 0;
            if (s < 128) { const f32x4 v = *(const f32x4*)(p.cache_v + (size_t)(seq * 128 + s) * 256 + cb * 64 + col); w0 = pack2(v[0], v[1]); w1 = pack2(v[2], v[3]); }
            else if (s < 132) { const u32x2 v = *(const u32x2*)(PKV + (size_t)(MP + seq * 4 + s - 128) * 512 + 256 + cb * 64 + col); w0 = v.x; w1 = v.y; }
            bf16_t* d = tl + s * 66 + col;
            d[0] = (bf16_t)(w0 & 0xffffu); d[1] = (bf16_t)(w0 >> 16); d[2] = (bf16_t)(w1 & 0xffffu); d[3] = (bf16_t)(w1 >> 16);
        }
        __syncthreads();
        for (int i = tid; i < 64 * 20; i += 256) {
            const int col = i / 20, ch = i % 20;
            u32x4 w;
            w.x = tl[(ch * 8 + 0) * 66 + col] | ((unsigned)tl[(ch * 8 + 1) * 66 + col] << 16);
            w.y = tl[(ch * 8 + 2) * 66 + col] | ((unsigned)tl[(ch * 8 + 3) * 66 + col] << 16);
            w.z = tl[(ch * 8 + 4) * 66 + col] | ((unsigned)tl[(ch * 8 + 5) * 66 + col] << 16);
            w.w = tl[(ch * 8 + 6) * 66 + col] | ((unsigned)tl[(ch * 8 + 7) * 66 + col] << 16);
            *(u32x4*)(VTS + (size_t)(seq * 256 + cb * 64 + col) * 160 + ch * 8) = w;
        }
    }
    __syncthreads();
    for (int i = gtid; i < 128 * 144 * 32; i += gsz) {
        const int ch = i & 31, slot = (i >> 5) % 144, seq = (i >> 5) / 144;
        u32x4 w = (u32x4){0u, 0u, 0u, 0u};
        if (slot < 128) {
            const float* s = p.cache_k + (size_t)(seq * 128 + slot) * 256 + ch * 8;
            const f32x4 a = *(const f32x4*)s, b = *(const f32x4*)(s + 4);
            w.x = pack2(a[0], a[1]); w.y = pack2(a[2], a[3]); w.z = pack2(b[0], b[1]); w.w = pack2(b[2], b[3]);
        } else if (slot < 132) w = *(const u32x4*)(PKV + (size_t)(MP + seq * 4 + slot - 128) * 512 + ch * 8);
        *(u32x4*)(KCS + (size_t)i * 8) = w;
    }
}

DI void prep_item(const Params& p, int item, char* lds) {
    char* C = p.ws + OFF_C;
    bf16_t* PU = (bf16_t*)(C + C_PU);
    const float* PBA = (const float*)(C + C_PBA);
    bf16_t* KDT = (bf16_t*)(C + C_KDT); bf16_t* ACH = (bf16_t*)(C + C_ACH); float* GAM = (float*)(C + C_GAM);
    const bf16_t* HALO = (const bf16_t*)(C + C_HALO);
    bf16_t* UP = (bf16_t*)((char*)p.out + T_UP);
    int tid = threadIdx.x; asm volatile("" : "+v"(tid));
    const int lane = tid & 63, wid = tid >> 6, fr = lane & 15, fq = lane >> 4;
    const int b = item >> 9, n = (item >> 3) & 63, h = item & 7;
    const int r0 = b * 4096 + n * 64;
    char* Qt = lds; char* Kt = lds + 16384;
    float* Ls = (float*)(lds + 32768);
    float* gc = (float*)(lds + 50176); float* be = gc + 64; float* eg = be + 64;
    const bf16_t* halo = HALO + (size_t)(b * 64 + n) * 3 * 3072;
    __syncthreads();
    {
        const int slot = tid >> 4, l16 = tid & 15, which = slot & 1, rsub = slot >> 1;
        const int cbase = which * 1024 + h * 128 + l16 * 8;
        float w[4][8];
#pragma unroll
        for (int t = 0; t < 4; ++t) {
            const f32x4 a = *(const f32x4*)(p.conv_w + t * 3072 + cbase), bb = *(const f32x4*)(p.conv_w + t * 3072 + cbase + 4);
#pragma unroll
            for (int e = 0; e < 4; ++e) { w[t][e] = a[e]; w[t][4 + e] = bb[e]; }
        }
        const float qs = which == 0 ? 0.08838834764831845f : 1.f;
        for (int ps = 0; ps < 8; ++ps) {
            const int i = ps * 8 + rsub;
            float y[8];
#pragma unroll
            for (int e = 0; e < 8; ++e) y[e] = 0.f;
#pragma unroll
            for (int t = 0; t < 4; ++t) {
                const int tr = i - 3 + t;
                const bf16_t* src = tr < 0 ? halo + (3 + tr) * 3072 + cbase : PU + (size_t)(r0 + tr) * 3072 + cbase;
                u32x4 v = *(const u32x4*)src;
                if (tr < 0 && n == 0) v = (u32x4){0u, 0u, 0u, 0u};
                y[0] += w[t][0] * bflo(v.x); y[1] += w[t][1] * bfhi(v.x); y[2] += w[t][2] * bflo(v.y); y[3] += w[t][3] * bfhi(v.y);
                y[4] += w[t][4] * bflo(v.z); y[5] += w[t][5] * bfhi(v.z); y[6] += w[t][6] * bflo(v.w); y[7] += w[t][7] * bfhi(v.w);
            }
            float ss = 0.f;
#pragma unroll
            for (int e = 0; e < 8; ++e) { y[e] = siluf(y[e]); ss += y[e] * y[e]; }
            ss += __shfl_xor(ss, 1); ss += __shfl_xor(ss, 2); ss += __shfl_xor(ss, 4); ss += __shfl_xor(ss, 8);
            const float sc = rsqrtf(ss + EPSF) * qs;
            u32x4 o; o.x = pack2(y[0] * sc, y[1] * sc); o.y = pack2(y[2] * sc, y[3] * sc); o.z = pack2(y[4] * sc, y[5] * sc); o.w = pack2(y[6] * sc, y[7] * sc);
            *(u32x4*)((which ? Kt : Qt) + i * 256 + ((l16 ^ (i & 15)) << 4)) = o;
        }
    }
    if (wid == 0) {
        const float braw = PBA[(size_t)(r0 + lane) * 16 + h], araw = PBA[(size_t)(r0 + lane) * 16 + 8 + h];
        float g = -__expf(p.a_log[h]) * softplusf(araw + p.dt_bias[h]);
#pragma unroll
        for (int o = 1; o < 64; o <<= 1) { const float t = __shfl_up(g, o); if (lane >= o) g += t; }
        gc[lane] = g; be[lane] = sigm(braw); eg[lane] = __expf(g);
    }
    __syncthreads();
    {
        f32x4 ak[4], aq[4];
#pragma unroll
        for (int nj = 0; nj < 4; ++nj) { ak[nj] = (f32x4){0.f, 0.f, 0.f, 0.f}; aq[nj] = ak[nj]; }
#pragma unroll
        for (int ks = 0; ks < 4; ++ks) {
            const int ri = wid * 16 + fr, ch = ks * 4 + fq;
            const bf16x8 fk = *(const bf16x8*)(Kt + ri * 256 + ((ch ^ (ri & 15)) << 4));
            const bf16x8 fqq = *(const bf16x8*)(Qt + ri * 256 + ((ch ^ (ri & 15)) << 4));
#pragma unroll
            for (int nj = 0; nj < 4; ++nj) {
                const int rj = nj * 16 + fr;
                const bf16x8 fb = *(const bf16x8*)(Kt + rj * 256 + ((ch ^ (rj & 15)) << 4));
                ak[nj] = MFMA16(fk, fb, ak[nj]);
                aq[nj] = MFMA16(fqq, fb, aq[nj]);
            }
        }
#pragma unroll
        for (int nj = 0; nj < 4; ++nj)
#pragma unroll
            for (int jj = 0; jj < 4; ++jj) {
                const int i = wid * 16 + 4 * fq + jj, j = nj * 16 + fr;
                const float dec = __expf(fminf(gc[i] - gc[j], 0.f));
                Ls[i * 68 + j] = i > j ? be[i] * ak[nj][jj] * dec : 0.f;
                ACH[(size_t)item * 4096 + i * 64 + j] = (bf16_t)f2bf(i >= j ? aq[nj][jj] * dec : 0.f);
            }
    }
    __syncthreads();
    asm volatile("" : "+v"(tid));
    float x[64];
    if (tid < 128) {
        const int cv = 2048 + h * 128 + tid;
        const float w0 = p.conv_w[cv], w1 = p.conv_w[3072 + cv], w2 = p.conv_w[2 * 3072 + cv], w3 = p.conv_w[3 * 3072 + cv];
        float xm3 = bf2f(halo[cv]), xm2 = bf2f(halo[3072 + cv]), xm1 = bf2f(halo[2 * 3072 + cv]);
        if (n == 0) { xm3 = 0.f; xm2 = 0.f; xm1 = 0.f; }
#pragma unroll
        for (int i = 0; i < 64; ++i) {
            const float xi = bf2f(PU[(size_t)(r0 + i) * 3072 + cv]);
            x[i] = siluf(w0 * xm3 + w1 * xm2 + w2 * xm1 + w3 * xi) * be[i];
            xm3 = xm2; xm2 = xm1; xm1 = xi;
            if ((i & 15) == 15) __builtin_amdgcn_sched_barrier(0);
        }
    } else {
        const int ck = tid - 128;
#pragma unroll
        for (int i = 0; i < 64; ++i) {
            const bf16_t kv = *(const bf16_t*)(Kt + i * 256 + (((ck >> 3) ^ (i & 15)) << 4) + (ck & 7) * 2);
            x[i] = bf2f(kv) * be[i] * eg[i];
            if ((i & 15) == 15) __builtin_amdgcn_sched_barrier(0);
        }
    }
#pragma unroll
    for (int i = 1; i < 64; ++i) {
        float a = x[i];
#pragma unroll
        for (int j4 = 0; j4 < (i + 3) / 4; ++j4) {
            const f32x4 l = *(const f32x4*)(Ls + i * 68 + j4 * 4);
            a -= l[0] * x[j4 * 4];
            if (j4 * 4 + 1 < i) a -= l[1] * x[j4 * 4 + 1];
            if (j4 * 4 + 2 < i) a -= l[2] * x[j4 * 4 + 2];
            if (j4 * 4 + 3 < i) a -= l[3] * x[j4 * 4 + 3];
        }
        x[i] = a;
        if ((i & 3) == 3) __builtin_amdgcn_sched_barrier(0);
    }
    __syncthreads();
    asm volatile("" : "+v"(tid));
    if (tid < 128) {
        const int sl = tid >> 4, f16 = tid & 15;
#pragma unroll
        for (int q4 = 0; q4 < 4; ++q4) {
            bf16_t* dst = UP + (((size_t)item * 8 + sl) * 64 + q4 * 16 + f16) * 16;
            u32x4 a, bq;
            a.x = pack2(x[0 + 4 * q4 + 0], x[0 + 4 * q4 + 1]); a.y = pack2(x[0 + 4 * q4 + 2], x[0 + 4 * q4 + 3]);
            a.z = pack2(x[16 + 4 * q4 + 0], x[16 + 4 * q4 + 1]); a.w = pack2(x[16 + 4 * q4 + 2], x[16 + 4 * q4 + 3]);
            bq.x = pack2(x[32 + 4 * q4 + 0], x[32 + 4 * q4 + 1]); bq.y = pack2(x[32 + 4 * q4 + 2], x[32 + 4 * q4 + 3]);
            bq.z = pack2(x[48 + 4 * q4 + 0], x[48 + 4 * q4 + 1]); bq.w = pack2(x[48 + 4 * q4 + 2], x[48 + 4 * q4 + 3]);
            *(u32x4*)dst = a; *(u32x4*)(dst + 8) = bq;
        }
    } else {
        const unsigned off = (unsigned)r0 * 3072u + 1024u + h * 128u + (tid - 128);
#pragma unroll
        for (int i = 0; i < 64; ++i) PU[off + (unsigned)i * 3072u] = (bf16_t)f2bf(x[i]);
    }
    {
        const int i = tid >> 2, part = tid & 3;
        const float e = eg[i];
#pragma unroll
        for (int c4 = 0; c4 < 4; ++c4) {
            const int ch = part * 4 + c4;
            const u32x4 v = *(const u32x4*)(Qt + i * 256 + ((ch ^ (i & 15)) << 4));
            u32x4 o;
            o.x = pack2(bflo(v.x) * e, bfhi(v.x) * e); o.y = pack2(bflo(v.y) * e, bfhi(v.y) * e);
            o.z = pack2(bflo(v.z) * e, bfhi(v.z) * e); o.w = pack2(bflo(v.w) * e, bfhi(v.w) * e);
            *(u32x4*)(PU + (size_t)(r0 + i) * 3072 + h * 128 + ch * 8) = o;
        }
    }
    {
        const int dk = tid & 127, ih = tid >> 7;
        const float gl = gc[63];
#pragma unroll
        for (int c4 = 0; c4 < 4; ++c4) {
            float v[8];
#pragma unroll
            for (int e = 0; e < 8; ++e) {
                const int i = ih * 32 + c4 * 8 + e;
                const bf16_t kv = *(const bf16_t*)(Kt + i * 256 + (((dk >> 3) ^ (i & 15)) << 4) + (dk & 7) * 2);
                v[e] = bf2f(kv) * __expf(gl - gc[i]);
            }
            u32x4 o; o.x = pack2(v[0], v[1]); o.y = pack2(v[2], v[3]); o.z = pack2(v[4], v[5]); o.w = pack2(v[6], v[7]);
            *(u32x4*)(KDT + ((size_t)item * 128 + dk) * 64 + ih * 32 + c4 * 8) = o;
        }
        if (tid == 0) GAM[item] = __expf(gl);
    }
}

DI bf16x8 frag_perm(const char* base, int rowbytes, int row, int c0, int fq) {
    const char* q = base + row * rowbytes + (c0 + 4 * fq) * 2;
    const s16x4 lo = *(const s16x4*)q, hi = *(const s16x4*)(q + 32);
    return cat4(lo, hi);
}
#define LDS_BARRIER() do { asm volatile("s_waitcnt lgkmcnt(0)" ::: "memory"); __builtin_amdgcn_s_barrier(); asm volatile("" ::: "memory"); } while (0)
DI void scan_block(const Params& p, int blk, char* lds) {
    char* C = p.ws + OFF_C;
    bf16_t* PU = (bf16_t*)(C + C_PU);
    const bf16_t* KDT = (const bf16_t*)(C + C_KDT); const bf16_t* ACH = (const bf16_t*)(C + C_ACH); const float* GAM = (const float*)(C + C_GAM);
    float* SSQ = (float*)(C + C_SSQ);
    const bf16_t* UP = (const bf16_t*)((const char*)p.out + T_UP);
    const int tid = threadIdx.x, lane = tid & 63, wid = tid >> 6, fr = lane & 15, fq = lane >> 4;
    const int bh = blk & 31, half = blk >> 5, b = bh >> 3, h = bh & 7;
    const int dvb = half * 64 + wid * 16;
    char* Wt = lds; char* Qt = lds + 17408; char* At = lds + 34816; char* Kd = lds + 43520;
    f32x4 S[8];
#pragma unroll
    for (int t = 0; t < 8; ++t) S[t] = (f32x4){0.f, 0.f, 0.f, 0.f};
    u32x4 rW[4], rQ[4], rA[2], rK[4];
    u32x4 rU[2];
    float gam;
#define SCAN_LOAD(nn) do { \
        int tid = threadIdx.x; asm volatile("" : "+v"(tid)); const int lane = tid & 63, wid = tid >> 6; \
        const int r0n_ = b * 4096 + (nn) * 64; const size_t it_ = (size_t)((b * 64 + (nn)) * 8 + h); \
        _Pragma("unroll") for (int i = 0; i < 4; ++i) { const int id = tid + 256 * i, row = id >> 4, ch = id & 15; \
            rW[i] = *(const u32x4*)(PU + (size_t)(r0n_ + row) * 3072 + 1024 + h * 128 + ch * 8); \
            rQ[i] = *(const u32x4*)(PU + (size_t)(r0n_ + row) * 3072 + h * 128 + ch * 8); } \
        _Pragma("unroll") for (int i = 0; i < 2; ++i) { const int id = tid + 256 * i; rA[i] = *(const u32x4*)(ACH + it_ * 4096 + (size_t)id * 8); } \
        _Pragma("unroll") for (int i = 0; i < 4; ++i) { const int id = tid + 256 * i; rK[i] = *(const u32x4*)(KDT + it_ * 8192 + (size_t)id * 8); } \
        { const bf16_t* up_ = UP + ((it_ * 8 + half * 4 + wid) * 64 + lane) * 16; rU[0] = *(const u32x4*)up_; rU[1] = *(const u32x4*)(up_ + 8); } \
        gam = GAM[it_]; } while (0)
    SCAN_LOAD(0);
    __syncthreads();
    for (int n = 0; n < 64; ++n) {
        const int r0 = b * 4096 + n * 64;
        int tid = threadIdx.x; asm volatile("" : "+v"(tid));
#pragma unroll
        for (int i = 0; i < 4; ++i) { const int id = tid + 256 * i, row = id >> 4, ch = id & 15;
            *(u32x4*)(Wt + row * 272 + ch * 16) = rW[i]; *(u32x4*)(Qt + row * 272 + ch * 16) = rQ[i]; }
#pragma unroll
        for (int i = 0; i < 2; ++i) { const int id = tid + 256 * i, row = id >> 3, ch = id & 7; char* q = At + row * 136 + ch * 16;
            *(u32x2*)q = (u32x2){rA[i].x, rA[i].y}; *(u32x2*)(q + 8) = (u32x2){rA[i].z, rA[i].w}; }
#pragma unroll
        for (int i = 0; i < 4; ++i) { const int id = tid + 256 * i, row = id >> 3, ch = id & 7; char* q = Kd + row * 136 + ch * 16;
            *(u32x2*)q = (u32x2){rK[i].x, rK[i].y}; *(u32x2*)(q + 8) = (u32x2){rK[i].z, rK[i].w}; }
        float uc[16];
#pragma unroll
        for (int i = 0; i < 8; ++i) { const unsigned w = i < 4 ? rU[0][i] : rU[1][i - 4]; uc[2 * i] = bflo(w); uc[2 * i + 1] = bfhi(w); }
        const float gcur = gam;
        LDS_BARRIER();
        if (n + 1 < 64) SCAN_LOAD(n + 1);
        bf16x8 Sb[4];
#pragma unroll
        for (int ks = 0; ks < 4; ++ks) Sb[ks] = pack8(S[2 * ks], S[2 * ks + 1]);
        f32x4 aw[4], ao[4];
#pragma unroll
        for (int m = 0; m < 4; ++m) { aw[m] = (f32x4){0.f, 0.f, 0.f, 0.f}; ao[m] = aw[m]; }
        {
            bf16x8 fw[4][4];
#pragma unroll
            for (int ks = 0; ks < 4; ++ks)
#pragma unroll
                for (int m = 0; m < 4; ++m) fw[ks][m] = frag_perm(Wt, 272, 16 * m + fr, 32 * ks, fq);
#pragma unroll
            for (int ks = 0; ks < 4; ++ks)
#pragma unroll
                for (int m = 0; m < 4; ++m) aw[m] = MFMA16(fw[ks][m], Sb[ks], aw[m]);
        }
        __builtin_amdgcn_sched_barrier(0);
        f32x4 vn[4];
        bf16x8 Vb[2];
        {
            bf16x8 fqr[4][4], fa[6];
#pragma unroll
            for (int ks = 0; ks < 4; ++ks)
#pragma unroll
                for (int m = 0; m < 4; ++m) fqr[ks][m] = frag_perm(Qt, 272, 16 * m + fr, 32 * ks, fq);
            fa[0] = frag_perm(At, 136, 0 + fr, 0, fq); fa[1] = frag_perm(At, 136, 16 + fr, 0, fq);
            fa[2] = frag_perm(At, 136, 32 + fr, 0, fq); fa[3] = frag_perm(At, 136, 48 + fr, 0, fq);
            fa[4] = frag_perm(At, 136, 32 + fr, 32, fq); fa[5] = frag_perm(At, 136, 48 + fr, 32, fq);
#pragma unroll
            for (int m = 0; m < 4; ++m)
#pragma unroll
                for (int jj = 0; jj < 4; ++jj) vn[m][jj] = uc[m * 4 + jj] - aw[m][jj];
            Vb[0] = pack8(vn[0], vn[1]); Vb[1] = pack8(vn[2], vn[3]);
#pragma unroll
            for (int ks = 0; ks < 4; ++ks)
#pragma unroll
                for (int m = 0; m < 4; ++m) ao[m] = MFMA16(fqr[ks][m], Sb[ks], ao[m]);
            ao[0] = MFMA16(fa[0], Vb[0], ao[0]); ao[1] = MFMA16(fa[1], Vb[0], ao[1]);
            ao[2] = MFMA16(fa[2], Vb[0], ao[2]); ao[3] = MFMA16(fa[3], Vb[0], ao[3]);
            ao[2] = MFMA16(fa[4], Vb[1], ao[2]); ao[3] = MFMA16(fa[5], Vb[1], ao[3]);
        }
        __builtin_amdgcn_sched_barrier(0);
        {
            bf16x8 fk[2][8];
#pragma unroll
            for (int k2 = 0; k2 < 2; ++k2)
#pragma unroll
                for (int t = 0; t < 8; ++t) fk[k2][t] = frag_perm(Kd, 136, 16 * t + fr, 32 * k2, fq);
#pragma unroll
            for (int t = 0; t < 8; ++t) S[t] = S[t] * gcur;
#pragma unroll
            for (int k2 = 0; k2 < 2; ++k2)
#pragma unroll
                for (int t = 0; t < 8; ++t) S[t] = MFMA16(fk[k2][t], Vb[k2], S[t]);
        }
#pragma unroll
        for (int m = 0; m < 4; ++m)
#pragma unroll
            for (int j2 = 0; j2 < 2; ++j2) {
                const unsigned w = pack2(ao[m][2 * j2], ao[m][2 * j2 + 1]);
                const unsigned ob = (unsigned)(r0 + 4 * fq) * 3072u + 2048u + h * 128u + dvb + fr + (unsigned)(16 * m + 2 * j2) * 3072u;
                PU[ob] = (bf16_t)(w & 0xffffu); PU[ob + 3072u] = (bf16_t)(w >> 16);
            }
        LDS_BARRIER();
    }
#undef SCAN_LOAD
#pragma unroll
    for (int t = 0; t < 8; ++t)
#pragma unroll
        for (int jj = 0; jj < 4; ++jj)
            p.out[O_DELTAP + ((size_t)(b * 8 + h) * 128 + 16 * t + 4 * fq + jj) * 128 + dvb + fr] = S[t][jj];
}

DI void sdelta_item(const Params& p, int item, char* lds) {
    char* C = p.ws + OFF_C;
    bf16_t* PU = (bf16_t*)(C + C_PU);
    const float* PBA = (const float*)(C + C_PBA);
    float* SSQ = (float*)(C + C_SSQ);
    const int tid = threadIdx.x, lane = tid & 63, wid = tid >> 6;
    const int seq = item >> 3, h = item & 7, rs = MP + seq * 4;
    float* qs = (float*)lds;
    float* ks = qs + 512; float* vs = ks + 512;
    float* red = vs + 512;
    float* bt = red + 16; float* al = bt + 4;
    float* kSp = al + 4;
    float* op = kSp + 1024;
    const int ch = tid & 127, part = tid >> 7;
    __syncthreads();
    float yq[4];
    {
        const int nch = part == 0 ? 2 : 1;
        for (int cc = 0; cc < nch; ++cc) {
            const int c = part == 1 ? 1024 + h * 128 + ch : (cc == 0 ? h * 128 + ch : 2048 + h * 128 + ch);
            float full[7];
#pragma unroll
            for (int i = 0; i < 3; ++i) full[i] = p.st_conv[(size_t)(seq * 3 + i) * 3072 + c];
#pragma unroll
            for (int i = 0; i < 4; ++i) full[3 + i] = bf2f(PU[(size_t)(rs + i) * 3072 + c]);
#pragma unroll
            for (int i = 0; i < 3; ++i) p.out[O_CONVS + (size_t)(seq * 3 + i) * 3072 + c] = full[4 + i];
            const float w0 = p.conv_w[c], w1 = p.conv_w[3072 + c], w2 = p.conv_w[2 * 3072 + c], w3 = p.conv_w[3 * 3072 + c];
            float y[4];
#pragma unroll
            for (int t = 0; t < 4; ++t) y[t] = siluf(w0 * full[t] + w1 * full[t + 1] + w2 * full[t + 2] + w3 * full[t + 3]);
            if (part == 0 && cc == 1) {
#pragma unroll
                for (int t = 0; t < 4; ++t) vs[t * 128 + ch] = y[t];
            } else {
#pragma unroll
                for (int t = 0; t < 4; ++t) yq[t] = y[t];
            }
        }
    }
#pragma unroll
    for (int t = 0; t < 4; ++t) {
        float s = yq[t] * yq[t];
#pragma unroll
        for (int o = 32; o > 0; o >>= 1) s += __shfl_xor(s, o);
        if (lane == 0) red[wid * 4 + t] = s;
    }
    if (tid < 4) {
        const float braw = PBA[(size_t)(rs + tid) * 16 + h], araw = PBA[(size_t)(rs + tid) * 16 + 8 + h];
        bt[tid] = sigm(braw);
        al[tid] = __expf(-__expf(p.a_log[h]) * softplusf(araw + p.dt_bias[h]));
    }
    __syncthreads();
#pragma unroll
    for (int t = 0; t < 4; ++t) {
        const float tot = red[(2 * part) * 4 + t] + red[(2 * part + 1) * 4 + t];
        const float sc = rsqrtf(tot + EPSF) * (part == 0 ? 0.08838834764831845f : 1.f);
        (part == 0 ? qs : ks)[t * 128 + ch] = yq[t] * sc;
    }
    __syncthreads();
    const int dv = ch, dk0 = part * 64;
    float S[64];
    const float* s0 = p.st_delta + ((size_t)(seq * 8 + h) * 128 + dk0) * 128 + dv;
#pragma unroll
    for (int i = 0; i < 64; ++i) S[i] = s0[(size_t)i * 128];
#pragma unroll
    for (int t = 0; t < 4; ++t) {
        float pk = 0.f;
#pragma unroll
        for (int i = 0; i < 64; ++i) pk += ks[t * 128 + dk0 + i] * S[i];
        kSp[(t * 2 + part) * 128 + dv] = pk;
        __syncthreads();
        const float kS = kSp[(t * 2) * 128 + dv] + kSp[(t * 2 + 1) * 128 + dv];
        const float a = al[t];
        const float vnew = bt[t] * (vs[t * 128 + dv] - a * kS);
        float po = 0.f;
#pragma unroll
        for (int i = 0; i < 64; ++i) { S[i] = a * S[i] + ks[t * 128 + dk0 + i] * vnew; po += qs[t * 128 + dk0 + i] * S[i]; }
        op[(t * 2 + part) * 128 + dv] = po;
        __syncthreads();
        if (part == 0) {
            const float o = op[(t * 2) * 128 + dv] + op[(t * 2 + 1) * 128 + dv];
            PU[(size_t)(rs + t) * 3072 + 2048 + h * 128 + dv] = (bf16_t)f2bf(o);
        }
    }
    float* so = p.out + O_DELTAS + ((size_t)(seq * 8 + h) * 128 + dk0) * 128 + dv;
#pragma unroll
    for (int i = 0; i < 64; ++i) so[(size_t)i * 128] = S[i];
}

DI void attn_block(const Params& p, int bt) {
    char* C = p.ws + OFF_C;
    bf16_t* PQ = (bf16_t*)(C + C_PQ);
    const bf16_t* PKV = (const bf16_t*)(C + C_PKV); const bf16_t* KCS = (const bf16_t*)(C + C_KCS);
    const bf16_t* VTP = (const bf16_t*)(C + C_VTP); const bf16_t* VTS = (const bf16_t*)(C + C_VTS);
    const int lane = threadIdx.x & 63, wid = threadIdx.x >> 6, fr = lane & 15, fq = lane >> 4;
    const bool isS = bt >= 4096;
    int b = 0, kvh, t0 = 0, seq = 0, head, qrow;
    if (!isS) { b = bt >> 10; kvh = (bt >> 8) & 3; t0 = (bt & 255) * 16; head = kvh * 4 + wid; qrow = b * 4096 + t0 + fr; }
    else { seq = bt - 4096; kvh = wid; head = kvh * 4 + (fr >> 2); qrow = MP + seq * 4 + (fr & 3); }
    bf16_t* qp = PQ + (size_t)qrow * 1024 + head * 64;
    const float sink = p.sinks[head];
    bf16x8 bq[2];
    bq[0] = *(const bf16x8*)(qp + fq * 8); bq[1] = *(const bf16x8*)(qp + 32 + fq * 8);
    f32x4 sc[10];
#pragma unroll
    for (int n = 0; n < 10; ++n) {
        const bf16_t* kp;
        if (!isS) { int t = t0 - 144 + 16 * n + fr; t = t < 0 ? 0 : t; kp = PKV + (size_t)(b * 4096 + t) * 512 + kvh * 64; }
        else { int s = 16 * n + fr; s = s > 143 ? 143 : s; kp = KCS + (size_t)(seq * 144 + s) * 256 + kvh * 64; }
        f32x4 a = (f32x4){0.f, 0.f, 0.f, 0.f};
        a = MFMA16(*(const bf16x8*)(kp + fq * 8), bq[0], a);
        a = MFMA16(*(const bf16x8*)(kp + 32 + fq * 8), bq[1], a);
        sc[n] = a;
    }
    float mx = sink;
#pragma unroll
    for (int n = 0; n < 10; ++n)
#pragma unroll
        for (int jj = 0; jj < 4; ++jj) {
            const int kidx = 16 * n + 4 * fq + jj;
            bool valid;
            if (!isS) { const int t = t0 - 144 + kidx, d = 144 + fr - kidx; valid = t >= 0 && d >= 0 && d <= 128; }
            else { const int d = (fr & 3) + 128 - kidx; valid = d >= 0 && d <= 128; }
            const float s = valid ? sc[n][jj] * 0.125f : -1e30f;
            sc[n][jj] = s; mx = fmaxf(mx, s);
        }
    mx = fmaxf(mx, __shfl_xor(mx, 16)); mx = fmaxf(mx, __shfl_xor(mx, 32));
    float sum = 0.f;
#pragma unroll
    for (int n = 0; n < 10; ++n)
#pragma unroll
        for (int jj = 0; jj < 4; ++jj) { const float e = __expf(sc[n][jj] - mx); sc[n][jj] = e; sum += e; }
    sum += __shfl_xor(sum, 16); sum += __shfl_xor(sum, 32);
    const float inv = 1.f / (sum + __expf(sink - mx));
    bf16x8 bP[5];
#pragma unroll
    for (int s5 = 0; s5 < 5; ++s5) bP[s5] = pack8(sc[2 * s5] * inv, sc[2 * s5 + 1] * inv);
#pragma unroll
    for (int ds = 0; ds < 4; ++ds) {
        const bf16_t* vrow = !isS ? VTP + (size_t)(b * 256 + kvh * 64 + 16 * ds + fr) * 4096 : VTS + (size_t)(seq * 256 + kvh * 64 + 16 * ds + fr) * 160;
        f32x4 a = (f32x4){0.f, 0.f, 0.f, 0.f};
#pragma unroll
        for (int s5 = 0; s5 < 5; ++s5) {
            int g0 = 32 * s5 + 4 * fq, g1 = g0 + 16;
            if (!isS) { g0 += t0 - 144; g1 += t0 - 144; g0 = g0 < 0 ? 0 : g0; g1 = g1 < 0 ? 0 : g1; }
            const s16x4 lo = *(const s16x4*)(vrow + g0), hi = *(const s16x4*)(vrow + g1);
            a = MFMA16(cat4(lo, hi), bP[s5], a);
        }
        u32x2 w; w.x = pack2(a[0], a[1]); w.y = pack2(a[2], a[3]);
        *(u32x2*)(qp + 16 * ds + 4 * fq) = w;
    }
}

DI void sample_window_out(const Params& p) {
    const bf16_t* PKV = (const bf16_t*)(p.ws + OFF_C + C_PKV);
    const int gt = blockIdx.x * 256 + threadIdx.x, gs = gridDim.x * 256;
    for (int i = gt; i < 128 * 128 * 128; i += gs) {
        const int c = (i & 127) * 4, s = (i >> 7) & 127, seq = i >> 14;
        const int cc = c & 255; const bool isv = c >= 256;
        f32x4 v;
        if (s < 124) v = *(const f32x4*)((isv ? p.cache_v : p.cache_k) + (size_t)(seq * 128 + s + 4) * 256 + cc);
        else { const u32x2 w = *(const u32x2*)(PKV + (size_t)(MP + seq * 4 + s - 124) * 512 + c); v = (f32x4){bflo(w.x), bfhi(w.x), bflo(w.y), bfhi(w.y)}; }
        *(f32x4*)(p.out + (isv ? O_SWVS : O_SWKS) + (size_t)(seq * 128 + s) * 256 + cc) = v;
    }
}

DI void phase_mixer(const Params& p, char* lds) {
    const int nb = gridDim.x, blk = blockIdx.x;
    const int nscan = 64;
#ifndef MK_P9
#define MK_P9 7
#endif
    if (blk < nscan) { if (MK_P9 & 1) scan_block(p, blk, lds); return; }
    const int halfg = nb >> 1;
    if (nb == 512 && blk >= halfg && blk < halfg + nscan) return;
    const int wb = (nb == 512) ? (blk < halfg ? blk - nscan : blk - 2 * nscan) : blk - nscan, nw = (nb == 512) ? nb - 2 * nscan : nb - nscan;
    if (MK_P9 & 2) for (int it = wb; it < 1024; it += nw) sdelta_item(p, it, lds);
    if (MK_P9 & 4) for (int bt = wb; bt < 4224; bt += nw) attn_block(p, bt);
}

#define XB_TMO      128
#define XB_XCNT(j)  (256  + 64 * (j))
#define XB_XSUB(j)  (1280 + 64 * (j))
#define XB_XGEN(j)  (2304 + 64 * (j))
#define XB_TOP      3328
#define XB_TOPGEN   3392
#define XCD_BAR_WORDS 3456
#define XB_SPIN_CAP (1u << 22)
DI unsigned xb_ld(unsigned* p) { return __hip_atomic_load(p, __ATOMIC_RELAXED, __HIP_MEMORY_SCOPE_AGENT); }
DI unsigned xb_add(unsigned* p, unsigned v) { return __hip_atomic_fetch_add(p, v, __ATOMIC_RELAXED, __HIP_MEMORY_SCOPE_AGENT); }
DI unsigned xb_xcc_id() { return (unsigned)__builtin_amdgcn_s_getreg((3 << 11) | 20) & 0xFu; }
#define XB_SPIN(cond, bar) do { unsigned _sp = 0; while (cond) { __builtin_amdgcn_s_sleep(1); \
    if ((++_sp & 255u) == 0u) { if (xb_ld(&(bar)[XB_TMO])) break; if (_sp > XB_SPIN_CAP) { atomicAdd(&(bar)[XB_TMO], 1u); break; } } } } while (0)
struct XcdBarrier { unsigned* bar; unsigned x; unsigned nloc; unsigned nx; };
DI XcdBarrier xcd_barrier_post(unsigned* bar) {
    XcdBarrier b; b.bar = bar; b.x = xb_xcc_id(); b.nloc = 0u; b.nx = 0u;
    if (threadIdx.x == 0) (void)xb_add(&bar[XB_XCNT(b.x)], 1u);
    return b;
}
DI void xcd_barrier_complete(unsigned* bar, unsigned x, unsigned& nloc, unsigned& nx) {
    const unsigned G = gridDim.x * gridDim.y * gridDim.z;
    unsigned sum, cnt, mine, sp = 0u;
    for (;;) {
        sum = 0u; cnt = 0u; mine = 0u;
#pragma unroll
        for (unsigned j = 0; j < 16; ++j) { const unsigned c = xb_ld(&bar[XB_XCNT(j)]); sum += c; cnt += (c > 0u) ? 1u : 0u; mine = (j == x) ? c : mine; }
        if (sum == G) break;
        __builtin_amdgcn_s_sleep(1);
        if ((++sp & 255u) == 0u) { if (xb_ld(&bar[XB_TMO])) break; if (sp > XB_SPIN_CAP) { atomicAdd(&bar[XB_TMO], 1u); break; } }
    }
    nloc = mine > 0u ? mine : 1u; nx = cnt > 0u ? cnt : 1u;
}
DI void xcd_barrier(XcdBarrier& b) {
    asm volatile("s_waitcnt vmcnt(0)" ::: "memory");
    __syncthreads();
    if (threadIdx.x == 0) {
        unsigned* bar = b.bar;
        __builtin_amdgcn_s_waitcnt(0);
        unsigned nloc = b.nloc, nx = b.nx;
        if (nloc == 0u) { xcd_barrier_complete(bar, b.x, nloc, nx); b.nloc = nloc; b.nx = nx; }
        const unsigned old = xb_add(&bar[XB_XSUB(b.x)], 1u);
        const unsigned gen = old / nloc;
        if (old + 1u == (gen + 1u) * nloc) {
            __builtin_amdgcn_fence(__ATOMIC_RELEASE, "agent");
            asm volatile("s_waitcnt vmcnt(0)" ::: "memory");
            const unsigned og = xb_add(&bar[XB_TOP], 1u);
            const unsigned tg = og / nx;
            if (og + 1u == (tg + 1u) * nx) xb_add(&bar[XB_TOPGEN], 1u);
            else XB_SPIN(xb_ld(&bar[XB_TOPGEN]) == tg, bar);
            __builtin_amdgcn_fence(__ATOMIC_ACQUIRE, "agent");
            xb_add(&bar[XB_XGEN(b.x)], 1u);
            asm volatile("s_waitcnt vmcnt(0)" ::: "memory");
        } else {
            XB_SPIN(xb_ld(&bar[XB_XGEN(b.x)]) == gen, bar);
            __builtin_amdgcn_fence(__ATOMIC_ACQUIRE, "agent");
            asm volatile("s_waitcnt vmcnt(0)" ::: "memory");
        }
    }
    __syncthreads();
}
constexpr size_t OFF_BAR = 293921280;

template <bool COOP>
__global__ void __launch_bounds__(256, 2) mega(Params p) {
    __shared__ __attribute__((aligned(16))) char lds[65536];
    XcdBarrier xb;
    if (COOP) {
        xb = xcd_barrier_post((unsigned*)(p.ws + OFF_BAR));
        if (p.plo < 0) cg::this_grid().sync();
    }
    char* ws = p.ws; char* C = ws + OFF_C; char* ob = (char*)p.out;
    bf16_t* H = (bf16_t*)(ws + OFF_H);
    bf16_t* F = (bf16_t*)(C + C_F);
#define RUNPH(k, ...) do { if (PHON(k) && p.plo <= (k) && (k) < p.phi) { __VA_ARGS__ } \
        if (COOP && p.plo <= (k) && (k) + 1 < p.phi) { xcd_barrier(xb); } } while (0)
    RUNPH(0, phase_prologue(p, lds););
    RUNPH(1, EpiF32 e{(float*)(ws + OFF_MOD), 9216, p.b_ada}; gemm_phase<4>((const bf16_t*)(ws + OFF_SC), (const bf16_t*)(C + C_WADA), 1024, 2, 72, lds, e););
    RUNPH(2, norm_phase(p, true, nullptr, 0, 0.f, nullptr, false, p.n1pre, 0, 1););
    RUNPH(3, EpiSwiglu e{(bf16_t*)(C + C_ACT)}; gemm_phase<4>(H, (const bf16_t*)(ob + T_W1GU), 1024, 132, 43, lds, e););
    RUNPH(4, EpiBf16 e{F, 1024}; gemm_phase<4>((const bf16_t*)(C + C_ACT), (const bf16_t*)(ob + T_W1D), DFF, 132, 8, lds, e););
    RUNPH(5, norm_phase(p, true, F, 2, 0.5f, p.n1post, true, p.nmpre, 3, 4););
    RUNPH(6, EpiP e{(bf16_t*)(C + C_PU), (bf16_t*)(C + C_PQ), (bf16_t*)(C + C_PKV), (float*)(C + C_PBA), (const float*)(ws + OFF_ROPE), (bf16_t*)(C + C_HALO), p.out};
             gemm_phase<4>(H, (const bf16_t*)(ob + T_WA), 1024, 132, 37, lds, e););
    RUNPH(8, for (int it = blockIdx.x; it < 2048; it += gridDim.x) prep_item(p, it, lds); __syncthreads(); phase_mixprep(p, lds););
    RUNPH(9, phase_mixer(p, lds););
    RUNPH(10, sample_window_out(p); EpiMerge e{(const bf16_t*)(C + C_PU), (const bf16_t*)(C + C_PQ), p.dn_norm, (bf16_t*)(C + C_Y)};
              gemm_phase<3>(H, (const bf16_t*)(ws + OFF_WB), 1024, 132, 32, lds, e););
    RUNPH(11, EpiBf16 e{F, 1024}; gemm_phase<4>((const bf16_t*)(C + C_Y), (const bf16_t*)(ws + OFF_WO), 1024, 132, 8, lds, e););
    RUNPH(12, norm_phase(p, false, F, 5, 1.0f, p.nmpost, true, p.n2pre, 6, 7); cvt_jobs<13, 16>(p, lds););
    RUNPH(13, EpiSwiglu e{(bf16_t*)(C + C_ACT)}; gemm_phase<4>(H, (const bf16_t*)(C + C_W2GU), 1024, 132, 43, lds, e););
    RUNPH(14, EpiBf16 e{F, 1024}; gemm_phase<4>((const bf16_t*)(C + C_ACT), (const bf16_t*)(C + C_W2D), DFF, 132, 8, lds, e););
    RUNPH(15, norm_phase(p, false, F, 8, 0.5f, p.n2post, true, nullptr, 0, 0););
#undef RUNPH
}

constexpr int NPHASE = 16;

extern "C" void kernel_launch(void* const* d_in, const int* in_sizes, int n_in, void* d_out, int out_size, void* d_ws, size_t ws_size,
                              hipStream_t stream) {
    Params p{};
    const float** pp = (const float**)&p;
    for (int i = 0; i < 29; ++i) pp[i] = (const float*)d_in[i];
    p.out = (float*)d_out; p.ws = (char*)d_ws; p.plo = 0; p.phi = NPHASE;
#if MK_COOP
    static int grid_blocks = 0;
    if (!grid_blocks) {
        int dev = 0, cus = 0, per_cu = 0;
        (void)hipGetDevice(&dev);
        (void)hipDeviceGetAttribute(&cus, hipDeviceAttributeMultiprocessorCount, dev);
        (void)hipOccupancyMaxActiveBlocksPerMultiprocessor(&per_cu, mega<true>, 256, 0);
        if (per_cu > 2) per_cu = 2;
        grid_blocks = cus * per_cu;
    }
    void* args[] = {&p};
    (void)hipMemsetAsync((char*)d_ws + OFF_BAR, 0, XCD_BAR_WORDS * 4, stream);
    hipError_t e = hipLaunchCooperativeKernel((void*)mega<true>, dim3(grid_blocks), dim3(256), args, 0, stream);
    if (e != hipSuccess) fprintf(stderr, "cooperative launch failed: %s (grid %d)\n", hipGetErrorString(e), grid_blocks);
#else
    for (int ph = 0; ph < NPHASE; ++ph) {
        p.plo = ph; p.phi = ph + 1;
        hipLaunchKernelGGL(mega<false>, dim3(512), dim3(256), 0, stream, p);
    }
#endif
}
```
